# Optimizing an MI355X kernel written in HIP

```python
import math
import jax
import jax.numpy as jnp
from jax import lax
import numpy as np

D_MODEL = 1024
BATCH = 8
SEQ = 4096
DEPTH = 2

GRID_W = 64
CTX_LEN = 256
EPS = 1e-6

SHORT_CONV = 4
CONV_LEFT = 2

LRU_HEADS = 4
LRU_HEAD_DIM = 64
LRU_WIDTH = LRU_HEADS * LRU_HEAD_DIM
LRU_C = 8.0

SSD_HEADS = 4
SSD_HEAD_DIM = 64
SSD_WIDTH = SSD_HEADS * SSD_HEAD_DIM
SSD_GROUPS = 2
SSD_STATE = 128
SSD_CHUNK = 128
SSD_CONV_DIM = SSD_WIDTH + 2 * SSD_GROUPS * SSD_STATE

DA_HEADS = 4
DA_QK_DIM = 64
DA_V_DIM = 2 * DA_QK_DIM
DA_QK_WIDTH = DA_HEADS * 2 * DA_QK_DIM
DA_WIDTH = DA_HEADS * DA_V_DIM
DA_SCALE = DA_QK_DIM ** -0.5
Q_BLOCK = 128
ROPE_BASE = 10000.0

D_MIX = LRU_WIDTH + SSD_WIDTH + DA_WIDTH

OFF_LRU_X = LRU_WIDTH
OFF_SSD_Z = 2 * LRU_WIDTH
OFF_SSD_XBC = OFF_SSD_Z + SSD_WIDTH
OFF_SSD_DT = OFF_SSD_XBC + SSD_CONV_DIM
OFF_DA_Q = OFF_SSD_DT + 2 * SSD_HEADS
OFF_DA_K = OFF_DA_Q + DA_QK_WIDTH
OFF_DA_V = OFF_DA_K + DA_QK_WIDTH
D_IN = OFF_DA_V + DA_WIDTH
IN_SPLITS = (OFF_LRU_X, OFF_SSD_Z, OFF_SSD_XBC, OFF_SSD_DT, OFF_DA_Q, OFF_DA_K, OFF_DA_V)

N_EXPERTS = 32
TOP_K = 4
D_EXPERT = 1024
SWIGLU_ALPHA = 1.702
SWIGLU_LIMIT = 7.0
MOE_BLOCK = 256

kernel_name = 'hymba_lru_ssd_diffattn_moe_dit'


def rmsnorm(x, g):
    xf = x.astype(jnp.float32)
    y = xf * lax.rsqrt(jnp.mean(xf * xf, axis=-1, keepdims=True) + EPS)
    return (y * g.astype(jnp.float32)).astype(x.dtype)


def modulate(h, shift, scale):
    return h * (1.0 + scale) + shift


def dwconv(x, w, b):
    k = w.shape[0]
    y = lax.conv_general_dilated(x, w[:, None, :].astype(x.dtype), window_strides=(1,),
                                 padding=[(CONV_LEFT, k - 1 - CONV_LEFT)],
                                 dimension_numbers=('NWC', 'WIO', 'NWC'),
                                 feature_group_count=x.shape[-1])
    return y + b.astype(x.dtype)


def rglru_coeffs(xc, wa, ba, wx, bx, lam):
    b, l, w = xc.shape
    xh = xc.reshape(b, l, LRU_HEADS, LRU_HEAD_DIM)
    r = jax.nn.sigmoid(jnp.einsum('blhi,hij->blhj', xh, wa.astype(jnp.float32)).reshape(b, l, w) + ba.astype(jnp.float32))
    i = jax.nn.sigmoid(jnp.einsum('blhi,hij->blhj', xh, wx.astype(jnp.float32)).reshape(b, l, w) + bx.astype(jnp.float32))
    log_a = -LRU_C * r * jax.nn.softplus(-lam.astype(jnp.float32))
    a = jnp.exp(log_a)
    u = jnp.sqrt(-jnp.expm1(2.0 * log_a)) * (i * xc)
    return a, u


def _lin_combine(lhs, rhs):
    a1, b1 = lhs
    a2, b2 = rhs
    return a1 * a2, a2 * b1 + b2


def linear_scan(a, u, h0, reverse):
    edge = -1 if reverse else 0
    u = u.at[:, edge].add(a[:, edge] * h0)
    _, h = lax.associative_scan(_lin_combine, (a, u), reverse=reverse, axis=1)
    return h


def lru_mix(gate_in, x_in, conv_w, conv_b, wa, ba, wx, bx, lam, h0f, h0b, need_y):
    xc = dwconv(x_in, conv_w, conv_b).astype(jnp.float32)
    af, uf = rglru_coeffs(xc, wa[0], ba[0], wx[0], bx[0], lam[0])
    ab, ub = rglru_coeffs(xc, wa[1], ba[1], wx[1], bx[1], lam[1])
    hf = linear_scan(af, uf, h0f, False)
    hb = linear_scan(ab, ub, h0b, True)
    if not need_y:
        return None, hf[:, -1], hb[:, 0]
    y = jax.nn.gelu(gate_in.astype(jnp.float32)) * (hf + hb)
    return y.astype(gate_in.dtype), hf[:, -1], hb[:, 0]


def segsum(x):
    t = x.shape[-1]
    xx = jnp.broadcast_to(x[..., None], x.shape + (t,))
    xx = jnp.where(jnp.tril(jnp.ones((t, t), bool), -1), xx, 0.0)
    cs = jnp.cumsum(xx, axis=-2)
    return jnp.where(jnp.tril(jnp.ones((t, t), bool)), cs, -jnp.inf)


def ssd_scan(xdt, adt, bm, cm, h0, need_y):
    b, l, h, p = xdt.shape
    n = bm.shape[-1]
    nc = l // SSD_CHUNK
    X = xdt.reshape(b, nc, SSD_CHUNK, h, p)
    Bc = bm.reshape(b, nc, SSD_CHUNK, h, n)
    Cc = cm.reshape(b, nc, SSD_CHUNK, h, n)
    A = adt.reshape(b, nc, SSD_CHUNK, h).transpose(0, 3, 1, 2)
    A_cs = jnp.cumsum(A, axis=-1)
    decay_states = jnp.exp(A_cs[..., -1:] - A_cs)
    states = jnp.einsum('bclhn,bhcl,bclhp->bchpn', Bc, decay_states, X)
    states = jnp.concatenate([h0[:, None], states], axis=1)
    decay_chunk = jnp.exp(segsum(jnp.pad(A_cs[..., -1], ((0, 0), (0, 0), (1, 0)))))
    new_states = jnp.einsum('bhzc,bchpn->bzhpn', decay_chunk, states)
    final = new_states[:, -1]
    if not need_y:
        return None, final
    states = new_states[:, :-1]
    Lmat = jnp.exp(segsum(A))
    y_diag = jnp.einsum('bclhn,bcshn,bhcls,bcshp->bclhp', Cc, Bc, Lmat, X)
    y_off = jnp.einsum('bclhn,bchpn,bhcl->bclhp', Cc, states, jnp.exp(A_cs))
    return (y_diag + y_off).reshape(b, l, h, p), final


def ssd_mix(z, xbc, dt_raw, conv_w, conv_b, a_log, dt_bias, d_skip, norm_g, h0f, h0b, need_y):
    b, l, _ = xbc.shape
    xbc = jax.nn.silu(dwconv(xbc, conv_w, conv_b)).astype(jnp.float32)
    xs, bm, cm = jnp.split(xbc, [SSD_WIDTH, SSD_WIDTH + SSD_GROUPS * SSD_STATE], axis=-1)
    xs = xs.reshape(b, l, SSD_HEADS, SSD_HEAD_DIM)
    rep = SSD_HEADS // SSD_GROUPS
    bm = jnp.repeat(bm.reshape(b, l, SSD_GROUPS, SSD_STATE), rep, axis=2)
    cm = jnp.repeat(cm.reshape(b, l, SSD_GROUPS, SSD_STATE), rep, axis=2)
    dt_all = jax.nn.softplus(dt_raw.astype(jnp.float32).reshape(b, l, 2, SSD_HEADS) + dt_bias.astype(jnp.float32))
    a = -jnp.exp(a_log.astype(jnp.float32))
    dtf, dtb = dt_all[:, :, 0], dt_all[:, :, 1]
    yf, ff = ssd_scan(xs * dtf[..., None], dtf * a[0], bm, cm, h0f, need_y)
    yb, fb = ssd_scan((xs * dtb[..., None])[:, ::-1], (dtb * a[1])[:, ::-1], bm[:, ::-1], cm[:, ::-1], h0b, need_y)
    if not need_y:
        return None, ff, fb
    y = yf + yb[:, ::-1] + d_skip.astype(jnp.float32)[:, None] * xs
    y = y.reshape(b, l, SSD_WIDTH) * jax.nn.silu(z.astype(jnp.float32))
    return rmsnorm(y, norm_g).astype(z.dtype), ff, fb


def axial_rope(rows):
    r, col = jnp.meshgrid(jnp.arange(rows, dtype=jnp.float32), jnp.arange(GRID_W, dtype=jnp.float32), indexing='ij')
    per_axis = DA_QK_DIM // 4
    inv = ROPE_BASE ** (-jnp.arange(per_axis, dtype=jnp.float32) / per_axis)
    ang = jnp.concatenate([r.reshape(-1, 1) * inv, col.reshape(-1, 1) * inv], axis=-1)
    return jnp.cos(ang), jnp.sin(ang)


def apply_rope(t, cos, sin):
    tf = t.astype(jnp.float32)
    half = DA_QK_DIM // 2
    t1, t2 = tf[..., :half], tf[..., half:]
    c = cos[:, None, None, :]
    s = sin[:, None, None, :]
    return jnp.concatenate([t1 * c - t2 * s, t2 * c + t1 * s], axis=-1).astype(t.dtype)


def da_qk(t, g, cos, sin):
    b, l, _ = t.shape
    t = rmsnorm(t.reshape(b, l, DA_HEADS, 2, DA_QK_DIM), g)
    if cos is not None:
        t = apply_rope(t, cos, sin)
    return t


def diff_lambda(lam_q, lam_k, lam_init):
    lq = lam_q.astype(jnp.float32)
    lk = lam_k.astype(jnp.float32)
    return jnp.exp(jnp.sum(lq[0] * lk[0])) - jnp.exp(jnp.sum(lq[1] * lk[1])) + lam_init


def diff_block(q, k, v, lam):
    s = jnp.einsum('bqhtd,bkhtd->bhtqk', q, k, preferred_element_type=jnp.float32) * DA_SCALE
    p = jax.nn.softmax(s, axis=-1)
    w = p[:, :, 0] - lam * p[:, :, 1]
    return jnp.einsum('bhqk,bkhe->bqhe', w.astype(v.dtype), v)


def diff_attn_latent(q, k, v, k_ctx, v_ctx, lam):
    b, l = q.shape[:2]
    k_all = jnp.concatenate([k_ctx, k], axis=1)
    v_all = jnp.concatenate([v_ctx, v], axis=1)
    nb = l // Q_BLOCK
    qb = q.reshape(b, nb, Q_BLOCK, DA_HEADS, 2, DA_QK_DIM).swapaxes(0, 1)
    o = lax.map(lambda qi: diff_block(qi, k_all, v_all, lam), qb)
    return o.swapaxes(0, 1).reshape(b, l, DA_HEADS, DA_V_DIM)


def diff_heads_out(o, g, lam_init):
    b, l = o.shape[:2]
    return (rmsnorm(o, g) * (1.0 - lam_init)).reshape(b, l, DA_WIDTH)


def expert_swiglu(xb, wgu, bgu, wd, bd):
    gu = jnp.matmul(xb, wgu) + bgu
    gate, up = gu[..., ::2], gu[..., 1::2]
    gate = jnp.minimum(gate, SWIGLU_LIMIT)
    up = jnp.clip(up, -SWIGLU_LIMIT, SWIGLU_LIMIT)
    glu = gate * jax.nn.sigmoid(SWIGLU_ALPHA * gate)
    return jnp.matmul((up + 1.0) * glu, wd) + bd


def moe_ffn(h, router_w, router_b, w_gu, b_gu, w_down, b_down):
    t, d = h.shape
    n = t * TOP_K
    logits = jnp.matmul(h, router_w, preferred_element_type=jnp.float32) + router_b.astype(jnp.float32)
    top_v, top_e = lax.top_k(logits, TOP_K)
    gates = jax.nn.softmax(top_v, axis=-1)
    flat_e = top_e.reshape(n)
    order = jnp.argsort(flat_e)
    e_sorted = flat_e[order]
    tok_sorted = order // TOP_K
    gate_sorted = gates.reshape(n)[order]
    counts = jnp.bincount(flat_e, length=N_EXPERTS)
    padded = (counts + MOE_BLOCK - 1) // MOE_BLOCK * MOE_BLOCK
    start = jnp.cumsum(counts) - counts
    pend = jnp.cumsum(padded)
    pstart = pend - padded
    dest = pstart[e_sorted] + jnp.arange(n) - start[e_sorted]
    nb = (n + N_EXPERTS * (MOE_BLOCK - 1)) // MOE_BLOCK
    slot_tok = jnp.full((nb * MOE_BLOCK,), t, jnp.int32).at[dest].set(tok_sorted.astype(jnp.int32))
    block_e = jnp.minimum(jnp.searchsorted(pend, jnp.arange(nb) * MOE_BLOCK, side='right'), N_EXPERTS - 1)
    h_pad = jnp.concatenate([h, jnp.zeros((1, d), h.dtype)], axis=0)
    xb = h_pad[slot_tok].reshape(nb, MOE_BLOCK, d)
    yb = lax.map(lambda args: expert_swiglu(args[0], w_gu[args[1]], b_gu[args[1]], w_down[args[1]], b_down[args[1]]), (xb, block_e))
    y = yb.reshape(nb * MOE_BLOCK, d)[dest] * gate_sorted[:, None].astype(h.dtype)
    return jnp.zeros((t, d), h.dtype).at[tok_sorted].add(y)


def setup_inputs(seed: int = 0) -> dict:
    key = jax.random.key(seed)
    ks = iter(jax.random.split(key, 48))
    f32 = jnp.float32

    def nrm(shape, scale):
        return jax.random.normal(next(ks), shape, f32) * scale

    def gain(shape):
        return 1.0 + nrm(shape, 0.02)

    L = DEPTH
    u_lru = jax.random.uniform(next(ks), (L, 2, LRU_WIDTH), f32, 0.9, 0.999)
    a_lru = u_lru ** (1.0 / LRU_C)
    dt0 = jnp.exp(jax.random.uniform(next(ks), (L, 2, SSD_HEADS), f32, math.log(1e-3), math.log(1e-1)))
    return {
        'x': nrm((BATCH, SEQ, D_MODEL), 1.0),
        'c': nrm((BATCH, D_MODEL), 1.0),
        'ctx': nrm((BATCH, CTX_LEN, D_MODEL), 1.0),
        'c_ctx': nrm((D_MODEL,), 1.0),
        'w_mod': nrm((L, D_MODEL, 6 * D_MODEL), D_MODEL ** -0.5),
        'b_mod': nrm((L, 6 * D_MODEL), 0.02),
        'norm1_g': gain((L, D_MODEL)),
        'norm2_g': gain((L, D_MODEL)),
        'w_in': nrm((L, D_MODEL, D_IN), D_MODEL ** -0.5),
        'w_out': nrm((L, D_MIX, D_MODEL), D_MIX ** -0.5),
        'lru_conv_w': nrm((L, SHORT_CONV, LRU_WIDTH), SHORT_CONV ** -0.5),
        'lru_conv_b': nrm((L, LRU_WIDTH), 0.02),
        'lru_wa': nrm((L, 2, LRU_HEADS, LRU_HEAD_DIM, LRU_HEAD_DIM), LRU_HEAD_DIM ** -0.5),
        'lru_ba': nrm((L, 2, LRU_WIDTH), 0.02),
        'lru_wx': nrm((L, 2, LRU_HEADS, LRU_HEAD_DIM, LRU_HEAD_DIM), LRU_HEAD_DIM ** -0.5),
        'lru_bx': nrm((L, 2, LRU_WIDTH), 0.02),
        'lru_lam': jnp.log(a_lru) - jnp.log1p(-a_lru),
        'ssd_conv_w': nrm((L, SHORT_CONV, SSD_CONV_DIM), SHORT_CONV ** -0.5),
        'ssd_conv_b': nrm((L, SSD_CONV_DIM), 0.02),
        'ssd_a_log': jnp.log(jax.random.uniform(next(ks), (L, 2, SSD_HEADS), f32, 1.0, 16.0)),
        'ssd_dt_bias': dt0 + jnp.log(-jnp.expm1(-dt0)),
        'ssd_d': 1.0 + nrm((L, SSD_HEADS), 0.1),
        'ssd_norm_g': gain((L, SSD_WIDTH)),
        'da_q_norm': gain((L, DA_QK_DIM)),
        'da_k_norm': gain((L, DA_QK_DIM)),
        'da_lam_q': nrm((L, 2, DA_QK_DIM), 0.1),
        'da_lam_k': nrm((L, 2, DA_QK_DIM), 0.1),
        'da_subln_g': gain((L, DA_V_DIM)),
        'router_w': nrm((L, D_MODEL, N_EXPERTS), D_MODEL ** -0.5),
        'router_b': nrm((L, N_EXPERTS), 0.01),
        'exp_w_gu': nrm((L, N_EXPERTS, D_MODEL, 2 * D_EXPERT), D_MODEL ** -0.5),
        'exp_b_gu': nrm((L, N_EXPERTS, 2 * D_EXPERT), 0.02),
        'exp_w_down': nrm((L, N_EXPERTS, D_EXPERT, D_MODEL), D_EXPERT ** -0.5),
        'exp_b_down': nrm((L, N_EXPERTS, D_MODEL), 0.02),
    }


def reference(x, c, ctx, c_ctx, w_mod, b_mod, norm1_g, norm2_g, w_in, w_out,
              lru_conv_w, lru_conv_b, lru_wa, lru_ba, lru_wx, lru_bx, lru_lam,
              ssd_conv_w, ssd_conv_b, ssd_a_log, ssd_dt_bias, ssd_d, ssd_norm_g,
              da_q_norm, da_k_norm, da_lam_q, da_lam_k, da_subln_g,
              router_w, router_b, exp_w_gu, exp_b_gu, exp_w_down, exp_b_down):
    b, seq_len, d = x.shape
    ctx_len = ctx.shape[1]
    rows = seq_len // GRID_W
    cos, sin = axial_rope(rows)
    x_lat, x_ctx = x, ctx
    for l in range(DEPTH):
        need_ctx = l < DEPTH - 1
        lam_init = 0.8 - 0.6 * math.exp(-0.3 * l)
        mod = jnp.matmul(jax.nn.silu(c), w_mod[l]) + b_mod[l]
        mod_c = jnp.matmul(jax.nn.silu(c_ctx), w_mod[l]) + b_mod[l]
        sh1, sc1, g1, sh2, sc2, g2 = jnp.split(mod[:, None, :], 6, axis=-1)
        sh1c, sc1c, g1c, sh2c, sc2c, g2c = jnp.split(mod_c, 6, axis=-1)

        h_lat = modulate(rmsnorm(x_lat, norm1_g[l]), sh1, sc1)
        h_ctx = modulate(rmsnorm(x_ctx, norm1_g[l]), sh1c, sc1c)
        lg_l, lx_l, sz_l, sxbc_l, sdt_l, q_l, k_l, v_l = jnp.split(jnp.matmul(h_lat, w_in[l]), IN_SPLITS, axis=-1)
        lg_c, lx_c, sz_c, sxbc_c, sdt_c, q_c, k_c, v_c = jnp.split(jnp.matmul(h_ctx, w_in[l]), IN_SPLITS, axis=-1)

        zl = jnp.zeros((b, LRU_WIDTH), jnp.float32)
        lru_c, lru_sf, lru_sb = lru_mix(lg_c, lx_c, lru_conv_w[l], lru_conv_b[l], lru_wa[l], lru_ba[l],
                                        lru_wx[l], lru_bx[l], lru_lam[l], zl, zl, need_ctx)
        lru_y, _, _ = lru_mix(lg_l, lx_l, lru_conv_w[l], lru_conv_b[l], lru_wa[l], lru_ba[l],
                              lru_wx[l], lru_bx[l], lru_lam[l], lru_sf, lru_sb, True)

        zs = jnp.zeros((b, SSD_HEADS, SSD_HEAD_DIM, SSD_STATE), jnp.float32)
        ssd_c, ssd_sf, ssd_sb = ssd_mix(sz_c, sxbc_c, sdt_c, ssd_conv_w[l], ssd_conv_b[l], ssd_a_log[l],
                                        ssd_dt_bias[l], ssd_d[l], ssd_norm_g[l], zs, zs, need_ctx)
        ssd_y, _, _ = ssd_mix(sz_l, sxbc_l, sdt_l, ssd_conv_w[l], ssd_conv_b[l], ssd_a_log[l],
                              ssd_dt_bias[l], ssd_d[l], ssd_norm_g[l], ssd_sf, ssd_sb, True)

        lam = diff_lambda(da_lam_q[l], da_lam_k[l], lam_init)
        kc = da_qk(k_c, da_k_norm[l], None, None)
        vc = v_c.reshape(b, ctx_len, DA_HEADS, DA_V_DIM)
        ql = da_qk(q_l, da_q_norm[l], cos, sin)
        kl = da_qk(k_l, da_k_norm[l], cos, sin)
        vl = v_l.reshape(b, seq_len, DA_HEADS, DA_V_DIM)
        da_y = diff_heads_out(diff_attn_latent(ql, kl, vl, kc, vc, lam), da_subln_g[l], lam_init)

        o_lat = jnp.matmul(jnp.concatenate([lru_y, ssd_y, da_y], axis=-1), w_out[l])
        if need_ctx:
            qc = da_qk(q_c, da_q_norm[l], None, None)
            da_c = diff_heads_out(diff_block(qc, kc, vc, lam), da_subln_g[l], lam_init)
            o_ctx = jnp.matmul(jnp.concatenate([lru_c, ssd_c, da_c], axis=-1), w_out[l])
            x_ctx = x_ctx + g1c * o_ctx
        x_lat = x_lat + g1 * o_lat

        h2_lat = modulate(rmsnorm(x_lat, norm2_g[l]), sh2, sc2)
        if need_ctx:
            h2_ctx = modulate(rmsnorm(x_ctx, norm2_g[l]), sh2c, sc2c)
            tok = jnp.concatenate([h2_ctx, h2_lat], axis=1).reshape(-1, d)
            f = moe_ffn(tok, router_w[l], router_b[l], exp_w_gu[l], exp_b_gu[l],
                        exp_w_down[l], exp_b_down[l]).reshape(b, ctx_len + seq_len, d)
            x_ctx = x_ctx + g2c * f[:, :ctx_len]
            x_lat = x_lat + g2 * f[:, ctx_len:]
        else:
            f = moe_ffn(h2_lat.reshape(-1, d), router_w[l], router_b[l], exp_w_gu[l], exp_b_gu[l],
                        exp_w_down[l], exp_b_down[l]).reshape(b, seq_len, d)
            x_lat = x_lat + g2 * f
    return x_lat
```

```cpp
#include <hip/hip_runtime.h>
#include <stdint.h>
#include <stdio.h>

#ifndef MK_ONE_LAUNCH
#define MK_ONE_LAUNCH 1
#endif
#ifndef MK_DBG
#define MK_DBG 0
#endif
#ifndef MK_LAST_PHASE
#define MK_LAST_PHASE 19
#endif

#define LAS __attribute__((address_space(3)))
typedef unsigned short bf16_t;
typedef short bf16x8 __attribute__((ext_vector_type(8)));
typedef float f32x4 __attribute__((ext_vector_type(4)));
typedef float f32x2 __attribute__((ext_vector_type(2)));
typedef float f32x16 __attribute__((ext_vector_type(16)));
typedef unsigned u32x4 __attribute__((ext_vector_type(4)));
typedef unsigned u32x2 __attribute__((ext_vector_type(2)));

constexpr int DM = 1024, NBATCH = 8, SEQ = 4096, CTXL = 256, TPB = SEQ + CTXL, NROW = NBATCH * TPB;
constexpr int NPROJ = 3072;
constexpr int C_LG = 0, C_LX = 256, C_SZ = 512, C_XS = 768, C_BM = 1024, C_CM = 1280, C_Q = 1536, C_K = 2048, C_V = 2560;
constexpr int NEXP = 32, DEXP = 1024;
constexpr float EPSN = 1e-6f;
constexpr int LDS_BYTES = 160 * 1024, LDS_MISC = LDS_BYTES - 256;
constexpr int NTHR = 512;

enum { I_X = 0, I_C, I_CTX, I_CCTX, I_WMOD, I_BMOD, I_N1G, I_N2G, I_WIN, I_WOUT, I_LCW, I_LCB, I_LWA, I_LBA, I_LWX, I_LBX, I_LLAM,
       I_SCW, I_SCB, I_SALOG, I_SDTB, I_SD, I_SNG, I_QN, I_KN, I_LAMQ, I_LAMK, I_SUBG, I_RW, I_RB, I_WGU, I_BGU, I_WD, I_BD, N_IN };

constexpr size_t al256(size_t x) { return (x + 255) & ~(size_t)255; }
constexpr size_t WS_BAR = 0;
constexpr size_t WS_DBG = 16384;
constexpr size_t WS_CNT = WS_DBG + 4096;
constexpr size_t WS_ZERO_END = WS_CNT + 1024;
constexpr size_t WS_MOD = al256(WS_ZERO_END);
constexpr size_t WS_WDT = WS_MOD + al256((size_t)2 * 9 * 6144 * 4);
constexpr size_t WS_WIN = WS_WDT + al256((size_t)2 * 8 * 1024 * 4);
constexpr size_t WS_WOUT = WS_WIN + (size_t)2 * NPROJ * 1024 * 2;
constexpr size_t WS_WGU = WS_WOUT + (size_t)2 * 1024 * 1024 * 2;
constexpr size_t WS_WD = WS_WGU + (size_t)2 * 32 * 2048 * 1024 * 2;
constexpr size_t WS_XRES = WS_WD + (size_t)2 * 32 * 1024 * 1024 * 2;
constexpr size_t WS_H = WS_XRES + (size_t)NROW * 1024 * 4;
constexpr size_t WS_DTRAW = WS_H + (size_t)NROW * 1024 * 2;
constexpr size_t WS_PROJ = WS_DTRAW + al256((size_t)NROW * 8 * 4);
constexpr size_t WS_QB = WS_PROJ + (size_t)NROW * NPROJ * 2;
constexpr size_t WS_KB = WS_QB + (size_t)NROW * 512 * 2;
constexpr size_t WS_VT = WS_KB + (size_t)NROW * 512 * 2;
constexpr size_t WS_ACT = WS_PROJ;
constexpr size_t WS_YMIX = WS_VT + (size_t)NROW * 512 * 2;
constexpr size_t WS_LRUS = WS_YMIX + (size_t)NROW * 1024 * 2;
constexpr size_t WS_LRUC = WS_LRUS + (size_t)8 * 136 * 2 * 256 * 8;
constexpr size_t WS_SSDS = WS_LRUC + (size_t)8 * 136 * 2 * 256 * 4;
constexpr size_t WS_SSDI = WS_SSDS + (size_t)8 * 34 * 8 * 8192 * 4;
constexpr size_t WS_SSDD = WS_SSDI + (size_t)8 * 34 * 8 * 8192 * 2;
constexpr size_t WS_TOKG = WS_SSDD + al256((size_t)8 * 34 * 8 * 4);
constexpr size_t WS_TOKE = WS_TOKG + (size_t)NROW * 4 * 4;
constexpr size_t WS_LIST = WS_TOKE + (size_t)NROW * 4 * 4;
constexpr size_t WS_YSLOT = WS_LIST + (size_t)NEXP * NROW * 4;
constexpr size_t WS_YPRE = WS_YSLOT + (size_t)NROW * 4 * 1024 * 2;
constexpr size_t WS_END = WS_YPRE + (size_t)NROW * 256 * 4;
static_assert((size_t)576 * 256 * 1024 * 2 <= WS_YMIX - WS_PROJ, "act alias");
static_assert(WS_END < (size_t)2000 * 1024 * 1024, "workspace");

struct Args { const float* in[N_IN]; float* out; unsigned char* ws; int lo, hi; };

#define XB_TMO      128
#define XB_XCNT(j)  (256  + 64 * (j))
#define XB_XSUB(j)  (1280 + 64 * (j))
#define XB_XGEN(j)  (2304 + 64 * (j))
#define XB_TOP      3328
#define XB_TOPGEN   3392
#define XCD_BAR_WORDS 3456
#define XB_SPIN_CAP (1u << 18)
__device__ __forceinline__ unsigned xb_ld(unsigned* p)              { return __hip_atomic_load(p, __ATOMIC_RELAXED, __HIP_MEMORY_SCOPE_AGENT); }
__device__ __forceinline__ unsigned xb_add(unsigned* p, unsigned v) { return __hip_atomic_fetch_add(p, v, __ATOMIC_RELAXED, __HIP_MEMORY_SCOPE_AGENT); }
__device__ __forceinline__ unsigned xb_xcc_id() { return (unsigned)__builtin_amdgcn_s_getreg((3 << 11) | 20) & 0xFu; }
#define XB_SPIN(cond, bar) do { unsigned _sp = 0; while (cond) { __builtin_amdgcn_s_sleep(1); \
    if ((++_sp & 255u) == 0u) { if (xb_ld(&(bar)[XB_TMO])) break; if (_sp > XB_SPIN_CAP) { atomicAdd(&(bar)[XB_TMO], 1u); break; } } } } while (0)
struct XcdBarrier { unsigned* bar; unsigned x; volatile LAS unsigned* st; };
__device__ __forceinline__ XcdBarrier xcd_barrier_post(unsigned* bar, volatile LAS unsigned* st) {
    XcdBarrier b; b.bar = bar; b.x = xb_xcc_id(); b.st = st;
    if (threadIdx.x == 0) (void)xb_add(&bar[XB_XCNT(b.x)], 1u);
    return b;
}
__device__ __forceinline__ void xcd_barrier_complete(unsigned* bar, unsigned x, unsigned& nloc, unsigned& nx) {
    const unsigned G = gridDim.x * gridDim.y * gridDim.z;
    unsigned sum, cnt, mine, sp = 0u;
    for (;;) {
        sum = 0u; cnt = 0u; mine = 0u;
#pragma unroll
        for (unsigned j = 0; j < 16; ++j) { const unsigned c = xb_ld(&bar[XB_XCNT(j)]); sum += c; cnt += (c > 0u) ? 1u : 0u; mine = (j == x) ? c : mine; }
        if (sum == G) break;
        __builtin_amdgcn_s_sleep(1);
        if ((++sp & 255u) == 0u) { if (xb_ld(&bar[XB_TMO])) break; if (sp > XB_SPIN_CAP) { atomicAdd(&bar[XB_TMO], 1u); break; } }
    }
    nloc = mine > 0u ? mine : 1u; nx = cnt > 0u ? cnt : 1u;
}
__device__ __forceinline__ void xcd_barrier(const XcdBarrier& b) {
    asm volatile("s_waitcnt vmcnt(0)" ::: "memory");
    __syncthreads();
    if (threadIdx.x == 0) {
        unsigned* bar = b.bar;
        __builtin_amdgcn_s_waitcnt(0);
        unsigned nloc = b.st[0], nx = b.st[1];
        if (nloc == 0u) { xcd_barrier_complete(bar, b.x, nloc, nx); b.st[0] = nloc; b.st[1] = nx; }
        const unsigned old = xb_add(&bar[XB_XSUB(b.x)], 1u);
        const unsigned gen = old / nloc;
        if (old + 1u == (gen + 1u) * nloc) {
            __builtin_amdgcn_fence(__ATOMIC_RELEASE, "agent");
            asm volatile("s_waitcnt vmcnt(0)" ::: "memory");
            const unsigned og = xb_add(&bar[XB_TOP], 1u);
            const unsigned tg = og / nx;
            if (og + 1u == (tg + 1u) * nx) xb_add(&bar[XB_TOPGEN], 1u);
            else XB_SPIN(xb_ld(&bar[XB_TOPGEN]) == tg, bar);
            __builtin_amdgcn_fence(__ATOMIC_ACQUIRE, "agent");
            xb_add(&bar[XB_XGEN(b.x)], 1u);
            asm volatile("s_waitcnt vmcnt(0)" ::: "memory");
        } else {
            XB_SPIN(xb_ld(&bar[XB_XGEN(b.x)]) == gen, bar);
            __builtin_amdgcn_fence(__ATOMIC_ACQUIRE, "agent");
            asm volatile("s_waitcnt vmcnt(0)" ::: "memory");
        }
    }
    __syncthreads();
}

__device__ __forceinline__ unsigned cvt_pk_bf16(float lo, float hi) { unsigned r; asm("v_cvt_pk_bf16_f32 %0, %1, %2" : "=v"(r) : "v"(lo), "v"(hi)); return r; }
__device__ __forceinline__ bf16_t f2bf(float f) { return (bf16_t)(cvt_pk_bf16(f, 0.f) & 0xffffu); }
__device__ __forceinline__ float bf2f(bf16_t b) { return __uint_as_float(((unsigned)b) << 16); }
__device__ __forceinline__ float bflo(unsigned w) { return __uint_as_float(w << 16); }
__device__ __forceinline__ float bfhi(unsigned w) { return __uint_as_float(w & 0xffff0000u); }
__device__ __forceinline__ float wave_sum(float v) {
#pragma unroll
    for (int o = 32; o >= 1; o >>= 1) v += __shfl_xor(v, o);
    return v;
}
__device__ __forceinline__ float sigmoidf_(float x) { return 1.0f / (1.0f + __expf(-x)); }
__device__ __forceinline__ float siluf_(float x) { return x / (1.0f + __expf(-x)); }
__device__ __forceinline__ float log1p_fast(float t) { return t < 0.01f ? t * (1.0f + t * (-0.5f + t * (1.0f / 3.0f))) : __logf(1.0f + t); }
__device__ __forceinline__ float softplusf_(float x) { return fmaxf(x, 0.f) + log1p_fast(__expf(-fabsf(x))); }
__device__ __forceinline__ float one_minus_exp(float x) { return x > -0.05f ? -x * (1.0f + x * (0.5f + x * (1.0f / 6.0f + x * (1.0f / 24.0f)))) : 1.0f - __expf(x); }
__device__ __forceinline__ float tanh_fast(float x) { const float e = __expf(2.0f * fminf(x, 15.f)); return 1.0f - 2.0f / (e + 1.0f); }

struct Frame {
    const float* const* in; float* out; unsigned char* ws; LAS unsigned char* lds;
    int tid, lane, wid, G, bx;
    const float* const* in0; unsigned char* ws0;
    __device__ __forceinline__ void refresh() { int t = threadIdx.x; asm volatile("" : "+v"(t)); tid = t; lane = t & 63; wid = __builtin_amdgcn_readfirstlane(t >> 6);
        unsigned long long z; asm volatile("s_mov_b64 %0, 0" : "=s"(z)); in = (const float* const*)((const char*)in0 + z); ws = ws0 + z; }
};
__device__ __forceinline__ int row_mrow(int r) { const int b = r / TPB, pos = r - b * TPB; return pos < CTXL ? 8 : b; }
__device__ __forceinline__ const float* row_input(const Frame& F, int r) {
    const int b = r / TPB, pos = r - b * TPB;
    return pos < CTXL ? F.in[I_CTX] + ((size_t)b * CTXL + pos) * DM : F.in[I_X] + ((size_t)b * SEQ + (pos - CTXL)) * DM;
}

__device__ __forceinline__ void cvt_block(const Frame& F, const float* src, int ld, int k0, int c0, bf16_t* dst, int mode, int d0) {
    LAS float* tile = (LAS float*)F.lds;
    const int tid = F.tid;
#pragma unroll
    for (int i = 0; i < 4; ++i) {
        const int r = (tid >> 5) + 16 * i, c4 = (tid & 31) * 4;
        const f32x4 v = *(const f32x4*)(src + (size_t)(k0 + r) * ld + c0 + c4);
        *(LAS f32x4*)(tile + r * 132 + c4) = v;
    }
    __syncthreads();
    const int nl = tid >> 2, kq = tid & 3;
    int csrc, rho;
    if (mode == 1) { const int half = nl >> 6, jj = nl & 63, a0 = c0 >> 1; csrc = 2 * jj + half; rho = (a0 >> 7) * 256 + half * 128 + (a0 & 127) + jj; }
    else { csrc = nl; rho = d0 + nl; }
    unsigned w[8];
#pragma unroll
    for (int j = 0; j < 8; ++j) w[j] = cvt_pk_bf16(tile[(kq * 16 + 2 * j) * 132 + csrc], tile[(kq * 16 + 2 * j + 1) * 132 + csrc]);
    bf16_t* dp = dst + (size_t)rho * 1024 + k0 + kq * 16;
    *(u32x4*)dp = (u32x4){w[0], w[1], w[2], w[3]};
    *(u32x4*)(dp + 8) = (u32x4){w[4], w[5], w[6], w[7]};
    __syncthreads();
}
__device__ __forceinline__ void mod_unit(const Frame& F, int l, int jb) {
    LAS float* sm = (LAS float*)F.lds;
    LAS float* red = sm + 9 * 1024;
    const int tid = F.tid;
    for (int idx = tid; idx < 9 * 1024; idx += NTHR) { const int r = idx >> 10, k = idx & 1023; const float v = r < 8 ? F.in[I_C][r * 1024 + k] : F.in[I_CCTX][k]; sm[idx] = siluf_(v); }
    __syncthreads();
    const int kg = tid >> 6, jj = tid & 63, j = jb * 64 + jj;
    float acc[9];
#pragma unroll
    for (int r = 0; r < 9; ++r) acc[r] = 0.f;
    const float* wp = F.in[I_WMOD] + (size_t)l * 1024 * 6144 + j;
#pragma unroll 8
    for (int k = kg * 128; k < kg * 128 + 128; ++k) {
        const float w = wp[(size_t)k * 6144];
#pragma unroll
        for (int r = 0; r < 9; ++r) acc[r] += sm[r * 1024 + k] * w;
    }
#pragma unroll
    for (int r = 0; r < 9; ++r) red[(kg * 9 + r) * 64 + jj] = acc[r];
    __syncthreads();
    float* mod = (float*)(F.ws + WS_MOD);
    for (int idx = tid; idx < 576; idx += NTHR) {
        const int r = idx >> 6, j2 = idx & 63; float s = 0.f;
#pragma unroll
        for (int g = 0; g < 8; ++g) s += red[(g * 9 + r) * 64 + j2];
        mod[(size_t)(l * 9 + r) * 6144 + jb * 64 + j2] = s + F.in[I_BMOD][l * 6144 + jb * 64 + j2];
    }
    __syncthreads();
}
__device__ __forceinline__ void p0_prologue(const Frame& F) {
    { float* wdt = (float*)(F.ws + WS_WDT);
      for (int i = F.bx * NTHR + F.tid; i < 2 * 8 * 1024; i += F.G * NTHR) { const int l = i >> 13, j = (i >> 10) & 7, k = i & 1023; wdt[i] = F.in[I_WIN][((size_t)l * 1024 + k) * 3080 + 1536 + j]; } }
    constexpr int NMOD = 192, PER_L = 384 + 128 + 8192 + 4096;
    for (int u = F.bx; u < NMOD + 2 * PER_L; u += F.G) {
        if (u < NMOD) { mod_unit(F, u / 96, u % 96); continue; }
        int r = u - NMOD; const int l = r / PER_L; r -= l * PER_L;
        if (r < 384) { const int tk = r / 24, tn = r % 24, d0 = tn * 128, c0 = d0 < 1536 ? d0 : d0 + 8;
            cvt_block(F, F.in[I_WIN] + (size_t)l * 1024 * 3080, 3080, tk * 64, c0, (bf16_t*)(F.ws + WS_WIN) + (size_t)l * NPROJ * 1024, 0, d0); }
        else if (r < 512) { r -= 384; const int tk = r / 8, tn = r % 8;
            cvt_block(F, F.in[I_WOUT] + (size_t)l * 1024 * 1024, 1024, tk * 64, tn * 128, (bf16_t*)(F.ws + WS_WOUT) + (size_t)l * 1024 * 1024, 0, tn * 128); }
        else if (r < 512 + 8192) { r -= 512; const int e = r >> 8, rr = r & 255, tk = rr >> 4, tn = rr & 15;
            cvt_block(F, F.in[I_WGU] + ((size_t)l * 32 + e) * 1024 * 2048, 2048, tk * 64, tn * 128, (bf16_t*)(F.ws + WS_WGU) + ((size_t)l * 32 + e) * 2048 * 1024, 1, 0); }
        else { r -= 512 + 8192; const int e = r >> 7, rr = r & 127, tk = rr >> 3, tn = rr & 7;
            cvt_block(F, F.in[I_WD] + ((size_t)l * 32 + e) * 1024 * 1024, 1024, tk * 64, tn * 128, (bf16_t*)(F.ws + WS_WD) + ((size_t)l * 32 + e) * 1024 * 1024, 0, tn * 128); }
    }
}

__device__ __forceinline__ void load_row_x(const Frame& F, int l, int row, f32x4 (&x)[4]) {
    const int lane = F.lane;
    if (l == 0) { const float* p = row_input(F, row);
#pragma unroll
        for (int i = 0; i < 4; ++i) x[i] = *(const f32x4*)(p + lane * 4 + 256 * i);
    } else {
        const float* p = (const float*)(F.ws + WS_XRES) + (size_t)row * DM;
        const float* g2 = (const float*)(F.ws + WS_MOD) + (size_t)((l - 1) * 9 + row_mrow(row)) * 6144 + 5 * 1024;
        const bf16_t* ys = (const bf16_t*)(F.ws + WS_YSLOT) + (size_t)row * 4 * DM;
#pragma unroll
        for (int i = 0; i < 4; ++i) {
            const int c = lane * 4 + 256 * i; f32x4 s = (f32x4){0.f, 0.f, 0.f, 0.f};
#pragma unroll
            for (int k = 0; k < 4; ++k) { const u32x2 w = *(const u32x2*)(ys + (size_t)k * DM + c); s += (f32x4){bflo(w.x), bfhi(w.x), bflo(w.y), bfhi(w.y)}; }
            x[i] = *(const f32x4*)(p + c) + *(const f32x4*)(g2 + c) * s;
        }
    }
}
__device__ __forceinline__ void p_norm1(const Frame& F, int l) {
    LAS float* wdt = (LAS float*)F.lds;
    { const float* src = (const float*)(F.ws + WS_WDT) + (size_t)l * 8192; for (int i = F.tid; i < 8192; i += NTHR) wdt[i] = src[i]; }
    __syncthreads();
    const int lane = F.lane;
    const float* ng = F.in[I_N1G] + l * DM;
    f32x4 g[4];
#pragma unroll
    for (int i = 0; i < 4; ++i) g[i] = *(const f32x4*)(ng + lane * 4 + 256 * i);
    for (int row = F.bx * 8 + F.wid; row < NROW; row += F.G * 8) {
        f32x4 x[4]; load_row_x(F, l, row, x);
        float* xr = (float*)(F.ws + WS_XRES) + (size_t)row * DM;
        float ss = 0.f;
#pragma unroll
        for (int i = 0; i < 4; ++i) { *(f32x4*)(xr + lane * 4 + 256 * i) = x[i]; ss += x[i][0] * x[i][0] + x[i][1] * x[i][1] + x[i][2] * x[i][2] + x[i][3] * x[i][3]; }
        ss = wave_sum(ss);
        const float rstd = 1.0f / sqrtf(ss * (1.0f / DM) + EPSN);
        const float* mod = (const float*)(F.ws + WS_MOD) + (size_t)(l * 9 + row_mrow(row)) * 6144;
        bf16_t* hp = (bf16_t*)(F.ws + WS_H) + (size_t)row * DM;
        float dt[8];
#pragma unroll
        for (int j = 0; j < 8; ++j) dt[j] = 0.f;
#pragma unroll
        for (int i = 0; i < 4; ++i) {
            const int c = lane * 4 + 256 * i;
            const f32x4 sh = *(const f32x4*)(mod + c), sc = *(const f32x4*)(mod + 1024 + c);
            const f32x4 h = x[i] * rstd * g[i] * (sc + 1.0f) + sh;
            *(u32x2*)(hp + c) = (u32x2){cvt_pk_bf16(h[0], h[1]), cvt_pk_bf16(h[2], h[3])};
#pragma unroll
            for (int j = 0; j < 8; ++j) { const f32x4 w = *(LAS f32x4*)(wdt + j * 1024 + c); dt[j] += h[0] * w[0] + h[1] * w[1] + h[2] * w[2] + h[3] * w[3]; }
        }
#pragma unroll
        for (int j = 0; j < 8; ++j) dt[j] = wave_sum(dt[j]);
        if (lane == 0) { float* dp = (float*)(F.ws + WS_DTRAW) + (size_t)row * 8;
            *(f32x4*)dp = (f32x4){dt[0], dt[1], dt[2], dt[3]}; *(f32x4*)(dp + 4) = (f32x4){dt[4], dt[5], dt[6], dt[7]}; }
    }
    __syncthreads();
}

namespace gm {
constexpr int BM = 256, BK = 64, HALF = 128, HTB = HALF * BK * 2, STAGE_BYTES = 8 * HTB;
__device__ __forceinline__ int lds_byte(int r, int c) { const int st = (r >> 4) * 2 + (c >> 5), rr = r & 15, cc = c & 31, ob = rr * 64 + cc * 2; return st * 1024 + (ob ^ (((ob >> 9) & 1) << 5)); }
__device__ __forceinline__ void stage_rc(int b, int& R, int& C) { const int st = b / 1024, sb = b % 1024, swz = sb ^ (((sb >> 9) & 1) << 5); R = (st >> 1) * 16 + swz / 64; C = (st & 1) * 32 + (swz % 64) / 2; }
__device__ __forceinline__ int perm32(int rho) { const int n = rho >> 4, i = rho & 15; return 8 * (i >> 2) + 4 * n + (i & 3); }
struct GU { int m0, nrows, pn, e, rbg; const char* bptr; };

template <bool PERM, bool GATHER, class Sched, class Epi>
__device__ __forceinline__ void gemm_phase(LAS unsigned char* lds, const char* Abase, const Sched& S, const Epi& E) {
    constexpr int K = 1024, nt = K / BK;
    constexpr size_t kstep = (size_t)(BK * 2), hstep = (size_t)HALF * K * 2;
    int tid = threadIdx.x; asm volatile("" : "+v"(tid));
    const int wid = __builtin_amdgcn_readfirstlane(tid >> 6), lane = tid & 63, wr = wid >> 2, wc = wid & 3, fr = lane & 15, fq = lane >> 4;
    unsigned voffB[2], voffA[2];
#pragma unroll
    for (int i = 0; i < 2; ++i) { int R, C; stage_rc(tid * 16 + i * 8192, R, C); const int Rb = PERM ? ((R & ~31) + perm32(R & 31)) : R; voffB[i] = (unsigned)(Rb * K + C) * 2u;
        voffA[i] = GATHER ? (unsigned)C * 2u : (unsigned)(R * K + C) * 2u; }
    const unsigned ldsw = (unsigned)wid * 1024u;
    const int aoff = lds_byte(wr * 64 + fr, fq * 8), boff = lds_byte(wc * 32 + fr, fq * 8);
#define GM_SA(b, h) (((b) * 2 + (h)) * HTB)
#define GM_SB(b, h) ((4 + (b) * 2 + (h)) * HTB)
#define GM_STAGE(bufoff, gbase, voff) do { _Pragma("unroll") for (int _i = 0; _i < 2; ++_i) \
        __builtin_amdgcn_global_load_lds((const unsigned*)((const char*)(gbase) + (voff)[_i]), (LAS unsigned*)(lds + (bufoff) + ldsw + _i * 8192), 16, 0, 0); } while (0)
#define GM_STAGE_A(bufoff, ub, pk, h, ko) do { _Pragma("unroll") for (int _i = 0; _i < 2; ++_i) { \
        const char* _p = GATHER ? (Abase + (ko) + (size_t)((((pk)[_i] >> (16 * (h))) & 0xffffu) * (unsigned)(K * 2) + voffA[_i])) : ((ub) + (ko) + (size_t)(h) * hstep + voffA[_i]); \
        __builtin_amdgcn_global_load_lds((const unsigned*)_p, (LAS unsigned*)(lds + (bufoff) + ldsw + _i * 8192), 16, 0, 0); } } while (0)
#define GM_LDA(dst, b, h) do { _Pragma("unroll") for (int m = 0; m < 4; ++m) _Pragma("unroll") for (int k = 0; k < 2; ++k) dst[m][k] = *(const LAS bf16x8*)(lds + GM_SA(b, h) + aoff + m * 2048 + k * 1024); } while (0)
#define GM_LDB(dst, b, h) do { _Pragma("unroll") for (int n = 0; n < 2; ++n) _Pragma("unroll") for (int k = 0; k < 2; ++k) dst[n][k] = *(const LAS bf16x8*)(lds + GM_SB(b, h) + boff + n * 2048 + k * 1024); } while (0)
#define GM_MMA(ai, bj, At, Bt) do { __builtin_amdgcn_s_setprio(1); _Pragma("unroll") for (int m = 0; m < 4; ++m) _Pragma("unroll") for (int n = 0; n < 2; ++n) _Pragma("unroll") for (int k = 0; k < 2; ++k) \
        acc[ai][bj][m][n] = __builtin_amdgcn_mfma_f32_16x16x32_bf16(Bt[n][k], At[m][k], acc[ai][bj][m][n], 0, 0, 0); __builtin_amdgcn_s_setprio(0); } while (0)
#define GM_WAIT_V(n) asm volatile("s_waitcnt vmcnt(" #n ")" ::: "memory")
#define GM_WAIT_L(n) asm volatile("s_waitcnt lgkmcnt(" #n ")" ::: "memory")
#define GM_BAR __builtin_amdgcn_s_barrier()
#define GM_SCHED __builtin_amdgcn_sched_barrier(0)
#define GM_MKA(u, pk) do { if (GATHER) { _Pragma("unroll") for (int _i = 0; _i < 2; ++_i) { int R_, C_; stage_rc(tid * 16 + _i * 8192, R_, C_); \
        pk[_i] = S.arow(u, R_) | (S.arow(u, HALF + R_) << 16); } } } while (0)
#define GM_KITER(U1, P1, KO1, U2, P2, KO2, B2) do { \
            GM_LDB(B0, 0, 0); GM_SCHED; GM_LDA(At, 0, 0); GM_STAGE_A(GM_SA(1, 1), U1, P1, 1, KO1); \
            GM_WAIT_L(8); GM_BAR; GM_WAIT_L(0); GM_MMA(0, 0, At, B0); GM_BAR; GM_SCHED; \
            GM_LDB(B1, 0, 1); GM_STAGE(GM_SB(0, 0), B2, voffB); \
            GM_BAR; GM_WAIT_L(0); GM_MMA(0, 1, At, B1); GM_BAR; \
            GM_LDA(At, 0, 1); GM_STAGE_A(GM_SA(0, 0), U2, P2, 0, KO2); \
            GM_BAR; GM_WAIT_L(0); GM_MMA(1, 0, At, B0); GM_BAR; GM_SCHED; \
            GM_STAGE(GM_SB(0, 1), (B2) + hstep, voffB); \
            GM_WAIT_V(6); GM_BAR; GM_MMA(1, 1, At, B1); GM_BAR; \
            GM_LDB(B0, 1, 0); GM_SCHED; GM_LDA(At, 1, 0); GM_STAGE_A(GM_SA(0, 1), U2, P2, 1, KO2); \
            GM_WAIT_L(8); GM_BAR; GM_WAIT_L(0); GM_MMA(0, 0, At, B0); GM_BAR; GM_SCHED; \
            GM_LDB(B1, 1, 1); GM_STAGE(GM_SB(1, 0), (B2) + kstep, voffB); \
            GM_BAR; GM_WAIT_L(0); GM_MMA(0, 1, At, B1); GM_BAR; \
            GM_LDA(At, 1, 1); GM_STAGE_A(GM_SA(1, 0), U2, P2, 0, (KO2) + kstep); \
            GM_BAR; GM_WAIT_L(0); GM_MMA(1, 0, At, B0); GM_BAR; GM_SCHED; \
            GM_STAGE(GM_SB(1, 1), (B2) + kstep + hstep, voffB); \
            GM_WAIT_V(6); GM_BAR; GM_MMA(1, 1, At, B1); GM_BAR; } while (0)
    GU cur, nxt; int ui = 0;
    if (!S.next(0, cur)) return;
    f32x4 acc[2][2][4][2];
    bf16x8 At[4][2], B0[2][2], B1[2][2];
    unsigned cP[2] = {0u, 0u}, nP[2] = {0u, 0u};
    GM_MKA(cur, cP);
    const char* cB = cur.bptr;
    const char* cU = Abase + (size_t)cur.m0 * (K * 2);
    GM_STAGE(GM_SB(0, 0), cB, voffB); GM_STAGE_A(GM_SA(0, 0), cU, cP, 0, 0); GM_STAGE(GM_SB(0, 1), cB + hstep, voffB); GM_STAGE_A(GM_SA(0, 1), cU, cP, 1, 0);
    if (wr == 1) GM_BAR;
    GM_WAIT_V(4); GM_BAR;
    GM_STAGE(GM_SB(1, 0), cB + kstep, voffB); GM_STAGE_A(GM_SA(1, 0), cU, cP, 0, kstep); GM_STAGE(GM_SB(1, 1), cB + hstep + kstep, voffB);
    GM_WAIT_V(6); GM_BAR;
    GM_SCHED;
#pragma unroll
    for (int a = 0; a < 2; ++a)
#pragma unroll
        for (int b = 0; b < 2; ++b)
#pragma unroll
            for (int m = 0; m < 4; ++m)
#pragma unroll
                for (int n = 0; n < 2; ++n) acc[a][b][m][n] = (f32x4){0.f, 0.f, 0.f, 0.f};
    for (;;) {
        const bool has_next = S.next(ui + 1, nxt);
        if (has_next) { GM_MKA(nxt, nP); } else { nP[0] = cP[0]; nP[1] = cP[1]; nxt = cur; }
        const char* nB = nxt.bptr;
        const char* nU = Abase + (size_t)nxt.m0 * (K * 2);
        for (int t = 0; t < nt - 2; t += 2) {
            const size_t ko1 = (size_t)(t + 1) * kstep, ko2 = (size_t)(t + 2) * kstep;
            const char* b2 = cB + ko2;
            GM_KITER(cU, cP, ko1, cU, cP, ko2, b2);
        }
        GM_KITER(cU, cP, (size_t)(nt - 1) * kstep, nU, nP, (size_t)0, nB);
        { int tz = tid; asm volatile("" : "+v"(tz)); E(acc, cur, tz); }
        if (!has_next) break;
#pragma unroll
        for (int a = 0; a < 2; ++a)
#pragma unroll
            for (int b = 0; b < 2; ++b)
#pragma unroll
                for (int m = 0; m < 4; ++m)
#pragma unroll
                    for (int n = 0; n < 2; ++n) acc[a][b][m][n] = (f32x4){0.f, 0.f, 0.f, 0.f};
        cur = nxt; cB = nB; cU = nU; cP[0] = nP[0]; cP[1] = nP[1]; ++ui;
    }
    GM_WAIT_V(0);
    if (wr == 0) GM_BAR;
    GM_BAR;
#undef GM_SA
#undef GM_SB
#undef GM_STAGE
#undef GM_STAGE_A
#undef GM_LDA
#undef GM_LDB
#undef GM_MMA
#undef GM_WAIT_V
#undef GM_WAIT_L
#undef GM_BAR
#undef GM_SCHED
#undef GM_MKA
#undef GM_KITER
}

struct DenseSched {
    int nrb, npn, x, j, wpx; const char* Bt; size_t btile; int skipctx;
    __device__ __forceinline__ bool next(int i, GU& u) const {
        const int v = i * wpx + j, rbl = v / npn; int rb;
        if (skipctx) { const int q = rbl * 8 + x; rb = q + q / 16 + 1; } else rb = rbl * 8 + x;
        if (rb >= nrb) return false;
        u.pn = v - rbl * npn; u.m0 = rb * BM; u.nrows = BM; u.e = 0; u.rbg = rb; u.bptr = Bt + (size_t)u.pn * btile; return true;
    }
    __device__ __forceinline__ unsigned arow(const GU& u, int r) const { return (unsigned)(u.m0 + r); }
};
}

struct EpiProj {
    bf16_t* O;
    __device__ __forceinline__ void operator()(const f32x4 (&acc)[2][2][4][2], const gm::GU& u, int tz) const {
        const int wid = tz >> 6, lane = tz & 63, wr = wid >> 2, wc = wid & 3, fr = lane & 15, fq = lane >> 4;
        const int row0 = u.m0 + wr * 64 + fr, col0 = u.pn * 256 + wc * 32 + 8 * fq;
#pragma unroll
        for (int ai = 0; ai < 2; ++ai)
#pragma unroll
            for (int m = 0; m < 4; ++m) { bf16_t* rowp = O + (size_t)(row0 + ai * 128 + m * 16) * NPROJ + col0;
#pragma unroll
                for (int bj = 0; bj < 2; ++bj) { const f32x4 v0 = acc[ai][bj][m][0], v1 = acc[ai][bj][m][1];
                    *(u32x4*)(rowp + bj * 128) = (u32x4){cvt_pk_bf16(v0[0], v0[1]), cvt_pk_bf16(v0[2], v0[3]), cvt_pk_bf16(v1[0], v1[1]), cvt_pk_bf16(v1[2], v1[3])}; } }
    }
};
__device__ __forceinline__ void p_inproj(const Frame& F, int l) {
    gm::DenseSched S; S.nrb = NROW / 256; S.npn = NPROJ / 256; S.x = F.bx & 7; S.j = F.bx >> 3; S.wpx = F.G >> 3;
    S.Bt = (const char*)(F.ws + WS_WIN) + (size_t)l * NPROJ * 1024 * 2; S.btile = (size_t)256 * 1024 * 2; S.skipctx = 0;
    EpiProj E{(bf16_t*)(F.ws + WS_PROJ)};
    gm::gemm_phase<true, false>(F.lds, (const char*)(F.ws + WS_H), S, E);
}

constexpr float QSCALE = 0.125f * 1.4426950408889634f;
__device__ __forceinline__ void c1_setup(const Frame& F, LAS float* tab) {
    for (int idx = F.tid; idx < 1024; idx += NTHR) { const int p = idx >> 4, i = idx & 15; const float inv = exp2f(-(float)i * (13.287712379549449f / 16.0f));
        const float xa = (float)p * inv, k = rintf(xa * 0.15915494309189535f);
        float rr = __builtin_fmaf(-k, 6.28125f, xa); rr = __builtin_fmaf(-k, 1.9353071795864769e-3f, rr);
        tab[2 * idx] = __cosf(rr); tab[2 * idx + 1] = __sinf(rr); }
    __syncthreads();
}
__device__ __forceinline__ void c1_unit(const Frame& F, int l, int u, const LAS float* tab) {
    const int b = u / 68, pos0 = (u - b * 68) * 64, row0 = b * TPB + pos0;
    const bf16_t* proj = (const bf16_t*)(F.ws + WS_PROJ);
    LAS bf16_t* vt = (LAS bf16_t*)(F.lds + 8192);
#pragma unroll
    for (int j = 0; j < 8; ++j) { const int p = F.tid + NTHR * j, r = p >> 6, c8 = (p & 63) * 8;
        *(LAS u32x4*)(vt + r * 520 + c8) = *(const u32x4*)(proj + (size_t)(row0 + r) * NPROJ + C_V + c8); }
    const int hw = F.tid >> 5, i = F.tid & 31;
    const bool lat = pos0 >= CTXL;
    for (int it = 0; it < 64; ++it) {
        const int item = it * 16 + hw, rl = item >> 4, which = (item >> 3) & 1, h = (item >> 1) & 3, sub = item & 1;
        const bf16_t* src = proj + (size_t)(row0 + rl) * NPROJ + (which ? C_K : C_Q) + h * 128 + sub * 64;
        const float t1 = bf2f(src[i]), t2 = bf2f(src[i + 32]);
        float ss = t1 * t1 + t2 * t2;
#pragma unroll
        for (int o = 16; o >= 1; o >>= 1) ss += __shfl_xor(ss, o);
        const float rstd = 1.0f / sqrtf(ss * (1.0f / 64.0f) + EPSN);
        const float* g = F.in[which ? I_KN : I_QN] + l * 64;
        float n1 = t1 * rstd * g[i], n2 = t2 * rstd * g[i + 32];
        if (lat) { const int tp = pos0 + rl - CTXL, pp = (i < 16) ? (tp >> 6) : (tp & 63); const float cs = tab[2 * (pp * 16 + (i & 15))], sn = tab[2 * (pp * 16 + (i & 15)) + 1];
            const float o1 = n1 * cs - n2 * sn, o2 = n2 * cs + n1 * sn; n1 = o1; n2 = o2; }
        if (!which) { n1 *= QSCALE; n2 *= QSCALE; }
        bf16_t* dst = (bf16_t*)(F.ws + (which ? WS_KB : WS_QB)) + ((size_t)((b * 4 + h) * 2 + sub) * TPB + pos0 + rl) * 64;
        dst[i] = f2bf(n1); dst[i + 32] = f2bf(n2);
    }
    __syncthreads();
    { const int t = F.tid, h = t >> 7, dv = t & 127;
      bf16_t* dst = (bf16_t*)(F.ws + WS_VT) + ((size_t)((b * 4 + h) * 128 + dv)) * TPB + pos0;
#pragma unroll
      for (int g = 0; g < 4; ++g) { unsigned w[8];
#pragma unroll
          for (int pp = 0; pp < 16; pp += 2) { const int k0 = 16 * g + 8 * ((pp & 7) >> 2) + 4 * (pp >> 3) + (pp & 3);
              w[pp >> 1] = (unsigned)vt[k0 * 520 + t] | ((unsigned)vt[(k0 + 1) * 520 + t] << 16); }
          *(u32x4*)(dst + 16 * g) = (u32x4){w[0], w[1], w[2], w[3]}; *(u32x4*)(dst + 16 * g + 8) = (u32x4){w[4], w[5], w[6], w[7]}; } }
    __syncthreads();
}

__device__ __forceinline__ int crow(int r, int hi) { return (r & 3) + 8 * (r >> 2) + 4 * hi; }
#define MFMA32(a, b, c) __builtin_amdgcn_mfma_f32_32x32x16_bf16(a, b, c, 0, 0, 0)
__device__ __forceinline__ void attn_unit(const Frame& F, int l, int b, int h, int qb, float Mb, float lam, float lam_init) {
    LAS unsigned char* lds = F.lds;
    int t0 = threadIdx.x; asm volatile("" : "+v"(t0));
    const int lane = t0 & 63, wid = __builtin_amdgcn_readfirstlane(t0 >> 6), r32 = lane & 31, hi = lane >> 5;
    const int nkt = (qb == 0) ? 4 : 68;
    const bf16_t* Kg = (const bf16_t*)(F.ws + WS_KB) + (size_t)((b * 4 + h) * 2) * TPB * 64;
    const bf16_t* Vg = (const bf16_t*)(F.ws + WS_VT) + (size_t)((b * 4 + h) * 128) * TPB;
    const bf16_t* Qg = (const bf16_t*)(F.ws + WS_QB) + ((size_t)((b * 4 + h) * 2) * TPB + qb * 256) * 64;
#define AT_DMA(src, off) __builtin_amdgcn_global_load_lds((const unsigned*)(src), (LAS unsigned*)(lds + (off)), 16, 0, 0)
    unsigned koff[2], voff[2];
#pragma unroll
    for (int j = 0; j < 2; ++j) { const int idx = wid * 2 + j; koff[j] = (unsigned)(((idx >> 3) * TPB * 64 + lane * 64 + (idx & 7) * 8) * 2); voff[j] = (unsigned)((((idx & 1) * 64 + lane) * TPB + (idx >> 1) * 8) * 2); }
#define AT_TILE(t, s) do { const char* kt_ = (const char*)Kg + (size_t)(t) * (64 * 64 * 2); const char* vt_ = (const char*)Vg + (size_t)(t) * (64 * 2); \
        _Pragma("unroll") for (int j_ = 0; j_ < 2; ++j_) { const int idx_ = wid * 2 + j_; \
        AT_DMA(kt_ + koff[j_], (s) * 32768 + (idx_ >> 3) * 8192 + (idx_ & 7) * 1024); \
        AT_DMA(vt_ + voff[j_], (s) * 32768 + 16384 + (idx_ >> 1) * 2048 + (idx_ & 1) * 1024); } } while (0)
#pragma unroll
    for (int j = 0; j < 8; ++j) { const int idx = wid * 8 + j, sub = idx >> 5, ch = (idx >> 2) & 7, rg = idx & 3;
        AT_DMA((const char*)Qg + (unsigned)((sub * TPB * 64 + (rg * 64 + lane) * 64 + ch * 8) * 2), 65536 + sub * 32768 + ch * 4096 + rg * 1024); }
    AT_TILE(0, 0);
    f32x16 O[2][4];
#pragma unroll
    for (int a = 0; a < 2; ++a)
#pragma unroll
        for (int v = 0; v < 4; ++v)
#pragma unroll
            for (int r = 0; r < 16; ++r) O[a][v][r] = 0.f;
    float lsum0 = 0.f, lsum1 = 0.f;
    f32x16 zero16;
#pragma unroll
    for (int r = 0; r < 16; ++r) zero16[r] = 0.f;
    const float shift = (Mb > 40.f) ? (Mb - 40.f) : 0.f;
    const LAS unsigned char* qbase = lds + 65536 + (wid * 32 + r32) * 16 + hi * 4096;
    for (int t = 0; t < nkt; ++t) {
        asm volatile("s_waitcnt vmcnt(0)" ::: "memory");
        __syncthreads();
        const int s = t & 1;
        if (t + 1 < nkt) AT_TILE(t + 1, s ^ 1);
        const LAS unsigned char* kb = lds + s * 32768 + hi * 1024 + r32 * 16;
        const LAS unsigned char* vb = lds + s * 32768 + 16384 + hi * 2048 + r32 * 16;
        bf16x8 P[2][4];
#pragma unroll
        for (int sub = 0; sub < 2; ++sub) {
            f32x16 S0, S1;
#pragma unroll
            for (int ds = 0; ds < 4; ++ds) {
                const bf16x8 qf = *(const LAS bf16x8*)(qbase + sub * 32768 + ds * 8192);
                const bf16x8 k0 = *(const LAS bf16x8*)(kb + sub * 8192 + ds * 2048);
                const bf16x8 k1 = *(const LAS bf16x8*)(kb + sub * 8192 + ds * 2048 + 512);
                if (ds == 0) { S0 = MFMA32(k0, qf, zero16); S1 = MFMA32(k1, qf, zero16); } else { S0 = MFMA32(k0, qf, S0); S1 = MFMA32(k1, qf, S1); }
            }
            __builtin_amdgcn_sched_barrier(0);
            if (shift > 0.f) {
#pragma unroll
                for (int r = 0; r < 16; ++r) { S0[r] -= shift; S1[r] -= shift; }
            }
            float ls = 0.f;
#define AT_EXP8(S, base, dst) do { const float e0 = __builtin_amdgcn_exp2f(S[base]), e1 = __builtin_amdgcn_exp2f(S[base + 1]), e2 = __builtin_amdgcn_exp2f(S[base + 2]), e3 = __builtin_amdgcn_exp2f(S[base + 3]), \
                e4 = __builtin_amdgcn_exp2f(S[base + 4]), e5 = __builtin_amdgcn_exp2f(S[base + 5]), e6 = __builtin_amdgcn_exp2f(S[base + 6]), e7 = __builtin_amdgcn_exp2f(S[base + 7]); \
                ls += ((e0 + e1) + (e2 + e3)) + ((e4 + e5) + (e6 + e7)); \
                const u32x4 w_ = (u32x4){cvt_pk_bf16(e0, e1), cvt_pk_bf16(e2, e3), cvt_pk_bf16(e4, e5), cvt_pk_bf16(e6, e7)}; dst = __builtin_bit_cast(bf16x8, w_); \
                __builtin_amdgcn_sched_barrier(0); } while (0)
            AT_EXP8(S0, 0, P[sub][0]); AT_EXP8(S0, 8, P[sub][1]); AT_EXP8(S1, 0, P[sub][2]); AT_EXP8(S1, 8, P[sub][3]);
#undef AT_EXP8
            if (sub == 0) lsum0 += ls; else lsum1 += ls;
        }
#pragma unroll
        for (int ks = 0; ks < 4; ++ks) {
#pragma unroll
            for (int v4 = 0; v4 < 4; ++v4) {
                const bf16x8 vf = *(const LAS bf16x8*)(vb + ks * 4096 + v4 * 512);
                O[0][v4] = MFMA32(P[0][ks], vf, O[0][v4]); O[1][v4] = MFMA32(P[1][ks], vf, O[1][v4]);
            }
            __builtin_amdgcn_sched_barrier(0);
        }
    }
    lsum0 += __shfl_xor(lsum0, 32); lsum1 += __shfl_xor(lsum1, 32);
    int tz = threadIdx.x; asm volatile("" : "+v"(tz));
    const int lane2 = tz & 63, wid2 = tz >> 6, r32b = lane2 & 31, hib = lane2 >> 5;
    LAS float* wl = (LAS float*)(lds + 131072) + wid2 * 64;
    if (hib == 0) { wl[r32b] = __builtin_amdgcn_rcpf(lsum0); wl[32 + r32b] = lam * __builtin_amdgcn_rcpf(lsum1); }
    asm volatile("s_waitcnt lgkmcnt(0)" ::: "memory");
    float ss[16];
#pragma unroll
    for (int r = 0; r < 16; ++r) { const int q = crow(r, hib); const float i0 = wl[q], i1 = wl[32 + q]; float sacc = 0.f;
#pragma unroll
        for (int v4 = 0; v4 < 4; ++v4) { const float o = O[0][v4][r] * i0 - O[1][v4][r] * i1; O[0][v4][r] = o; sacc += o * o; }
        ss[r] = sacc; }
#pragma unroll
    for (int o = 1; o <= 16; o <<= 1)
#pragma unroll
        for (int r = 0; r < 16; ++r) ss[r] += __shfl_xor(ss[r], o);
    const float* gs = F.in[I_SUBG] + l * 128;
    float gv[4];
#pragma unroll
    for (int v4 = 0; v4 < 4; ++v4) gv[v4] = gs[v4 * 32 + r32b] * (1.0f - lam_init);
    bf16_t* yb = (bf16_t*)(F.ws + WS_YMIX) + (size_t)(b * TPB + qb * 256 + wid2 * 32) * DM + 512 + h * 128 + r32b;
#pragma unroll
    for (int r = 0; r < 16; ++r) { const float sc = 1.0f / sqrtf(ss[r] * (1.0f / 128.0f) + EPSN); bf16_t* yr = yb + (size_t)crow(r, hib) * DM;
#pragma unroll
        for (int v4 = 0; v4 < 4; ++v4) yr[v4 * 32] = f2bf(O[0][v4][r] * sc * gv[v4]); }
    __syncthreads();
#undef AT_DMA
#undef AT_TILE
}
struct LruW { bf16x8 wa[4][2], wx[4][2]; float ba[2], bx[2], sp[2]; };
__device__ __forceinline__ void lru_load_w(const Frame& F, int l, LruW& W) {
    const int lane = F.lane, r32 = lane & 31, hi = lane >> 5, h = F.wid & 3, dir = F.wid >> 2;
    const float* wa = F.in[I_LWA] + (size_t)((l * 2 + dir) * 4 + h) * 4096;
    const float* wx = F.in[I_LWX] + (size_t)((l * 2 + dir) * 4 + h) * 4096;
#pragma unroll
    for (int ks = 0; ks < 4; ++ks)
#pragma unroll
        for (int nb = 0; nb < 2; ++nb) { unsigned a[4], x[4];
#pragma unroll
            for (int j = 0; j < 4; ++j) { const int i0 = 16 * ks + 8 * hi + 2 * j, c = nb * 32 + r32;
                a[j] = cvt_pk_bf16(wa[i0 * 64 + c], wa[(i0 + 1) * 64 + c]); x[j] = cvt_pk_bf16(wx[i0 * 64 + c], wx[(i0 + 1) * 64 + c]); }
            W.wa[ks][nb] = __builtin_bit_cast(bf16x8, (u32x4){a[0], a[1], a[2], a[3]}); W.wx[ks][nb] = __builtin_bit_cast(bf16x8, (u32x4){x[0], x[1], x[2], x[3]}); }
#pragma unroll
    for (int nb = 0; nb < 2; ++nb) { const int ch = (l * 2 + dir) * 256 + h * 64 + nb * 32 + r32;
        W.ba[nb] = F.in[I_LBA][ch]; W.bx[nb] = F.in[I_LBX][ch]; W.sp[nb] = softplusf_(-F.in[I_LLAM][ch]); }
}
__device__ __forceinline__ float gelu_tanh(float x) { return 0.5f * x * (1.0f + tanh_fast(0.7978845608028654f * (x + 0.044715f * x * x * x))); }
template <int PASS>
__device__ __forceinline__ void lru_unit(const Frame& F, int l, int u, const LruW& W) {
    int t0 = threadIdx.x; asm volatile("" : "+v"(t0));
    const int tid = t0, lane = tid & 63, wid = __builtin_amdgcn_readfirstlane(tid >> 6), r32 = lane & 31, hi = lane >> 5;
    const int b = u / 136, c32 = u - b * 136, pos0 = c32 * 32, row0 = b * TPB + pos0;
    const int seg_lo = pos0 < CTXL ? 0 : CTXL, seg_hi = pos0 < CTXL ? CTXL : TPB;
    const bf16_t* proj = (const bf16_t*)(F.ws + WS_PROJ);
    LAS bf16_t* xcb = (LAS bf16_t*)F.lds;
    LAS f32x2* au = (LAS f32x2*)(F.lds + 16896);
    {
        const int ch = tid & 255, th = tid >> 8, p0 = pos0 + th * 16;
        const float* cw = F.in[I_LCW] + l * 1024; const float w0 = cw[ch], w1 = cw[256 + ch], w2 = cw[512 + ch], w3 = cw[768 + ch], cb = F.in[I_LCB][l * 256 + ch];
        float xv[19];
#pragma unroll
        for (int j = 0; j < 19; ++j) { const int p = p0 - 2 + j; xv[j] = (p >= seg_lo && p < seg_hi) ? bf2f(proj[(size_t)(b * TPB + p) * NPROJ + C_LX + ch]) : 0.f; }
#pragma unroll
        for (int j = 0; j < 16; ++j) xcb[(th * 16 + j) * 264 + ch] = f2bf(cb + w0 * xv[j] + w1 * xv[j + 1] + w2 * xv[j + 2] + w3 * xv[j + 3]);
    }
    __syncthreads();
    {
        const int h = wid & 3, dir = wid >> 2;
        f32x16 Da[2], Dx[2];
#pragma unroll
        for (int nb = 0; nb < 2; ++nb)
#pragma unroll
            for (int r = 0; r < 16; ++r) { Da[nb][r] = 0.f; Dx[nb][r] = 0.f; }
#pragma unroll
        for (int ks = 0; ks < 4; ++ks) { const bf16x8 a = *(const LAS bf16x8*)(xcb + r32 * 264 + h * 64 + 16 * ks + 8 * hi);
#pragma unroll
            for (int nb = 0; nb < 2; ++nb) { Da[nb] = MFMA32(a, W.wa[ks][nb], Da[nb]); Dx[nb] = MFMA32(a, W.wx[ks][nb], Dx[nb]); } }
#pragma unroll
        for (int nb = 0; nb < 2; ++nb) { const int ch = h * 64 + nb * 32 + r32;
#pragma unroll
            for (int r = 0; r < 16; ++r) { const int tok = crow(r, hi);
                const float ra = sigmoidf_(Da[nb][r] + W.ba[nb]), ix = sigmoidf_(Dx[nb][r] + W.bx[nb]);
                const float la = -8.0f * ra * W.sp[nb], a = __expf(la), xcv = bf2f(xcb[tok * 264 + ch]);
                const float uu = sqrtf(one_minus_exp(2.0f * la)) * ix * xcv;
                au[(dir * 32 + tok) * 256 + ch] = (f32x2){a, uu}; } }
    }
    __syncthreads();
    {
        const int dir = tid >> 8, ch = tid & 255; const size_t sidx = ((size_t)(b * 136 + c32) * 2 + dir) * 256 + ch;
        if (PASS == 1) { float A = 1.f, H = 0.f;
#pragma unroll 8
            for (int s2 = 0; s2 < 32; ++s2) { const int tok = dir ? 31 - s2 : s2; const f32x2 v = au[(dir * 32 + tok) * 256 + ch]; H = v.x * H + v.y; A *= v.x; }
            ((f32x2*)(F.ws + WS_LRUS))[sidx] = (f32x2){A, H};
        } else { float hh = ((const float*)(F.ws + WS_LRUC))[sidx];
#pragma unroll 8
            for (int s2 = 0; s2 < 32; ++s2) { const int tok = dir ? 31 - s2 : s2; f32x2 v = au[(dir * 32 + tok) * 256 + ch]; hh = v.x * hh + v.y; v.y = hh; au[(dir * 32 + tok) * 256 + ch] = v; }
        }
    }
    __syncthreads();
    if (PASS == 2) { const int ch = tid & 255, th = tid >> 8;
#pragma unroll 4
        for (int j = 0; j < 16; ++j) { const int tok = th * 16 + j; const float g = bf2f(proj[(size_t)(row0 + tok) * NPROJ + C_LG + ch]);
            const float y = gelu_tanh(g) * (au[tok * 256 + ch].y + au[(32 + tok) * 256 + ch].y);
            ((bf16_t*)(F.ws + WS_YMIX))[(size_t)(row0 + tok) * DM + ch] = f2bf(y); }
        __syncthreads();
    }
}
__device__ __forceinline__ void lru_carry_unit(const Frame& F, int u) {
    const int b = u >> 3, dir = (u >> 2) & 1, cg = u & 3, tid = F.tid;
    LAS f32x2* sm = (LAS f32x2*)F.lds;
    for (int idx = tid; idx < 136 * 64; idx += NTHR) { const int c = idx >> 6, cl = idx & 63; sm[idx] = ((const f32x2*)(F.ws + WS_LRUS))[((size_t)(b * 136 + c) * 2 + dir) * 256 + cg * 64 + cl]; }
    __syncthreads();
    if (tid < 64) { float h = 0.f; float* cr = (float*)(F.ws + WS_LRUC);
        for (int s2 = 0; s2 < 136; ++s2) { const int c = dir ? (s2 < 8 ? 7 - s2 : 143 - s2) : s2; const f32x2 v = sm[c * 64 + tid];
            cr[((size_t)(b * 136 + c) * 2 + dir) * 256 + cg * 64 + tid] = h; h = v.x * h + v.y; } }
    __syncthreads();
}

#define SSD_CONV128(COL, CCH, EMIT) do { \
        const float* cw_ = F.in[I_SCW] + l * 4 * 768; const float w0_ = cw_[CCH], w1_ = cw_[768 + (CCH)], w2_ = cw_[1536 + (CCH)], w3_ = cw_[2304 + (CCH)], cb_ = F.in[I_SCB][l * 768 + (CCH)]; \
        const bf16_t* pc_ = proj + (size_t)(b * TPB) * NPROJ + (COL); \
        float xm2_ = (pos0 - 2 >= seg_lo) ? bf2f(pc_[(size_t)(pos0 - 2) * NPROJ]) : 0.f, xm1_ = (pos0 - 1 >= seg_lo) ? bf2f(pc_[(size_t)(pos0 - 1) * NPROJ]) : 0.f, x0_ = bf2f(pc_[(size_t)pos0 * NPROJ]); \
        for (int t8_ = 0; t8_ < 16; ++t8_) { float xn_[8], o_[8]; \
            _Pragma("unroll") for (int j_ = 0; j_ < 8; ++j_) { const int p_ = pos0 + t8_ * 8 + j_ + 1; xn_[j_] = (p_ < seg_hi) ? bf2f(pc_[(size_t)p_ * NPROJ]) : 0.f; } \
            _Pragma("unroll") for (int j_ = 0; j_ < 8; ++j_) { const float v_ = cb_ + w0_ * xm2_ + w1_ * xm1_ + w2_ * x0_ + w3_ * xn_[j_]; o_[j_] = siluf_(v_); xm2_ = xm1_; xm1_ = x0_; x0_ = xn_[j_]; } \
            EMIT(t8_, o_); } } while (0)
#define SSD_EMIT_T(rowptr) [&](int t8, const float (&o)[8]) { *(LAS u32x4*)((rowptr) + t8 * 8) = (u32x4){cvt_pk_bf16(o[0], o[1]), cvt_pk_bf16(o[2], o[3]), cvt_pk_bf16(o[4], o[5]), cvt_pk_bf16(o[6], o[7])}; }

__device__ __forceinline__ void ssd_p1_unit(const Frame& F, int l, int u) {
    int t0 = threadIdx.x; asm volatile("" : "+v"(t0));
    const int tid = t0, lane = tid & 63, wid = __builtin_amdgcn_readfirstlane(tid >> 6), r32 = lane & 31, hi = lane >> 5;
    const int b = u / 34, c = u - b * 34, pos0 = c * 128, row0 = b * TPB + pos0;
    const int seg_lo = pos0 < CTXL ? 0 : CTXL, seg_hi = pos0 < CTXL ? CTXL : TPB;
    const bf16_t* proj = (const bf16_t*)(F.ws + WS_PROJ);
    LAS bf16_t* XsT = (LAS bf16_t*)F.lds;
    LAS bf16_t* Bt = (LAS bf16_t*)(F.lds + 69632);
    LAS float* dtf = (LAS float*)(F.lds + 139264);
    LAS float* dtb = dtf + 512; LAS float* wf = dtf + 1024; LAS float* wb = dtf + 1536;
    { LAS bf16_t* rowp = (tid < 256 ? XsT : Bt) + (tid & 255) * 136;
      auto emit = SSD_EMIT_T(rowp);
      SSD_CONV128(C_XS + tid, tid, emit); }
    if (tid < 128) { const float* dr = (const float*)(F.ws + WS_DTRAW) + (size_t)(row0 + tid) * 8;
#pragma unroll
        for (int h = 0; h < 4; ++h) { dtf[h * 128 + tid] = softplusf_(dr[h] + F.in[I_SDTB][l * 8 + h]); dtb[h * 128 + tid] = softplusf_(dr[4 + h] + F.in[I_SDTB][l * 8 + 4 + h]); } }
    __syncthreads();
    if (tid < 8) { const int h = tid & 3, dir = tid >> 2; const float a = -__expf(F.in[I_SALOG][l * 8 + dir * 4 + h]); float run = 0.f;
        if (dir == 0) { for (int t = 127; t >= 0; --t) { const float d = dtf[h * 128 + t]; wf[h * 128 + t] = d * __expf(run); run += d * a; } }
        else { for (int t = 0; t < 128; ++t) { const float d = dtb[h * 128 + t]; wb[h * 128 + t] = d * __expf(run); run += d * a; } }
        ((float*)(F.ws + WS_SSDD))[((size_t)(b * 34 + c) * 4 + h) * 2 + dir] = __expf(run); }
    __syncthreads();
    {   const int h = wid & 3, dir = wid >> 2, g = h >> 1;
        const LAS float* wv = (dir ? wb : wf) + h * 128;
        f32x16 D[2][4];
#pragma unroll
        for (int pb = 0; pb < 2; ++pb)
#pragma unroll
            for (int nb = 0; nb < 4; ++nb)
#pragma unroll
                for (int r = 0; r < 16; ++r) D[pb][nb][r] = 0.f;
#pragma unroll 2
        for (int ks = 0; ks < 8; ++ks) {
            const f32x4 s0 = *(const LAS f32x4*)(wv + 16 * ks + 8 * hi), s1 = *(const LAS f32x4*)(wv + 16 * ks + 8 * hi + 4);
            bf16x8 Af[2];
#pragma unroll
            for (int pb = 0; pb < 2; ++pb) { const u32x4 x = *(const LAS u32x4*)(XsT + (h * 64 + pb * 32 + r32) * 136 + 16 * ks + 8 * hi);
                const u32x4 y = (u32x4){cvt_pk_bf16(bflo(x.x) * s0[0], bfhi(x.x) * s0[1]), cvt_pk_bf16(bflo(x.y) * s0[2], bfhi(x.y) * s0[3]), cvt_pk_bf16(bflo(x.z) * s1[0], bfhi(x.z) * s1[1]), cvt_pk_bf16(bflo(x.w) * s1[2], bfhi(x.w) * s1[3])};
                Af[pb] = __builtin_bit_cast(bf16x8, y); }
#pragma unroll
            for (int nb = 0; nb < 4; ++nb) { const bf16x8 bfr = *(const LAS bf16x8*)(Bt + (g * 128 + nb * 32 + r32) * 136 + 16 * ks + 8 * hi);
                D[0][nb] = MFMA32(Af[0], bfr, D[0][nb]); D[1][nb] = MFMA32(Af[1], bfr, D[1][nb]); }
        }
        float* sp = (float*)(F.ws + WS_SSDS) + (((size_t)(b * 34 + c) * 4 + h) * 2 + dir) * 8192;
#pragma unroll
        for (int pb = 0; pb < 2; ++pb)
#pragma unroll
            for (int nb = 0; nb < 4; ++nb)
#pragma unroll
                for (int r = 0; r < 16; ++r) sp[(pb * 32 + crow(r, hi)) * 128 + nb * 32 + r32] = D[pb][nb][r];
    }
    __syncthreads();
}
__device__ __forceinline__ void ssd_carry_unit(const Frame& F, int u) {
    const int q = u & 3, dir = (u >> 2) & 1, h = (u >> 3) & 3, b = u >> 5, e = q * 2048 + F.tid * 4;
    const float* sl = (const float*)(F.ws + WS_SSDS); const float* dc = (const float*)(F.ws + WS_SSDD); bf16_t* si = (bf16_t*)(F.ws + WS_SSDI);
    f32x4 S = (f32x4){0.f, 0.f, 0.f, 0.f};
#pragma unroll 17
    for (int s2 = 0; s2 < 34; ++s2) { const int c = dir ? (s2 < 2 ? 1 - s2 : 35 - s2) : s2; const size_t base = ((size_t)(b * 34 + c) * 4 + h) * 2 + dir;
        *(u32x2*)(si + base * 8192 + e) = (u32x2){cvt_pk_bf16(S[0], S[1]), cvt_pk_bf16(S[2], S[3])};
        S = S * dc[base] + *(const f32x4*)(sl + base * 8192 + e); }
}
__device__ __forceinline__ void ssd_p2_unit(const Frame& F, int l, int u) {
    int t0 = threadIdx.x; asm volatile("" : "+v"(t0));
    const int tid = t0, lane = tid & 63, wid = __builtin_amdgcn_readfirstlane(tid >> 6), r32 = lane & 31, hi = lane >> 5;
    const int b = u / 34, c = u - b * 34, pos0 = c * 128, row0 = b * TPB + pos0;
    const int seg_lo = pos0 < CTXL ? 0 : CTXL, seg_hi = pos0 < CTXL ? CTXL : TPB;
    const bf16_t* proj = (const bf16_t*)(F.ws + WS_PROJ);
    LAS bf16_t* Cn = (LAS bf16_t*)F.lds;
    LAS bf16_t* Bn = (LAS bf16_t*)(F.lds + 34816);
    LAS bf16_t* XsT = (LAS bf16_t*)(F.lds + 69632);
    LAS f32x4* vec = (LAS f32x4*)(F.lds + 104448);
    LAS float* ssq = (LAS float*)(F.lds + 112640);
    if (tid < 128) { const float* dr = (const float*)(F.ws + WS_DTRAW) + (size_t)(row0 + tid) * 8; ssq[tid] = 0.f;
#pragma unroll
        for (int h = 0; h < 4; ++h) vec[h * 128 + tid] = (f32x4){0.f, 0.f, softplusf_(dr[h] + F.in[I_SDTB][l * 8 + h]), softplusf_(dr[4 + h] + F.in[I_SDTB][l * 8 + 4 + h])}; }
    __syncthreads();
    if (tid < 8) { const int h = tid & 3, dir = tid >> 2; const float a = -__expf(F.in[I_SALOG][l * 8 + dir * 4 + h]); float run = 0.f; LAS float* vf = (LAS float*)(vec + h * 128);
        if (dir == 0) { for (int t = 0; t < 128; ++t) { run += vf[4 * t + 2] * a; vf[4 * t] = run; } }
        else { for (int t = 127; t >= 0; --t) { run += vf[4 * t + 3] * a; vf[4 * t + 1] = run; } } }
    float* ypre = (float*)(F.ws + WS_YPRE);
#pragma unroll 1
    for (int g = 0; g < 2; ++g) {
        f32x16 Y[2];
        __syncthreads();
        if (tid < 384) {
            const int role = tid >> 7, idx = tid & 127;
            const int col = (role == 0 ? C_CM : (role == 1 ? C_BM : C_XS)) + g * 128 + idx, cch = (role == 0 ? 512 : (role == 1 ? 256 : 0)) + g * 128 + idx;
            LAS bf16_t* wp = (role == 0) ? (Cn + idx) : ((role == 1) ? (Bn + idx) : (XsT + idx * 136));
            auto emit = [&](int t8, const float (&o)[8]) {
                if (role == 2) { *(LAS u32x4*)(wp + t8 * 8) = (u32x4){cvt_pk_bf16(o[0], o[1]), cvt_pk_bf16(o[2], o[3]), cvt_pk_bf16(o[4], o[5]), cvt_pk_bf16(o[6], o[7])}; }
                else {
#pragma unroll
                    for (int j = 0; j < 8; ++j) wp[(t8 * 8 + j) * 136] = f2bf(o[j]); } };
            SSD_CONV128(col, cch, emit); }
        __syncthreads();
        int tq = threadIdx.x; asm volatile("" : "+v"(tq));
        const int lane_ = tq & 63, wid_ = __builtin_amdgcn_readfirstlane(tq >> 6), r32 = lane_ & 31, hi = lane_ >> 5;
        const int hg = wid_ >> 2, lb = wid_ & 3, h = 2 * g + hg;
        const LAS f32x4* vh = vec + h * 128;
        f32x16 GT[4];
#pragma unroll
        for (int sb = 0; sb < 4; ++sb)
#pragma unroll
            for (int r = 0; r < 16; ++r) GT[sb][r] = 0.f;
#pragma unroll 2
        for (int ks = 0; ks < 8; ++ks) { const bf16x8 cf = *(const LAS bf16x8*)(Cn + (lb * 32 + r32) * 136 + 16 * ks + 8 * hi);
#pragma unroll
            for (int sb = 0; sb < 4; ++sb) { const bf16x8 bf = *(const LAS bf16x8*)(Bn + (sb * 32 + r32) * 136 + 16 * ks + 8 * hi); GT[sb] = MFMA32(bf, cf, GT[sb]); } }
        const int lme = lb * 32 + r32; const f32x4 vl = vh[lme];
        bf16x8 Pf[8];
#pragma unroll
        for (int sb = 0; sb < 4; ++sb) { float pm[16];
#pragma unroll
            for (int r = 0; r < 16; ++r) { const int sidx = sb * 32 + crow(r, hi); const f32x4 vs = vh[sidx];
                const float mf = (sidx <= lme) ? __expf(vl[0] - vs[0]) * vs[2] : 0.f, mb = (sidx >= lme) ? __expf(vl[1] - vs[1]) * vs[3] : 0.f;
                pm[r] = GT[sb][r] * (mf + mb); }
            Pf[sb * 2] = __builtin_bit_cast(bf16x8, (u32x4){cvt_pk_bf16(pm[0], pm[1]), cvt_pk_bf16(pm[2], pm[3]), cvt_pk_bf16(pm[4], pm[5]), cvt_pk_bf16(pm[6], pm[7])});
            Pf[sb * 2 + 1] = __builtin_bit_cast(bf16x8, (u32x4){cvt_pk_bf16(pm[8], pm[9]), cvt_pk_bf16(pm[10], pm[11]), cvt_pk_bf16(pm[12], pm[13]), cvt_pk_bf16(pm[14], pm[15])}); }
#pragma unroll
        for (int pb = 0; pb < 2; ++pb)
#pragma unroll
            for (int r = 0; r < 16; ++r) Y[pb][r] = 0.f;
#pragma unroll
        for (int k2 = 0; k2 < 8; ++k2)
#pragma unroll
            for (int pb = 0; pb < 2; ++pb) { const LAS bf16_t* xr = XsT + (hg * 64 + pb * 32 + r32) * 136 + 16 * k2 + 4 * hi;
                const u32x2 lo = *(const LAS u32x2*)xr, hi2 = *(const LAS u32x2*)(xr + 8);
                Y[pb] = MFMA32(Pf[k2], __builtin_bit_cast(bf16x8, (u32x4){lo.x, lo.y, hi2.x, hi2.y}), Y[pb]); }
#pragma unroll
        for (int dir = 0; dir < 2; ++dir) {
            const bf16_t* sin = (const bf16_t*)(F.ws + WS_SSDI) + (((size_t)(b * 34 + c) * 4 + h) * 2 + dir) * 8192;
            f32x16 T[2];
#pragma unroll
            for (int pb = 0; pb < 2; ++pb)
#pragma unroll
                for (int r = 0; r < 16; ++r) T[pb][r] = 0.f;
#pragma unroll 2
            for (int ks = 0; ks < 8; ++ks) { const bf16x8 cf = *(const LAS bf16x8*)(Cn + (lb * 32 + r32) * 136 + 16 * ks + 8 * hi);
#pragma unroll
                for (int pb = 0; pb < 2; ++pb) { const bf16x8 sf = *(const bf16x8*)(sin + (pb * 32 + r32) * 128 + 16 * ks + 8 * hi); T[pb] = MFMA32(cf, sf, T[pb]); } }
#pragma unroll
            for (int r = 0; r < 16; ++r) { const f32x4 vr = vh[lb * 32 + crow(r, hi)]; const float sc = __expf(dir ? vr[1] : vr[0]);
                Y[0][r] += sc * T[0][r]; Y[1][r] += sc * T[1][r]; }
        }
        { const float dsk = F.in[I_SD][l * 4 + h];
#pragma unroll
          for (int r = 0; r < 16; ++r) { const int ll = lb * 32 + crow(r, hi); float sq = 0.f;
#pragma unroll
              for (int pb = 0; pb < 2; ++pb) { const int pc = hg * 64 + pb * 32 + r32;
                  const float xs = bf2f(XsT[pc * 136 + ll]), z = bf2f(proj[(size_t)(row0 + ll) * NPROJ + C_SZ + g * 128 + pc]);
                  const float y = (Y[pb][r] + dsk * xs) * siluf_(z); ypre[(size_t)(row0 + ll) * 256 + g * 128 + pc] = y; sq += y * y; }
#pragma unroll
              for (int o = 1; o <= 16; o <<= 1) sq += __shfl_xor(sq, o);
              if (r32 == 0) atomicAdd((float*)(ssq + ll), sq); } }
    }
    __syncthreads();
    { int t1 = threadIdx.x; asm volatile("" : "+v"(t1)); const int lane2 = t1 & 63, wid2 = t1 >> 6, r32b = lane2 & 31, hib = lane2 >> 5, hg = wid2 >> 2, lb = wid2 & 3;
#pragma unroll 1
      for (int g = 0; g < 2; ++g)
#pragma unroll 4
          for (int r = 0; r < 16; ++r) { const int ll = lb * 32 + crow(r, hib); const float rs = 1.0f / sqrtf(ssq[ll] * (1.0f / 256.0f) + EPSN);
#pragma unroll
              for (int pb = 0; pb < 2; ++pb) { const int ch = g * 128 + hg * 64 + pb * 32 + r32b;
                  ((bf16_t*)(F.ws + WS_YMIX))[(size_t)(row0 + ll) * DM + 256 + ch] = f2bf(ypre[(size_t)(row0 + ll) * 256 + ch] * rs * F.in[I_SNG][l * 256 + ch]); } } }
    __syncthreads();
}

struct AttnConsts { float Mb, lam, lam_init; };
__device__ __forceinline__ AttnConsts attn_consts(const Frame& F, int l) {
    AttnConsts c; const int lane = F.lane;
    float gq = fabsf(F.in[I_QN][l * 64 + lane]), gk = fabsf(F.in[I_KN][l * 64 + lane]);
#pragma unroll
    for (int o = 32; o >= 1; o >>= 1) { gq = fmaxf(gq, __shfl_xor(gq, o)); gk = fmaxf(gk, __shfl_xor(gk, o)); }
    c.Mb = __uint_as_float(__builtin_amdgcn_readfirstlane(__float_as_uint(64.0f * gq * gk * QSCALE * 1.001f)));
    const float d0 = wave_sum(F.in[I_LAMQ][l * 128 + lane] * F.in[I_LAMK][l * 128 + lane]);
    const float d1 = wave_sum(F.in[I_LAMQ][l * 128 + 64 + lane] * F.in[I_LAMK][l * 128 + 64 + lane]);
    c.lam_init = 0.8f - 0.6f * expf(-0.3f * (float)l);
    c.lam = __uint_as_float(__builtin_amdgcn_readfirstlane(__float_as_uint(expf(d0) - expf(d1) + c.lam_init)));
    return c;
}
__device__ __forceinline__ void p_post(const Frame& F, int l) {
    for (int u = F.bx; u < 272; u += F.G) ssd_p1_unit(F, l, u);
    { LruW W; lru_load_w(F, l, W);
      for (int u = (F.bx + F.G - 16) % F.G; u < 1088; u += F.G) lru_unit<1>(F, l, u, W); }
    __syncthreads();
    LAS float* tab = (LAS float*)F.lds;
    c1_setup(F, tab);
    for (int u = F.bx; u < 544; u += F.G) c1_unit(F, l, u, tab);
}
__device__ __forceinline__ void p_mix2(const Frame& F, int l) {
    for (int u = F.bx; u < 272; u += F.G) ssd_p2_unit(F, l, u);
    { LruW W; lru_load_w(F, l, W);
      for (int u = (F.bx + F.G - 16) % F.G; u < 1088; u += F.G) lru_unit<2>(F, l, u, W); }
}
__device__ __forceinline__ void p_attn(const Frame& F, int l) {
    for (int u = F.bx; u < 256; u += F.G) ssd_carry_unit(F, u);
    for (int u = F.bx; u < 64; u += F.G) lru_carry_unit(F, u);
    const AttnConsts c = attn_consts(F, l);
    const int nq = (l == 0) ? 17 : 16, nun = 32 * nq;
    for (int u = F.bx; u < nun; u += F.G) { const int bh = u % 32, qi = u / 32; attn_unit(F, l, bh >> 2, bh & 3, (l == 0) ? qi : qi + 1, c.Mb, c.lam, c.lam_init); }
}

struct EpiOut {
    float* X; const float* modl;
    __device__ __forceinline__ void operator()(const f32x4 (&acc)[2][2][4][2], const gm::GU& u, int tz) const {
        const int wid = tz >> 6, lane = tz & 63, wr = wid >> 2, wc = wid & 3, fr = lane & 15, fq = lane >> 4;
        const int row0 = u.m0 + wr * 64 + fr, col0 = u.pn * 256 + wc * 32 + 4 * fq;
        const int bb = u.rbg / 17, mrow = (u.rbg - bb * 17 == 0) ? 8 : bb;
        const float* g1 = modl + (size_t)mrow * 6144 + 2 * 1024 + col0;
        f32x4 gv[2][2];
#pragma unroll
        for (int bj = 0; bj < 2; ++bj)
#pragma unroll
            for (int n = 0; n < 2; ++n) gv[bj][n] = *(const f32x4*)(g1 + bj * 128 + n * 16);
#pragma unroll
        for (int ai = 0; ai < 2; ++ai)
#pragma unroll
            for (int m = 0; m < 4; ++m) { float* rowp = X + (size_t)(row0 + ai * 128 + m * 16) * DM + col0;
#pragma unroll
                for (int bj = 0; bj < 2; ++bj)
#pragma unroll
                    for (int n = 0; n < 2; ++n) { f32x4* p = (f32x4*)(rowp + bj * 128 + n * 16); *p = *p + gv[bj][n] * acc[ai][bj][m][n]; } }
    }
};
__device__ __forceinline__ void p_outproj(const Frame& F, int l) {
    gm::DenseSched S; S.nrb = NROW / 256; S.npn = 4; S.x = F.bx & 7; S.j = F.bx >> 3; S.wpx = F.G >> 3;
    S.Bt = (const char*)(F.ws + WS_WOUT) + (size_t)l * 1024 * 1024 * 2; S.btile = (size_t)256 * 1024 * 2; S.skipctx = (l == 1);
    EpiOut E{(float*)(F.ws + WS_XRES), (const float*)(F.ws + WS_MOD) + (size_t)l * 9 * 6144};
    gm::gemm_phase<false, false>(F.lds, (const char*)(F.ws + WS_YMIX), S, E);
}

__device__ __forceinline__ void p_norm2(const Frame& F, int l) {
    LAS f32x4* rw = (LAS f32x4*)F.lds;
    LAS int* ent = (LAS int*)(F.lds + 131072);
    LAS int* lcnt = ent + 8 * 17 * 4;
    LAS int* gb = lcnt + 32;
    const int tid = F.tid, lane = F.lane, wid = F.wid;
    { const float* src = F.in[I_RW] + (size_t)l * 1024 * 32;
      for (int idx = tid; idx < 8192; idx += NTHR) { const int k = idx >> 3, e4 = idx & 7; const int ln = k >> 2 & 63, jj = k & 3, i = k >> 8;
          rw[e4 * 1024 + (i * 4 + jj) * 64 + ln] = *(const f32x4*)(src + (size_t)k * 32 + e4 * 4); } }
    for (int idx = tid; idx < 8 * 17 * 4; idx += NTHR) ent[idx] = -1;
    if (tid < 32) lcnt[tid] = 0;
    __syncthreads();
    const float* ng = F.in[I_N2G] + l * DM;
    f32x4 g[4];
#pragma unroll
    for (int i = 0; i < 4; ++i) g[i] = *(const f32x4*)(ng + lane * 4 + 256 * i);
    const float rbias = F.in[I_RB][l * 32 + (lane >> 1)];
    int it = 0;
    for (int row = F.bx * 8 + wid; row < NROW; row += F.G * 8, ++it) {
        const int bq = row / TPB, pos = row - bq * TPB;
        if (l == 1 && pos < CTXL) continue;
        const float* xr = (const float*)(F.ws + WS_XRES) + (size_t)row * DM;
        f32x4 x[4]; float ss = 0.f;
#pragma unroll
        for (int i = 0; i < 4; ++i) { x[i] = *(const f32x4*)(xr + lane * 4 + 256 * i); ss += x[i][0] * x[i][0] + x[i][1] * x[i][1] + x[i][2] * x[i][2] + x[i][3] * x[i][3]; }
        ss = wave_sum(ss);
        const float rstd = 1.0f / sqrtf(ss * (1.0f / DM) + EPSN);
        const float* mod = (const float*)(F.ws + WS_MOD) + (size_t)(l * 9 + (pos < CTXL ? 8 : bq)) * 6144;
        bf16_t* hp = (bf16_t*)(F.ws + WS_H) + (size_t)row * DM;
        float acc[32];
#pragma unroll
        for (int e = 0; e < 32; ++e) acc[e] = 0.f;
#pragma unroll
        for (int i = 0; i < 4; ++i) {
            const int c = lane * 4 + 256 * i;
            const f32x4 sh = *(const f32x4*)(mod + 3 * 1024 + c), sc = *(const f32x4*)(mod + 4 * 1024 + c);
            const f32x4 h = x[i] * rstd * g[i] * (sc + 1.0f) + sh;
            *(u32x2*)(hp + c) = (u32x2){cvt_pk_bf16(h[0], h[1]), cvt_pk_bf16(h[2], h[3])};
#pragma unroll
            for (int jj = 0; jj < 4; ++jj)
#pragma unroll
                for (int e4 = 0; e4 < 8; ++e4) { const f32x4 w = rw[e4 * 1024 + (i * 4 + jj) * 64 + lane];
                    acc[e4 * 4] += h[jj] * w[0]; acc[e4 * 4 + 1] += h[jj] * w[1]; acc[e4 * 4 + 2] += h[jj] * w[2]; acc[e4 * 4 + 3] += h[jj] * w[3]; }
        }
        float v16[16], v8[8], v4[4], v2[2], v1;
#pragma unroll
        for (int e = 0; e < 16; ++e) { const bool up = lane & 32; const float send = up ? acc[e] : acc[e + 16], keep = up ? acc[e + 16] : acc[e]; v16[e] = keep + __shfl_xor(send, 32); }
#pragma unroll
        for (int e = 0; e < 8; ++e) { const bool up = lane & 16; const float send = up ? v16[e] : v16[e + 8], keep = up ? v16[e + 8] : v16[e]; v8[e] = keep + __shfl_xor(send, 16); }
#pragma unroll
        for (int e = 0; e < 4; ++e) { const bool up = lane & 8; const float send = up ? v8[e] : v8[e + 4], keep = up ? v8[e + 4] : v8[e]; v4[e] = keep + __shfl_xor(send, 8); }
#pragma unroll
        for (int e = 0; e < 2; ++e) { const bool up = lane & 4; const float send = up ? v4[e] : v4[e + 2], keep = up ? v4[e + 2] : v4[e]; v2[e] = keep + __shfl_xor(send, 4); }
        { const bool up = lane & 2; const float send = up ? v2[0] : v2[1], keep = up ? v2[1] : v2[0]; v1 = keep + __shfl_xor(send, 2); }
        v1 += __shfl_xor(v1, 1);
        float logit = v1 + rbias;
        int sel[4]; float val[4];
#pragma unroll
        for (int r = 0; r < 4; ++r) { float m = logit;
#pragma unroll
            for (int o = 32; o >= 1; o >>= 1) m = fmaxf(m, __shfl_xor(m, o));
            const unsigned long long bal = __ballot(logit == m); const int first = __builtin_ctzll(bal);
            sel[r] = first >> 1; val[r] = m; if ((lane >> 1) == sel[r]) logit = -INFINITY; }
        const float e1 = __expf(val[1] - val[0]), e2 = __expf(val[2] - val[0]), e3 = __expf(val[3] - val[0]), inv = 1.0f / (1.0f + e1 + e2 + e3);
        if (lane < 4) { const int e = lane == 0 ? sel[0] : (lane == 1 ? sel[1] : (lane == 2 ? sel[2] : sel[3]));
            const float gt = (lane == 0 ? 1.0f : (lane == 1 ? e1 : (lane == 2 ? e2 : e3))) * inv;
            const int lp = atomicAdd((int*)(lcnt + e), 1);
            ent[(wid * 17 + it) * 4 + lane] = e | (lp << 8);
            ((float*)(F.ws + WS_TOKG))[(size_t)row * 4 + lane] = gt; ((int*)(F.ws + WS_TOKE))[(size_t)row * 4 + lane] = e; }
    }
    __syncthreads();
    if (tid < 32) gb[tid] = atomicAdd((int*)(F.ws + WS_CNT) + l * 32 + tid, lcnt[tid]);
    __syncthreads();
    for (int idx = tid; idx < 8 * 17 * 4; idx += NTHR) { const int v = ent[idx]; if (v < 0) continue;
        const int w = idx / 68, it2 = (idx - w * 68) >> 2, r = idx & 3, row = F.bx * 8 + w + it2 * F.G * 8, e = v & 255, lp = v >> 8;
        ((int*)(F.ws + WS_LIST))[(size_t)e * NROW + gb[e] + lp] = row * 4 + r; }
    __syncthreads();
}

struct MoeTab { LAS int* first; LAS int* cntl; LAS int* tabe; int nbt; };
__device__ __forceinline__ MoeTab moe_tables(const Frame& F, int l) {
    MoeTab T; T.first = (LAS int*)(F.lds + 131072); T.cntl = T.first + 40; T.tabe = T.cntl + 32;
    if (F.tid < 32) T.cntl[F.tid] = ((const int*)(F.ws + WS_CNT))[l * 32 + F.tid];
    __syncthreads();
    if (F.tid == 0) { int a = 0; for (int e = 0; e < 32; ++e) { T.first[e] = a; a += (T.cntl[e] + 255) >> 8; } T.first[32] = a; }
    __syncthreads();
    T.nbt = T.first[32];
    for (int rb = F.tid; rb < T.nbt; rb += NTHR) { int e = 0; while (rb >= T.first[e + 1]) ++e; T.tabe[rb] = e; }
    __syncthreads();
    return T;
}
struct MoeSched {
    MoeTab T; int npn, x, j, wpx, gather; const char* W; size_t wexp; const int* list;
    __device__ __forceinline__ bool next(int i, gm::GU& u) const {
        const int v = i * wpx + j, rbl = v / npn, rbg = rbl * 8 + x;
        if (rbg >= T.nbt) return false;
        const int e = __builtin_amdgcn_readfirstlane(T.tabe[rbg]), f = __builtin_amdgcn_readfirstlane(T.first[e]), cn = __builtin_amdgcn_readfirstlane(T.cntl[e]);
        const int rb = rbg - f, nr = cn - rb * 256;
        u.pn = v - rbl * npn; u.e = e; u.rbg = rbg; u.m0 = gather ? rb * 256 : rbg * 256; u.nrows = nr < 256 ? nr : 256;
        u.bptr = W + (size_t)e * wexp + (size_t)u.pn * (256 * 1024 * 2); return true;
    }
    __device__ __forceinline__ unsigned arow(const gm::GU& u, int r) const { const int rc = r < u.nrows ? r : u.nrows - 1; return (unsigned)(list[(size_t)u.e * NROW + u.m0 + rc] >> 2); }
};
struct EpiGU {
    bf16_t* act; const float* bgu;
    __device__ __forceinline__ void operator()(const f32x4 (&acc)[2][2][4][2], const gm::GU& u, int tz) const {
        const int wid = tz >> 6, lane = tz & 63, wr = wid >> 2, wc = wid & 3, fr = lane & 15, fq = lane >> 4;
        const int a0 = u.pn * 128 + wc * 32 + 8 * fq;
        const float* bp = bgu + (size_t)u.e * 2048 + 2 * a0;
        f32x4 bb[4];
#pragma unroll
        for (int q = 0; q < 4; ++q) bb[q] = *(const f32x4*)(bp + 4 * q);
        bf16_t* base = act + (size_t)(u.rbg * 256 + wr * 64 + fr) * DEXP + a0;
#pragma unroll
        for (int ai = 0; ai < 2; ++ai)
#pragma unroll
            for (int m = 0; m < 4; ++m) { float o[8];
#pragma unroll
                for (int n = 0; n < 2; ++n)
#pragma unroll
                    for (int jx = 0; jx < 4; ++jx) { const int a = 4 * n + jx; const float bg = bb[a >> 1][(a & 1) * 2], bu = bb[a >> 1][(a & 1) * 2 + 1];
                        float gt = acc[ai][0][m][n][jx] + bg, up = acc[ai][1][m][n][jx] + bu;
                        gt = fminf(gt, 7.0f); up = fminf(fmaxf(up, -7.0f), 7.0f);
                        o[a] = (up + 1.0f) * gt * sigmoidf_(1.702f * gt); }
                *(u32x4*)(base + (size_t)(ai * 128 + m * 16) * DEXP) = (u32x4){cvt_pk_bf16(o[0], o[1]), cvt_pk_bf16(o[2], o[3]), cvt_pk_bf16(o[4], o[5]), cvt_pk_bf16(o[6], o[7])}; }
    }
};
struct EpiDown {
    bf16_t* ys; const float* bd; const int* list; const float* tokg; const LAS int* first;
    __device__ __forceinline__ void operator()(const f32x4 (&acc)[2][2][4][2], const gm::GU& u, int tz) const {
        const int wid = tz >> 6, lane = tz & 63, wr = wid >> 2, wc = wid & 3, fr = lane & 15, fq = lane >> 4;
        const int col0 = u.pn * 256 + wc * 32 + 8 * fq, lp0 = (u.rbg - first[u.e]) * 256;
        f32x4 bv[2][2];
#pragma unroll
        for (int bj = 0; bj < 2; ++bj)
#pragma unroll
            for (int n = 0; n < 2; ++n) bv[bj][n] = *(const f32x4*)(bd + (size_t)u.e * 1024 + col0 + bj * 128 + 4 * n);
#pragma unroll
        for (int ai = 0; ai < 2; ++ai)
#pragma unroll
            for (int m = 0; m < 4; ++m) { const int r = ai * 128 + wr * 64 + m * 16 + fr;
                if (r < u.nrows) { const int slot = list[(size_t)u.e * NROW + lp0 + r]; const float gt = tokg[slot]; bf16_t* rowp = ys + (size_t)slot * DM + col0;
#pragma unroll
                    for (int bj = 0; bj < 2; ++bj) { const f32x4 v0 = (acc[ai][bj][m][0] + bv[bj][0]) * gt, v1 = (acc[ai][bj][m][1] + bv[bj][1]) * gt;
                        *(u32x4*)(rowp + bj * 128) = (u32x4){cvt_pk_bf16(v0[0], v0[1]), cvt_pk_bf16(v0[2], v0[3]), cvt_pk_bf16(v1[0], v1[1]), cvt_pk_bf16(v1[2], v1[3])}; } } }
    }
};
__device__ __forceinline__ void p_moe_gu(const Frame& F, int l) {
    MoeSched S; S.T = moe_tables(F, l); S.npn = 8; S.x = F.bx & 7; S.j = F.bx >> 3; S.wpx = F.G >> 3; S.gather = 1;
    S.W = (const char*)(F.ws + WS_WGU) + (size_t)l * 32 * 2048 * 1024 * 2; S.wexp = (size_t)2048 * 1024 * 2; S.list = (const int*)(F.ws + WS_LIST);
    EpiGU E{(bf16_t*)(F.ws + WS_ACT), F.in[I_BGU] + (size_t)l * 32 * 2048};
    gm::gemm_phase<true, true>(F.lds, (const char*)(F.ws + WS_H), S, E);
}
__device__ __forceinline__ void p_moe_down(const Frame& F, int l) {
    MoeSched S; S.T = moe_tables(F, l); S.npn = 4; S.x = F.bx & 7; S.j = F.bx >> 3; S.wpx = F.G >> 3; S.gather = 0;
    S.W = (const char*)(F.ws + WS_WD) + (size_t)l * 32 * 1024 * 1024 * 2; S.wexp = (size_t)1024 * 1024 * 2; S.list = (const int*)(F.ws + WS_LIST);
    EpiDown E{(bf16_t*)(F.ws + WS_YSLOT), F.in[I_BD] + (size_t)l * 32 * 1024, (const int*)(F.ws + WS_LIST), (const float*)(F.ws + WS_TOKG), S.T.first};
    gm::gemm_phase<true, false>(F.lds, (const char*)(F.ws + WS_ACT), S, E);
}
__device__ __forceinline__ void p_final(const Frame& F) {
    const int lane = F.lane;
    for (int r = F.bx * 8 + F.wid; r < NBATCH * SEQ; r += F.G * 8) { const int b = r >> 12, t = r & 4095, row = b * TPB + CTXL + t;
        f32x4 x[4]; load_row_x(F, 2, row, x);
        float* op = F.out + (size_t)r * DM;
#pragma unroll
        for (int i = 0; i < 4; ++i) *(f32x4*)(op + lane * 4 + 256 * i) = x[i]; }
}

#if MK_DBG
__device__ __forceinline__ void dbg_acc(const Frame& F, int chk, float got, float ref) {
    float* d = (float*)(F.ws + WS_DBG);
    float e = got - ref; float n = e * e, q = ref * ref;
    if (!(n == n) || n > 1e30f) n = 1e30f;
    atomicAdd(d + 2 * chk, n); atomicAdd(d + 2 * chk + 1, q);
}
__device__ __forceinline__ unsigned hash_u(unsigned x) { x ^= x >> 16; x *= 0x7feb352du; x ^= x >> 15; x *= 0x846ca68bu; x ^= x >> 16; return x; }
__device__ void dbg_check_01(const Frame& F, int l) {
    const int gt = F.bx * NTHR + F.tid;
    { const unsigned hsh = hash_u(gt * 2654435761u + 17u + l); const int r = hsh % 9, j = (hsh >> 8) % 6144; float s = 0.f;
      for (int k = 0; k < 1024; ++k) { const float v = r < 8 ? F.in[I_C][r * 1024 + k] : F.in[I_CCTX][k]; s += siluf_(v) * F.in[I_WMOD][((size_t)l * 1024 + k) * 6144 + j]; }
      s += F.in[I_BMOD][l * 6144 + j];
      dbg_acc(F, 0, ((const float*)(F.ws + WS_MOD))[(size_t)(l * 9 + r) * 6144 + j], s); }
    LAS float* hrow = (LAS float*)F.lds; LAS float* red = hrow + 1024;
    const int row = hash_u(F.bx * 977u + 5u) % NROW;
    const float* xr = (const float*)(F.ws + WS_XRES) + (size_t)row * DM;
    float ss = 0.f; for (int k = F.tid; k < 1024; k += NTHR) ss += xr[k] * xr[k];
    ss = wave_sum(ss); if (F.lane == 0) red[F.wid] = ss; __syncthreads();
    float tot = 0.f; for (int w = 0; w < 8; ++w) tot += red[w];
    const float rstd = 1.0f / sqrtf(tot / 1024.f + EPSN);
    const float* mod = (const float*)(F.ws + WS_MOD) + (size_t)(l * 9 + row_mrow(row)) * 6144;
    for (int k = F.tid; k < 1024; k += NTHR) hrow[k] = xr[k] * rstd * F.in[I_N1G][l * 1024 + k] * (1.f + mod[1024 + k]) + mod[k];
    __syncthreads();
    for (int q = 0; q < 2; ++q) { const int n = hash_u(gt * 31u + q) % 3080; float s = 0.f;
        for (int k = 0; k < 1024; ++k) s += hrow[k] * F.in[I_WIN][((size_t)l * 1024 + k) * 3080 + n];
        float got;
        if (n >= 1536 && n < 1544) got = ((const float*)(F.ws + WS_DTRAW))[(size_t)row * 8 + n - 1536];
        else got = bf2f(((const bf16_t*)(F.ws + WS_PROJ))[(size_t)row * NPROJ + (n < 1536 ? n : n - 8)]);
        dbg_acc(F, 1, got, s); }
    __syncthreads();
}
__device__ void dbg_check_2(const Frame& F, int l) {
    LAS float* qh = (LAS float*)F.lds;
    LAS float* w = qh + 128;
    LAS float* red = w + 2 * TPB;
    LAS float* ov = red + 64;
    const bf16_t* proj = (const bf16_t*)(F.ws + WS_PROJ);
    const unsigned hs = hash_u(F.bx * 7919u + 13u + l);
    const int b = hs & 7, h = (hs >> 3) & 3; int pos = (hs >> 5) % TPB; if (l == 1 && pos < CTXL) pos += CTXL;
    const bool lat = pos >= CTXL; const int nk = lat ? TPB : CTXL; const int row = b * TPB + pos;
    const AttnConsts ac = attn_consts(F, l);
    if (F.tid < 128) { const int sub = F.tid >> 6, d = F.tid & 63; const bf16_t* src = proj + (size_t)row * NPROJ + C_Q + h * 128 + sub * 64; float ss = 0.f;
        for (int k = 0; k < 64; ++k) ss += bf2f(src[k]) * bf2f(src[k]);
        const float rstd = 1.0f / sqrtf(ss / 64.f + EPSN); const int dp = d ^ 32;
        float n = bf2f(src[d]) * rstd * F.in[I_QN][l * 64 + d], m = bf2f(src[dp]) * rstd * F.in[I_QN][l * 64 + dp];
        if (lat) { const int tp = pos - CTXL, i = d & 31; const float ang = (float)((i < 16) ? (tp >> 6) : (tp & 63)) * powf(10000.f, -(float)(i & 15) / 16.f);
            n = (d < 32) ? n * cosf(ang) - m * sinf(ang) : n * cosf(ang) + m * sinf(ang); }
        qh[F.tid] = n; }
    __syncthreads();
    for (int j = F.tid; j < nk; j += NTHR) {
        for (int sub = 0; sub < 2; ++sub) { const bf16_t* src = proj + (size_t)(b * TPB + j) * NPROJ + C_K + h * 128 + sub * 64; float ss = 0.f;
            for (int k = 0; k < 64; ++k) ss += bf2f(src[k]) * bf2f(src[k]);
            const float rstd = 1.0f / sqrtf(ss / 64.f + EPSN); float dot = 0.f;
            for (int i = 0; i < 32; ++i) { float n1 = bf2f(src[i]) * rstd * F.in[I_KN][l * 64 + i], n2 = bf2f(src[i + 32]) * rstd * F.in[I_KN][l * 64 + i + 32];
                if (j >= CTXL) { const int tp = j - CTXL; const float ang = (float)((i < 16) ? (tp >> 6) : (tp & 63)) * powf(10000.f, -(float)(i & 15) / 16.f); const float cs = cosf(ang), sn = sinf(ang);
                    const float o1 = n1 * cs - n2 * sn, o2 = n2 * cs + n1 * sn; n1 = o1; n2 = o2; }
                dot += qh[sub * 64 + i] * n1 + qh[sub * 64 + i + 32] * n2; }
            w[sub * TPB + j] = dot * 0.125f; } }
    __syncthreads();
    float inv[2];
    for (int sub = 0; sub < 2; ++sub) {
        float mx = -1e30f; for (int j = F.tid; j < nk; j += NTHR) mx = fmaxf(mx, w[sub * TPB + j]);
        for (int o = 32; o >= 1; o >>= 1) mx = fmaxf(mx, __shfl_xor(mx, o));
        if (F.lane == 0) red[F.wid] = mx; __syncthreads();
        mx = red[0]; for (int k = 1; k < 8; ++k) mx = fmaxf(mx, red[k]); __syncthreads();
        float sm = 0.f; for (int j = F.tid; j < nk; j += NTHR) { const float e = expf(w[sub * TPB + j] - mx); w[sub * TPB + j] = e; sm += e; }
        sm = wave_sum(sm); if (F.lane == 0) red[F.wid] = sm; __syncthreads();
        sm = 0.f; for (int k = 0; k < 8; ++k) sm += red[k]; __syncthreads();
        inv[sub] = 1.0f / sm; }
    if (F.tid < 128) { float o = 0.f;
        for (int j = 0; j < nk; ++j) o += (w[j] * inv[0] - ac.lam * w[TPB + j] * inv[1]) * bf2f(proj[(size_t)(b * TPB + j) * NPROJ + C_V + h * 128 + F.tid]);
        ov[F.tid] = o; }
    __syncthreads();
    if (F.tid < 128) { float ss = 0.f; for (int k = 0; k < 128; ++k) ss += ov[k] * ov[k];
        const float ref = ov[F.tid] / sqrtf(ss / 128.f + EPSN) * F.in[I_SUBG][l * 128 + F.tid] * (1.f - ac.lam_init);
        dbg_acc(F, 2, bf2f(((const bf16_t*)(F.ws + WS_YMIX))[(size_t)row * DM + 512 + h * 128 + F.tid]), ref); }
    __syncthreads();
}
__device__ __forceinline__ void dbg_acc2(const Frame& F, int chk, float num, float den) {
    num = wave_sum(num); den = wave_sum(den);
    if (F.lane == 0) { if (!(num == num) || num > 1e30f) num = 1e30f; float* d = (float*)(F.ws + WS_DBG); atomicAdd(d + 2 * chk, num); atomicAdd(d + 2 * chk + 1, den); }
}
__device__ __forceinline__ float dbg_px(const Frame& F, int b, int pos, int col, int seg_lo, int seg_hi) {
    return (pos >= seg_lo && pos < seg_hi) ? bf2f(((const bf16_t*)(F.ws + WS_PROJ))[(size_t)(b * TPB + pos) * NPROJ + col]) : 0.f; }
__device__ void dbg_check_3(const Frame& F, int l) {
    LAS float* A = (LAS float*)F.lds;
    const unsigned hs = hash_u(F.bx * 131u + 7u + l); const int b = hs & 7, ch = (hs >> 3) & 255, h = ch >> 6, cj = ch & 63;
    for (int pos = F.tid; pos < TPB; pos += NTHR) { const int seg_lo = pos < CTXL ? 0 : CTXL, seg_hi = pos < CTXL ? CTXL : TPB;
        float da0 = 0.f, dx0 = 0.f, da1 = 0.f, dx1 = 0.f, xself = 0.f;
        for (int i = 0; i < 64; ++i) { const int ci = h * 64 + i; float xc = F.in[I_LCB][l * 256 + ci];
            for (int j = 0; j < 4; ++j) xc += F.in[I_LCW][(l * 4 + j) * 256 + ci] * dbg_px(F, b, pos + j - 2, C_LX + ci, seg_lo, seg_hi);
            if (i == cj) xself = xc;
            da0 += xc * F.in[I_LWA][(size_t)(((l * 2 + 0) * 4 + h) * 64 + i) * 64 + cj]; dx0 += xc * F.in[I_LWX][(size_t)(((l * 2 + 0) * 4 + h) * 64 + i) * 64 + cj];
            da1 += xc * F.in[I_LWA][(size_t)(((l * 2 + 1) * 4 + h) * 64 + i) * 64 + cj]; dx1 += xc * F.in[I_LWX][(size_t)(((l * 2 + 1) * 4 + h) * 64 + i) * 64 + cj]; }
        for (int dir = 0; dir < 2; ++dir) { const int pi = (l * 2 + dir) * 256 + ch; const float da = dir ? da1 : da0, dx = dir ? dx1 : dx0;
            const float r = 1.f / (1.f + expf(-(da + F.in[I_LBA][pi]))), ii = 1.f / (1.f + expf(-(dx + F.in[I_LBX][pi])));
            const float la = -8.f * r * log1pf(expf(-F.in[I_LLAM][pi])); A[(2 * dir) * TPB + pos] = expf(la); A[(2 * dir + 1) * TPB + pos] = sqrtf(-expm1f(2.f * la)) * ii * xself; } }
    __syncthreads();
    if (F.tid == 0) { float hh = 0.f; for (int pos = 0; pos < TPB; ++pos) { hh = A[pos] * hh + A[TPB + pos]; A[TPB + pos] = hh; } }
    if (F.tid == 64) { float hh = 0.f; for (int pos = CTXL - 1; pos >= 0; --pos) { hh = A[2 * TPB + pos] * hh + A[3 * TPB + pos]; A[3 * TPB + pos] = hh; }
        for (int pos = TPB - 1; pos >= CTXL; --pos) { hh = A[2 * TPB + pos] * hh + A[3 * TPB + pos]; A[3 * TPB + pos] = hh; } }
    __syncthreads();
    float num = 0.f, den = 0.f;
    for (int pos = F.tid; pos < TPB; pos += NTHR) { const size_t row = (size_t)b * TPB + pos; const float g = bf2f(((const bf16_t*)(F.ws + WS_PROJ))[row * NPROJ + C_LG + ch]);
        const float ref = 0.5f * g * (1.f + tanhf(0.7978845608f * (g + 0.044715f * g * g * g))) * (A[TPB + pos] + A[3 * TPB + pos]);
        const float got = bf2f(((const bf16_t*)(F.ws + WS_YMIX))[row * DM + ch]); num += (got - ref) * (got - ref); den += ref * ref; }
    dbg_acc2(F, 3, num, den);
    __syncthreads();
}
__device__ __forceinline__ float dbg_convsilu(const Frame& F, int l, int b, int pos, int col, int cch) {
    const int seg_lo = pos < CTXL ? 0 : CTXL, seg_hi = pos < CTXL ? CTXL : TPB; float v = F.in[I_SCB][l * 768 + cch];
    for (int j = 0; j < 4; ++j) v += F.in[I_SCW][(l * 4 + j) * 768 + cch] * dbg_px(F, b, pos + j - 2, col, seg_lo, seg_hi);
    return v / (1.f + expf(-v)); }
__device__ void dbg_check_45(const Frame& F, int l) {
    LAS float* yp = (LAS float*)F.lds;
    const unsigned hs = hash_u(F.bx * 733u + 3u + l); const int b = hs & 7, h = (hs >> 3) & 3, p = (hs >> 5) & 63, g = h >> 1;
    if (F.tid < 256) { const int dir = F.tid >> 7, n = F.tid & 127; float st = 0.f;
        const float a = -expf(F.in[I_SALOG][l * 8 + dir * 4 + h]), bias = F.in[I_SDTB][l * 8 + dir * 4 + h];
        for (int s2 = 0; s2 < TPB; ++s2) { const int pos = dir ? (s2 < CTXL ? CTXL - 1 - s2 : TPB - 1 - (s2 - CTXL)) : s2;
            const float xs = dbg_convsilu(F, l, b, pos, C_XS + h * 64 + p, h * 64 + p), bn = dbg_convsilu(F, l, b, pos, C_BM + g * 128 + n, 256 + g * 128 + n), cn = dbg_convsilu(F, l, b, pos, C_CM + g * 128 + n, 512 + g * 128 + n);
            const float draw = ((const float*)(F.ws + WS_DTRAW))[(size_t)(b * TPB + pos) * 8 + dir * 4 + h] + bias; const float dt = draw > 20.f ? draw : log1pf(expf(draw));
            st = expf(dt * a) * st + bn * dt * xs; const float part = wave_sum(cn * st); if (F.lane == 0) yp[F.wid * TPB + pos] = part; } }
    __syncthreads();
    float num = 0.f, den = 0.f;
    for (int pos = F.tid; pos < TPB; pos += NTHR) { const size_t row = (size_t)b * TPB + pos; const float xs = dbg_convsilu(F, l, b, pos, C_XS + h * 64 + p, h * 64 + p);
        const float z = bf2f(((const bf16_t*)(F.ws + WS_PROJ))[row * NPROJ + C_SZ + h * 64 + p]);
        const float ref = (yp[pos] + yp[TPB + pos] + yp[2 * TPB + pos] + yp[3 * TPB + pos] + F.in[I_SD][l * 4 + h] * xs) * (z / (1.f + expf(-z)));
        const float got = ((const float*)(F.ws + WS_YPRE))[row * 256 + h * 64 + p]; num += (got - ref) * (got - ref); den += ref * ref; }
    dbg_acc2(F, 4, num, den);
    { const int row = hash_u((F.bx * 8 + F.wid) * 977u + 11u) % NROW; const float* yr = (const float*)(F.ws + WS_YPRE) + (size_t)row * 256; float v[4], ss = 0.f;
      for (int i = 0; i < 4; ++i) { v[i] = yr[F.lane + 64 * i]; ss += v[i] * v[i]; }
      ss = wave_sum(ss); const float rs = 1.f / sqrtf(ss / 256.f + EPSN); float n5 = 0.f, d5 = 0.f;
      for (int i = 0; i < 4; ++i) { const float ref = v[i] * rs * F.in[I_SNG][l * 256 + F.lane + 64 * i], got = bf2f(((const bf16_t*)(F.ws + WS_YMIX))[(size_t)row * DM + 256 + F.lane + 64 * i]); n5 += (got - ref) * (got - ref); d5 += ref * ref; }
      dbg_acc2(F, 5, n5, d5); }
    __syncthreads();
}
__device__ void dbg_check_6(const Frame& F, int l) {
    const int gt = F.bx * NTHR + F.tid; const unsigned hs = hash_u(gt * 2246822519u + 3u);
    const int row = hs % NROW, n = (hs >> 16) & 1023; float sacc = 0.f;
    for (int k = 0; k < 1024; ++k) sacc += bf2f(((const bf16_t*)(F.ws + WS_YMIX))[(size_t)row * DM + k]) * F.in[I_WOUT][((size_t)l * 1024 + k) * 1024 + n];
    const float ref = row_input(F, row)[n] + ((const float*)(F.ws + WS_MOD))[(size_t)(l * 9 + row_mrow(row)) * 6144 + 2 * 1024 + n] * sacc;
    dbg_acc2(F, 6, (((const float*)(F.ws + WS_XRES))[(size_t)row * DM + n] - ref) * (((const float*)(F.ws + WS_XRES))[(size_t)row * DM + n] - ref), ref * ref);
}
__device__ void dbg_check_78(const Frame& F, int l) {
    LAS float* hrow = (LAS float*)F.lds; LAS float* red = hrow + 1024; LAS float* lg = red + 16;
    const int row = hash_u(F.bx * 1597u + 29u) % NROW;
    const float* xr = (const float*)(F.ws + WS_XRES) + (size_t)row * DM;
    float ss = 0.f; for (int k = F.tid; k < 1024; k += NTHR) ss += xr[k] * xr[k];
    ss = wave_sum(ss); if (F.lane == 0) red[F.wid] = ss; __syncthreads();
    float tot = 0.f; for (int w = 0; w < 8; ++w) tot += red[w];
    const float rstd = 1.0f / sqrtf(tot / 1024.f + EPSN);
    const float* mod = (const float*)(F.ws + WS_MOD) + (size_t)(l * 9 + row_mrow(row)) * 6144;
    float num = 0.f, den = 0.f;
    for (int k = F.tid; k < 1024; k += NTHR) { const float h = xr[k] * rstd * F.in[I_N2G][l * 1024 + k] * (1.f + mod[4 * 1024 + k]) + mod[3 * 1024 + k]; hrow[k] = h;
        const float got = bf2f(((const bf16_t*)(F.ws + WS_H))[(size_t)row * DM + k]); num += (got - h) * (got - h); den += h * h; }
    __syncthreads();
    if (F.tid < 32) { float a = F.in[I_RB][l * 32 + F.tid]; for (int k = 0; k < 1024; ++k) a += hrow[k] * F.in[I_RW][((size_t)l * 1024 + k) * 32 + F.tid]; lg[F.tid] = a; }
    __syncthreads();
    if (F.tid == 0) { LAS float* sv = lg + 32; LAS int* se = (LAS int*)(lg + 40); unsigned used = 0u;
        for (int r = 0; r < 4; ++r) { float m = -1e30f; int bi = 0; for (int j = 0; j < 32; ++j) if (!((used >> j) & 1u) && lg[j] > m) { m = lg[j]; bi = j; } used |= 1u << bi; sv[r] = m; se[r] = bi; }
        float sm = 0.f; for (int r = 0; r < 4; ++r) sm += expf(sv[r] - sv[0]);
        float n8 = 0.f;
        for (int r = 0; r < 4; ++r) { const float ref = expf(sv[r] - sv[0]) / sm, got = ((const float*)(F.ws + WS_TOKG))[(size_t)row * 4 + r]; num += (got - ref) * (got - ref); den += ref * ref;
            n8 += (((const int*)(F.ws + WS_TOKE))[(size_t)row * 4 + r] != se[r]) ? 1.f : 0.f; }
        float* d = (float*)(F.ws + WS_DBG); atomicAdd(d + 16, n8); atomicAdd(d + 17, 4.f * 1000.f); }
    dbg_acc2(F, 7, num, den);
    __syncthreads();
}
__device__ void dbg_check_9(const Frame& F, int l) {
    LAS float* hrow = (LAS float*)F.lds; LAS float* act = hrow + 1024;
    const unsigned hs = hash_u(F.bx * 2971u + 41u); int row = hs % NROW; if (l == 1 && (row % TPB) < CTXL) row += CTXL; const int r = (hs >> 20) & 3, slot = row * 4 + r;
    const int e = ((const int*)(F.ws + WS_TOKE))[slot]; const float gate = ((const float*)(F.ws + WS_TOKG))[slot];
    for (int k = F.tid; k < 1024; k += NTHR) hrow[k] = bf2f(((const bf16_t*)(F.ws + WS_H))[(size_t)row * DM + k]);
    __syncthreads();
    const float* wgu = F.in[I_WGU] + ((size_t)l * 32 + e) * 1024 * 2048; const float* bgu = F.in[I_BGU] + ((size_t)l * 32 + e) * 2048;
    for (int j = F.tid; j < 1024; j += NTHR) { float g = bgu[2 * j], u = bgu[2 * j + 1];
        for (int k = 0; k < 1024; ++k) { const f32x2 w = *(const f32x2*)(wgu + (size_t)k * 2048 + 2 * j); g += hrow[k] * w.x; u += hrow[k] * w.y; }
        g = fminf(g, 7.f); u = fminf(fmaxf(u, -7.f), 7.f); act[j] = (u + 1.f) * g / (1.f + expf(-1.702f * g)); }
    __syncthreads();
    const float* wd = F.in[I_WD] + ((size_t)l * 32 + e) * 1024 * 1024; float num = 0.f, den = 0.f;
    for (int n = F.tid; n < 1024; n += NTHR) { float y = F.in[I_BD][((size_t)l * 32 + e) * 1024 + n]; for (int j = 0; j < 1024; ++j) y += act[j] * wd[(size_t)j * 1024 + n];
        y *= gate; const float got = bf2f(((const bf16_t*)(F.ws + WS_YSLOT))[(size_t)slot * DM + n]); num += (got - y) * (got - y); den += y * y; }
    dbg_acc2(F, 9, num, den);
    __syncthreads();
}
__device__ void dbg_report(const Frame& F, int nchk) {
    const float* d = (const float*)(F.ws + WS_DBG);
    int bad = -1; float rel = 0.f;
    for (int i = 0; i < nchk; ++i) { const float n = d[2 * i], q = d[2 * i + 1]; float r = (q > 0.f) ? sqrtf(n / q) : 1e9f; if (!(r == r)) r = 1e9f; if (r > 0.03f) { bad = i; rel = r; break; } }
    float V = 0.f;
    if (bad >= 0) { float m = 5.f + log10f(rel); m = m < 1.f ? 1.f : (m > 9.9f ? 9.9f : m); V = m * powf(10.f, (float)(3 + bad)); }
    else return;
    for (size_t i = (size_t)F.bx * NTHR + F.tid; i < (size_t)NBATCH * SEQ * DM; i += (size_t)F.G * NTHR) F.out[i] = V;
}
#endif

#if MK_DBG
__global__ void __launch_bounds__(NTHR) hymba_dbg(Args args) {
    extern __shared__ __attribute__((aligned(16))) unsigned char lds_raw[];
    Frame F; F.in = args.in; F.in0 = args.in; F.out = args.out; F.ws = args.ws; F.ws0 = args.ws; F.lds = (LAS unsigned char*)lds_raw;
    F.tid = threadIdx.x; F.lane = F.tid & 63; F.wid = __builtin_amdgcn_readfirstlane(F.tid >> 6); F.G = gridDim.x; F.bx = blockIdx.x;
    const int lo = args.lo, hi = args.hi;
    if (lo == 1001) dbg_check_01(F, hi);
    if (lo == 1002) dbg_check_2(F, hi);
    if (lo == 1003) dbg_check_3(F, hi);
    if (lo == 1004) dbg_check_45(F, hi);
    if (lo == 1006) dbg_check_6(F, hi);
    if (lo == 1007) dbg_check_78(F, hi);
    if (lo == 1009) dbg_check_9(F, hi);
    if (lo == 1099) dbg_report(F, hi);
}
#endif

__global__ void __launch_bounds__(NTHR, 2) hymba_fwd(Args args) {
    extern __shared__ __attribute__((aligned(16))) unsigned char lds_raw[];
    Frame F; F.in = args.in; F.in0 = args.in; F.out = args.out; F.ws = args.ws; F.ws0 = args.ws; F.lds = (LAS unsigned char*)lds_raw;
    F.tid = threadIdx.x; F.lane = F.tid & 63; F.wid = __builtin_amdgcn_readfirstlane(F.tid >> 6); F.G = gridDim.x; F.bx = blockIdx.x;
    const int lo = args.lo, hi = args.hi;
#define IN(k) (lo <= (k) && (k) < hi)
#define BOTH(k) (IN(k) && IN((k) + 1))
#if MK_ONE_LAUNCH
    volatile LAS unsigned* misc = (volatile LAS unsigned*)(F.lds + LDS_MISC);
    if (F.tid < 4) misc[F.tid] = 0u;
    __syncthreads();
    XcdBarrier bar = xcd_barrier_post((unsigned*)(F.ws + WS_BAR), misc);
#define GRID_BAR() xcd_barrier(bar)
#else
#define GRID_BAR() do {} while (0)
#endif
    if (IN(0)) { F.refresh(); p0_prologue(F); if (BOTH(0)) GRID_BAR(); }
    for (int l = 0; l < 2; ++l) {
        const int pb = 1 + 9 * l;
        if (IN(pb + 0)) { F.refresh(); p_norm1(F, l); if (BOTH(pb + 0)) GRID_BAR(); }
        if (IN(pb + 1)) { F.refresh(); p_inproj(F, l); if (BOTH(pb + 1)) GRID_BAR(); }
        if (IN(pb + 2)) { F.refresh(); p_post(F, l); if (BOTH(pb + 2)) GRID_BAR(); }
        if (IN(pb + 3)) { F.refresh(); p_attn(F, l); if (BOTH(pb + 3)) GRID_BAR(); }
        if (IN(pb + 4)) { F.refresh(); p_mix2(F, l); if (BOTH(pb + 4)) GRID_BAR(); }
        if (IN(pb + 5)) { F.refresh(); p_outproj(F, l); if (BOTH(pb + 5)) GRID_BAR(); }
        if (IN(pb + 6)) { F.refresh(); p_norm2(F, l); if (BOTH(pb + 6)) GRID_BAR(); }
        if (IN(pb + 7)) { F.refresh(); p_moe_gu(F, l); if (BOTH(pb + 7)) GRID_BAR(); }
        if (IN(pb + 8)) { F.refresh(); p_moe_down(F, l); if (BOTH(pb + 8)) GRID_BAR(); }
    }
    if (IN(19)) { F.refresh(); p_final(F); }
#undef IN
#undef BOTH
}

extern "C" void kernel_launch(void* const* d_in, const int* in_sizes, int n_in, void* d_out, int out_size, void* d_ws, size_t ws_size, hipStream_t stream) {
    static int grid = 0;
    if (grid == 0) {
        if (n_in != N_IN || out_size != NBATCH * SEQ * DM || ws_size < WS_END) { fprintf(stderr, "kernel_launch: unexpected shapes (n_in %d, out %d, ws %zu < %zu)\n", n_in, out_size, ws_size, (size_t)WS_END); grid = -1; return; }
        int dev = 0, cus = 0;
        if (hipGetDevice(&dev) != hipSuccess || hipDeviceGetAttribute(&cus, hipDeviceAttributeMultiprocessorCount, dev) != hipSuccess) { grid = -1; return; }
        if (hipFuncSetAttribute((const void*)hymba_fwd, hipFuncAttributeMaxDynamicSharedMemorySize, LDS_BYTES) != hipSuccess) { fprintf(stderr, "kernel_launch: hipFuncSetAttribute failed\n"); grid = -1; return; }
#if MK_DBG
        (void)hipFuncSetAttribute((const void*)hymba_dbg, hipFuncAttributeMaxDynamicSharedMemorySize, LDS_BYTES);
#endif
        int per_cu = 0;
        if (hipOccupancyMaxActiveBlocksPerMultiprocessor(&per_cu, (const void*)hymba_fwd, NTHR, LDS_BYTES) != hipSuccess || per_cu < 1) fprintf(stderr, "kernel_launch: occupancy query says %d\n", per_cu);
        (void)hipGetLastError();
        grid = (cus / 8) * 8;
        if (grid < 8) grid = 8;
    }
    if (grid < 0) return;
    (void)hipMemsetAsync(d_ws, 0, WS_ZERO_END, stream);
    Args a{};
    for (int i = 0; i < N_IN; ++i) a.in[i] = (const float*)d_in[i];
    a.out = (float*)d_out; a.ws = (unsigned char*)d_ws;
    auto launch = [&](int lo, int hi) { a.lo = lo; a.hi = hi;
#if MK_DBG
        if (lo >= 1000) { hipLaunchKernelGGL(hymba_dbg, dim3(grid), dim3(NTHR), LDS_BYTES, stream, a); return; }
#endif
        hipLaunchKernelGGL(hymba_fwd, dim3(grid), dim3(NTHR), LDS_BYTES, stream, a); };
#if MK_ONE_LAUNCH
    launch(0, 20);
#else
    const int last = MK_LAST_PHASE;
    for (int p = 0; p <= last; ++p) {
        launch(p, p + 1);
#if MK_DBG
        if (p == 2) launch(1001, 0);
        if (p == 4) launch(1002, 0);
        if (p == 5) { launch(1003, 0); launch(1004, 0); }
        if (p == 6) launch(1006, 0);
        if (p == 7) launch(1007, 0);
        if (p == 9) launch(1009, 0);
#endif
    }
#if MK_DBG
    launch(1099, 10);
#endif
#endif
}
```

```cpp
#include <hip/hip_runtime.h>
#include <stdint.h>
#include <stdio.h>

#ifndef MK_ONE_LAUNCH
#define MK_ONE_LAUNCH 1
#endif
#ifndef MK_DBG
#define MK_DBG 0
#endif
#ifndef MK_PA
#define MK_PA -1
#endif
#ifndef MK_PB
#define MK_PB -1
#endif
#ifndef MK_DUP
#define MK_DUP -1
#endif
#ifndef MK_SLACK
#define MK_SLACK 1
#endif
#ifndef MK_LAST_PHASE
#define MK_LAST_PHASE 21
#endif

#define LAS __attribute__((address_space(3)))
typedef unsigned short bf16_t;
typedef short bf16x8 __attribute__((ext_vector_type(8)));
typedef float f32x4 __attribute__((ext_vector_type(4)));
typedef float f32x2 __attribute__((ext_vector_type(2)));
typedef float f32x16 __attribute__((ext_vector_type(16)));
typedef unsigned u32x4 __attribute__((ext_vector_type(4)));
typedef unsigned u32x2 __attribute__((ext_vector_type(2)));

constexpr int DM = 1024, NBATCH = 8, SEQ = 4096, CTXL = 256, TPB = SEQ + CTXL, NROW = NBATCH * TPB;
constexpr int NPROJ = 3072;
constexpr int C_LG = 0, C_LX = 256, C_SZ = 512, C_XS = 768, C_BM = 1024, C_CM = 1280, C_Q = 1536, C_K = 2048, C_V = 2560;
constexpr int NEXP = 32, DEXP = 1024;
constexpr float EPSN = 1e-6f;
constexpr int LDS_BYTES = 160 * 1024, LDS_MISC = LDS_BYTES - 256;
constexpr int NTHR = 512;

enum { I_X = 0, I_C, I_CTX, I_CCTX, I_WMOD, I_BMOD, I_N1G, I_N2G, I_WIN, I_WOUT, I_LCW, I_LCB, I_LWA, I_LBA, I_LWX, I_LBX, I_LLAM,
       I_SCW, I_SCB, I_SALOG, I_SDTB, I_SD, I_SNG, I_QN, I_KN, I_LAMQ, I_LAMK, I_SUBG, I_RW, I_RB, I_WGU, I_BGU, I_WD, I_BD, N_IN };

constexpr size_t al256(size_t x) { return (x + 255) & ~(size_t)255; }
constexpr size_t WS_BAR = 0;
constexpr size_t WS_DBG = 16384;
constexpr size_t WS_CNT = WS_DBG + 4096;
constexpr size_t WS_ZERO_END = WS_CNT + 1024;
constexpr size_t WS_MOD = al256(WS_ZERO_END);
constexpr size_t WS_WDT = WS_MOD + al256((size_t)2 * 9 * 6144 * 4);
constexpr size_t WS_WIN = WS_WDT + al256((size_t)2 * 8 * 1024 * 4);
constexpr size_t WS_WOUT = WS_WIN + (size_t)2 * NPROJ * 1024 * 2;
constexpr size_t WS_WGU = WS_WOUT + (size_t)2 * 1024 * 1024 * 2;
constexpr size_t WS_WD = WS_WGU + (size_t)2 * 32 * 2048 * 1024 * 2;
constexpr size_t WS_XRES = WS_WD + (size_t)2 * 32 * 1024 * 1024 * 2;
constexpr size_t WS_H = WS_XRES + (size_t)NROW * 1024 * 4;
constexpr size_t WS_DTRAW = WS_H + (size_t)NROW * 1024 * 2;
constexpr size_t WS_PROJ = WS_DTRAW + al256((size_t)NROW * 8 * 4);
constexpr size_t WS_QB = WS_PROJ + (size_t)NROW * NPROJ * 2;
constexpr size_t WS_KB = WS_QB + (size_t)NROW * 512 * 2;
constexpr size_t WS_VT = WS_KB + (size_t)NROW * 512 * 2;
constexpr size_t WS_ACT = WS_PROJ;
constexpr size_t WS_YMIX = WS_VT + (size_t)NROW * 512 * 2;
constexpr size_t WS_LRUS = WS_YMIX + (size_t)NROW * 1024 * 2;
constexpr size_t WS_LRUC = WS_LRUS + (size_t)8 * 136 * 2 * 256 * 8;
constexpr size_t WS_SSDS = WS_LRUC + (size_t)8 * 136 * 2 * 256 * 4;
constexpr size_t WS_SSDI = WS_SSDS + (size_t)8 * 34 * 8 * 8192 * 4;
constexpr size_t WS_SSDD = WS_SSDI + (size_t)8 * 34 * 8 * 8192 * 2;
constexpr size_t WS_TOKG = WS_SSDD + al256((size_t)8 * 34 * 8 * 4);
constexpr size_t WS_TOKE = WS_TOKG + (size_t)NROW * 4 * 4;
constexpr size_t WS_LIST = WS_TOKE + (size_t)NROW * 4 * 4;
constexpr size_t WS_LISTG = WS_LIST + (size_t)NEXP * NROW * 4;
constexpr size_t WS_YSLOT = WS_LISTG + (size_t)NEXP * NROW * 4;
constexpr size_t WS_YPRE = WS_YSLOT + (size_t)NROW * 4 * 1024 * 2;
constexpr size_t WS_CONV = WS_YPRE + (size_t)NROW * 256 * 4;
constexpr size_t WS_XBT = WS_CONV + (size_t)NROW * 1024 * 2;
constexpr size_t WS_END = WS_XBT + (size_t)8 * 34 * 512 * 136 * 2;
static_assert((size_t)576 * 256 * 1024 * 2 <= WS_YMIX - WS_PROJ, "act alias");
static_assert(WS_END < (size_t)2000 * 1024 * 1024, "workspace");

struct Args { const float* in[N_IN]; float* out; unsigned char* ws; int lo, hi; };

#define XB_TMO      128
#define XB_XCNT(j)  (256  + 64 * (j))
#define XB_XSUB(j)  (1280 + 64 * (j))
#define XB_XGEN(j)  (2304 + 64 * (j))
#define XB_TOP      3328
#define XB_TOPGEN   3392
#define XCD_BAR_WORDS 3456
#define XB_SPIN_CAP (1u << 18)
__device__ __forceinline__ unsigned xb_ld(unsigned* p)              { return __hip_atomic_load(p, __ATOMIC_RELAXED, __HIP_MEMORY_SCOPE_AGENT); }
__device__ __forceinline__ unsigned xb_add(unsigned* p, unsigned v) { return __hip_atomic_fetch_add(p, v, __ATOMIC_RELAXED, __HIP_MEMORY_SCOPE_AGENT); }
__device__ __forceinline__ unsigned xb_xcc_id() { return (unsigned)__builtin_amdgcn_s_getreg((3 << 11) | 20) & 0xFu; }
#define XB_SPIN(cond, bar) do { unsigned _sp = 0; while (cond) { __builtin_amdgcn_s_sleep(1); \
    if ((++_sp & 255u) == 0u) { if (xb_ld(&(bar)[XB_TMO])) break; if (_sp > XB_SPIN_CAP) { atomicAdd(&(bar)[XB_TMO], 1u); break; } } } } while (0)
struct XcdBarrier { unsigned* bar; unsigned x; volatile LAS unsigned* st; int wave_s; };
__device__ __forceinline__ bool xb_thread0(int wave_s) { int l; asm volatile("v_mbcnt_lo_u32_b32 %0, -1, 0\n\tv_mbcnt_hi_u32_b32 %0, -1, %0" : "=v"(l)); return wave_s == 0 && l == 0; }
__device__ __forceinline__ XcdBarrier xcd_barrier_post(unsigned* bar, volatile LAS unsigned* st, int wave_s) {
    XcdBarrier b; b.bar = bar; b.x = xb_xcc_id(); b.st = st; b.wave_s = wave_s;
    if (xb_thread0(wave_s)) st[2] = xb_add(&bar[XB_XCNT(b.x)], 1u);
    return b;
}
__device__ __forceinline__ void xcd_barrier_complete(unsigned* bar, unsigned x, unsigned& nloc, unsigned& nx) {
    const unsigned G = gridDim.x * gridDim.y * gridDim.z;
    unsigned sum, cnt, mine, sp = 0u;
    for (;;) {
        sum = 0u; cnt = 0u; mine = 0u;
#pragma unroll
        for (unsigned j = 0; j < 16; ++j) { const unsigned c = xb_ld(&bar[XB_XCNT(j)]); sum += c; cnt += (c > 0u) ? 1u : 0u; mine = (j == x) ? c : mine; }
        if (sum == G) break;
        __builtin_amdgcn_s_sleep(1);
        if ((++sp & 255u) == 0u) { if (xb_ld(&bar[XB_TMO])) break; if (sp > XB_SPIN_CAP) { atomicAdd(&bar[XB_TMO], 1u); break; } }
    }
    nloc = mine > 0u ? mine : 1u; nx = cnt > 0u ? cnt : 1u;
}
__device__ __forceinline__ void xcd_barrier(const XcdBarrier& b) {
    asm volatile("s_waitcnt vmcnt(0)" ::: "memory");
    __syncthreads();
    if (xb_thread0(b.wave_s)) {
        unsigned* bar = b.bar;
        __builtin_amdgcn_s_waitcnt(0);
        unsigned nloc = b.st[0], nx = b.st[1];
        if (nloc == 0u) { xcd_barrier_complete(bar, b.x, nloc, nx); b.st[0] = nloc; b.st[1] = nx; }
        const unsigned old = xb_add(&bar[XB_XSUB(b.x)], 1u);
        const unsigned gen = old / nloc;
        if (old + 1u == (gen + 1u) * nloc) {
            __builtin_amdgcn_fence(__ATOMIC_RELEASE, "agent");
            asm volatile("s_waitcnt vmcnt(0)" ::: "memory");
            const unsigned og = xb_add(&bar[XB_TOP], 1u);
            const unsigned tg = og / nx;
            if (og + 1u == (tg + 1u) * nx) xb_add(&bar[XB_TOPGEN], 1u);
            else XB_SPIN(xb_ld(&bar[XB_TOPGEN]) == tg, bar);
            __builtin_amdgcn_fence(__ATOMIC_ACQUIRE, "agent");
            xb_add(&bar[XB_XGEN(b.x)], 1u);
            asm volatile("s_waitcnt vmcnt(0)" ::: "memory");
        } else {
            XB_SPIN(xb_ld(&bar[XB_XGEN(b.x)]) == gen, bar);
            __builtin_amdgcn_fence(__ATOMIC_ACQUIRE, "agent");
            asm volatile("s_waitcnt vmcnt(0)" ::: "memory");
        }
    }
    __syncthreads();
}

__device__ __forceinline__ unsigned cvt_pk_bf16(float lo, float hi) { unsigned r; asm("v_cvt_pk_bf16_f32 %0, %1, %2" : "=v"(r) : "v"(lo), "v"(hi)); return r; }
__device__ __forceinline__ bf16_t f2bf(float f) { return (bf16_t)(cvt_pk_bf16(f, 0.f) & 0xffffu); }
__device__ __forceinline__ float bf2f(bf16_t b) { return __uint_as_float(((unsigned)b) << 16); }
__device__ __forceinline__ float bflo(unsigned w) { return __uint_as_float(w << 16); }
__device__ __forceinline__ float bfhi(unsigned w) { return __uint_as_float(w & 0xffff0000u); }
__device__ __forceinline__ float wave_sum(float v) {
#pragma unroll
    for (int o = 32; o >= 1; o >>= 1) v += __shfl_xor(v, o);
    return v;
}
__device__ __forceinline__ float shfl_x(float v, int lane, int o) { return __uint_as_float((unsigned)__builtin_amdgcn_ds_bpermute((lane ^ o) << 2, (int)__float_as_uint(v))); }
template <int CTRL> __device__ __forceinline__ float dppf(float v) { return __uint_as_float((unsigned)__builtin_amdgcn_update_dpp(0, (int)__float_as_uint(v), CTRL, 0xf, 0xf, true)); }
struct OpAdd { static __device__ __forceinline__ float f(float a, float b) { return a + b; } };
struct OpMax { static __device__ __forceinline__ float f(float a, float b) { return fmaxf(a, b); } };
template <class Op> __device__ __forceinline__ float row16_red(float v) { v = Op::f(v, dppf<0xB1>(v)); v = Op::f(v, dppf<0x4E>(v)); v = Op::f(v, dppf<0x124>(v)); v = Op::f(v, dppf<0x128>(v)); return v; }
template <class Op> __device__ __forceinline__ float x16_red(float v) { const auto r = __builtin_amdgcn_permlane16_swap(__float_as_uint(v), __float_as_uint(v), false, false); return Op::f(__uint_as_float(r[0]), __uint_as_float(r[1])); }
template <class Op> __device__ __forceinline__ float x32_red(float v) { const auto r = __builtin_amdgcn_permlane32_swap(__float_as_uint(v), __float_as_uint(v), false, false); return Op::f(__uint_as_float(r[0]), __uint_as_float(r[1])); }
template <class Op> __device__ __forceinline__ float half32_red(float v) { return x16_red<Op>(row16_red<Op>(v)); }
template <class Op> __device__ __forceinline__ float wave64_red(float v) { return x32_red<Op>(half32_red<Op>(v)); }
__device__ __forceinline__ float wave_sum_l(float v, int) { return wave64_red<OpAdd>(v); }
__device__ __forceinline__ float sigmoidf_(float x) { return __builtin_amdgcn_rcpf(1.0f + __expf(-x)); }
__device__ __forceinline__ float siluf_(float x) { return x * __builtin_amdgcn_rcpf(1.0f + __expf(-x)); }
__device__ __forceinline__ float log1p_fast(float t) { return t < 0.01f ? t * (1.0f + t * (-0.5f + t * (1.0f / 3.0f))) : __logf(1.0f + t); }
__device__ __forceinline__ float softplusf_(float x) { return fmaxf(x, 0.f) + log1p_fast(__expf(-fabsf(x))); }
__device__ __forceinline__ float one_minus_exp(float x) { const float p = -x * (1.0f + x * (0.5f + x * (1.0f / 6.0f + x * (1.0f / 24.0f)))), e = 1.0f - __expf(x); return x > -0.05f ? p : e; }
__device__ __forceinline__ float tanh_fast(float x) { const float e = __expf(2.0f * fminf(x, 15.f)); return 1.0f - 2.0f * __builtin_amdgcn_rcpf(e + 1.0f); }

__device__ __forceinline__ void glds16_s(unsigned voff, const void* sbase, unsigned lds_addr) {
    unsigned sv;
    asm volatile("s_mov_b32 %0, m0\n\ts_mov_b32 m0, %3\n\ts_nop 0\n\tglobal_load_lds_dwordx4 %1, %2\n\ts_mov_b32 m0, %0"
                 : "=&s"(sv) : "v"(voff), "s"(sbase), "s"(lds_addr) : "memory");
}
__device__ __forceinline__ void glds4_v(const void* vaddr, unsigned lds_addr) {
    unsigned sv;
    asm volatile("s_mov_b32 %0, m0\n\ts_mov_b32 m0, %2\n\ts_nop 0\n\tglobal_load_lds_dword %1, off\n\ts_mov_b32 m0, %0"
                 : "=&s"(sv) : "v"(vaddr), "s"(lds_addr) : "memory");
}
__device__ __forceinline__ void st_wt(void* p, u32x2 v) { asm volatile("global_store_dwordx2 %0, %1, off sc1" :: "v"(p), "v"(v) : "memory"); }
__device__ __forceinline__ void st_wt(void* p, u32x4 v) { asm volatile("global_store_dwordx4 %0, %1, off sc1\n\ts_nop 1" :: "v"(p), "v"(v) : "memory"); }
__device__ __forceinline__ int tid_fresh(int wave_s) { int l; asm volatile("v_mbcnt_lo_u32_b32 %0, -1, 0\n\tv_mbcnt_hi_u32_b32 %0, -1, %0" : "=v"(l)); return wave_s * 64 + l; }
__device__ __forceinline__ float shfl_xor_l(float v, int lane, int o) { return __uint_as_float((unsigned)__builtin_amdgcn_ds_bpermute((lane ^ o) << 2, (int)__float_as_uint(v))); }
struct Frame {
    const float* const* in; float* out; unsigned char* ws; LAS unsigned char* lds;
    int tid, lane, wid, G, bx, wave_s;
    int gx, gj, gn;
    const float* const* in0; unsigned char* ws0;
    __device__ __forceinline__ void refresh() { const int t = tid_fresh(wave_s); tid = t; lane = t & 63; wid = wave_s;
        unsigned long long z; asm volatile("s_mov_b64 %0, 0" : "=s"(z)); in = (const float* const*)((const char*)in0 + z); ws = ws0 + z; }
};
__device__ __forceinline__ int row_mrow(int r) { const int b = r / TPB, pos = r - b * TPB; return pos < CTXL ? 8 : b; }
__device__ __forceinline__ const float* row_input(const Frame& F, int r) {
    const int b = r / TPB, pos = r - b * TPB;
    return pos < CTXL ? F.in[I_CTX] + ((size_t)b * CTXL + pos) * DM : F.in[I_X] + ((size_t)b * SEQ + (pos - CTXL)) * DM;
}

template <bool NT = false>
__device__ __forceinline__ void cvt_block(const Frame& F, const float* src, int ld, int k0, int c0, bf16_t* dst, int mode, int d0) {
    LAS float* tile = (LAS float*)F.lds;
    const int tid = F.tid;
#pragma unroll
    for (int i = 0; i < 4; ++i) {
        const int r = (tid >> 5) + 16 * i, c4 = (tid & 31) * 4;
        const f32x4 v = NT ? __builtin_nontemporal_load((const f32x4*)(src + (size_t)(k0 + r) * ld + c0 + c4)) : *(const f32x4*)(src + (size_t)(k0 + r) * ld + c0 + c4);
        *(LAS f32x4*)(tile + r * 132 + c4) = v;
    }
    __syncthreads();
    const int nl = tid >> 2, kq = tid & 3;
    int csrc, rho;
    if (mode == 1) { const int half = nl >> 6, jj = nl & 63, a0 = c0 >> 1; csrc = 2 * jj + half; rho = (a0 >> 7) * 256 + half * 128 + (a0 & 127) + jj; }
    else { csrc = nl; rho = d0 + nl; }
    unsigned w[8];
#pragma unroll
    for (int j = 0; j < 8; ++j) w[j] = cvt_pk_bf16(tile[(kq * 16 + 2 * j) * 132 + csrc], tile[(kq * 16 + 2 * j + 1) * 132 + csrc]);
    bf16_t* dp = dst + (size_t)rho * 1024 + k0 + kq * 16;
    if (NT) { __builtin_nontemporal_store((u32x4){w[0], w[1], w[2], w[3]}, (u32x4*)dp); __builtin_nontemporal_store((u32x4){w[4], w[5], w[6], w[7]}, (u32x4*)(dp + 8)); }
    else { *(u32x4*)dp = (u32x4){w[0], w[1], w[2], w[3]}; *(u32x4*)(dp + 8) = (u32x4){w[4], w[5], w[6], w[7]}; }
    __syncthreads();
}
__device__ __forceinline__ void mod_unit(const Frame& F, int l, int jb) {
    LAS float* sm = (LAS float*)F.lds;
    LAS float* red = sm + 9 * 1024;
    const int tid = F.tid;
    for (int idx = tid; idx < 9 * 1024; idx += NTHR) { const int r = idx >> 10, k = idx & 1023; const float v = r < 8 ? F.in[I_C][r * 1024 + k] : F.in[I_CCTX][k]; sm[idx] = siluf_(v); }
    __syncthreads();
    const int kg = tid >> 6, jj = tid & 63, j = jb * 64 + jj;
    float acc[9];
#pragma unroll
    for (int r = 0; r < 9; ++r) acc[r] = 0.f;
    const float* wp = F.in[I_WMOD] + (size_t)l * 1024 * 6144 + j;
#pragma unroll 8
    for (int k = kg * 128; k < kg * 128 + 128; ++k) {
        const float w = wp[(size_t)k * 6144];
#pragma unroll
        for (int r = 0; r < 9; ++r) acc[r] += sm[r * 1024 + k] * w;
    }
#pragma unroll
    for (int r = 0; r < 9; ++r) red[(kg * 9 + r) * 64 + jj] = acc[r];
    __syncthreads();
    float* mod = (float*)(F.ws + WS_MOD);
    for (int idx = tid; idx < 576; idx += NTHR) {
        const int r = idx >> 6, j2 = idx & 63; float s = 0.f;
#pragma unroll
        for (int g = 0; g < 8; ++g) s += red[(g * 9 + r) * 64 + j2];
        mod[(size_t)(l * 9 + r) * 6144 + jb * 64 + j2] = s + F.in[I_BMOD][l * 6144 + jb * 64 + j2];
    }
    __syncthreads();
}
constexpr int CVB_L = 8192 + 4096;
constexpr int SLK_IN = 2, SLK_OUT0 = 9;
constexpr int SLK_A = 8 * SLK_IN * 72, SLK_B = 8 * SLK_OUT0 * 28;
template <bool NT = false>
__device__ __forceinline__ void cvt_moe_blk(const Frame& F, int m) {
    const int l = m / CVB_L; int r = m - l * CVB_L;
    if (r < 8192) { const int e = r >> 8, rr = r & 255, tk = rr >> 4, tn = rr & 15;
        cvt_block<NT>(F, F.in[I_WGU] + ((size_t)l * 32 + e) * 1024 * 2048, 2048, tk * 64, tn * 128, (bf16_t*)(F.ws + WS_WGU) + ((size_t)l * 32 + e) * 2048 * 1024, 1, 0); }
    else { r -= 8192; const int e = r >> 7, rr = r & 127, tk = rr >> 3, tn = rr & 7;
        cvt_block<NT>(F, F.in[I_WD] + ((size_t)l * 32 + e) * 1024 * 1024, 1024, tk * 64, tn * 128, (bf16_t*)(F.ws + WS_WD) + ((size_t)l * 32 + e) * 1024 * 1024, 0, tn * 128); }
}
__device__ __forceinline__ bool slack_on(const Frame& F) { return MK_SLACK && F.G == 256; }
__device__ __forceinline__ void cvt_slack(const Frame& F, int first, int count, int sidx, int nsl) { for (int m = first + sidx; m < first + count; m += nsl) cvt_moe_blk<true>(F, m); }
__device__ __forceinline__ void p0_prologue(const Frame& F) {
    { float* wdt = (float*)(F.ws + WS_WDT);
      for (int i = F.bx * NTHR + F.tid; i < 2 * 8 * 1024; i += F.G * NTHR) { const int l = i >> 13, j = (i >> 10) & 7, k = i & 1023; wdt[i] = F.in[I_WIN][((size_t)l * 1024 + k) * 3080 + 1536 + j]; } }
    constexpr int NMOD = 192, PER_L = 384 + 128 + 8192 + 4096;
    for (int u = F.bx; u < NMOD + 2 * PER_L; u += F.G) {
        if (u < NMOD) { mod_unit(F, u / 96, u % 96); continue; }
        int r = u - NMOD; const int l = r / PER_L; r -= l * PER_L;
        if (r < 384) { const int tk = r / 24, tn = r % 24, d0 = tn * 128, c0 = d0 < 1536 ? d0 : d0 + 8;
            cvt_block(F, F.in[I_WIN] + (size_t)l * 1024 * 3080, 3080, tk * 64, c0, (bf16_t*)(F.ws + WS_WIN) + (size_t)l * NPROJ * 1024, 0, d0); }
        else if (r < 512) { r -= 384; const int tk = r / 8, tn = r % 8;
            cvt_block(F, F.in[I_WOUT] + (size_t)l * 1024 * 1024, 1024, tk * 64, tn * 128, (bf16_t*)(F.ws + WS_WOUT) + (size_t)l * 1024 * 1024, 0, tn * 128); }
        else { const int mb = r - 512;
            if (slack_on(F) && mb < (l == 0 ? SLK_A + SLK_B : SLK_A)) continue;
            cvt_moe_blk(F, l * CVB_L + mb); }
    }
}

__device__ __forceinline__ void load_row_x(const Frame& F, int l, int row, f32x4 (&x)[4]) {
    const int lane = F.lane;
    if (l == 0) { const float* p = row_input(F, row);
#pragma unroll
        for (int i = 0; i < 4; ++i) x[i] = *(const f32x4*)(p + lane * 4 + 256 * i);
    } else {
        const bf16_t* p = (const bf16_t*)(F.ws + WS_XRES) + (size_t)row * DM;
        const float* g2 = (const float*)(F.ws + WS_MOD) + (size_t)((l - 1) * 9 + row_mrow(row)) * 6144 + 5 * 1024;
        const bf16_t* ys = (const bf16_t*)(F.ws + WS_YSLOT) + (size_t)row * 4 * DM;
#pragma unroll
        for (int i = 0; i < 4; ++i) {
            const int c = lane * 4 + 256 * i; f32x4 s = (f32x4){0.f, 0.f, 0.f, 0.f};
#pragma unroll
            for (int k = 0; k < 4; ++k) { const u32x2 w = *(const u32x2*)(ys + (size_t)k * DM + c); s += (f32x4){bflo(w.x), bfhi(w.x), bflo(w.y), bfhi(w.y)}; }
            const u32x2 xw = *(const u32x2*)(p + c);
            x[i] = (f32x4){bflo(xw.x), bfhi(xw.x), bflo(xw.y), bfhi(xw.y)} + *(const f32x4*)(g2 + c) * s;
        }
    }
}
__device__ __forceinline__ void p_norm1(const Frame& F, int l) {
    LAS float* wdt = (LAS float*)F.lds;
    { const float* src = (const float*)(F.ws + WS_WDT) + (size_t)l * 8192; for (int i = F.tid; i < 8192; i += NTHR) wdt[i] = src[i]; }
    __syncthreads();
    const int lane = F.lane;
    const float* ng = F.in[I_N1G] + l * DM;
    f32x4 g[4];
#pragma unroll
    for (int i = 0; i < 4; ++i) g[i] = *(const f32x4*)(ng + lane * 4 + 256 * i);
    for (int row = F.bx * 8 + F.wid; row < NROW; row += F.G * 8) {
        f32x4 x[4]; load_row_x(F, l, row, x);
        bf16_t* xr = (bf16_t*)(F.ws + WS_XRES) + (size_t)row * DM;
        float ss = 0.f;
#pragma unroll
        for (int i = 0; i < 4; ++i) { if (l != 0) st_wt(xr + lane * 4 + 256 * i, (u32x2){cvt_pk_bf16(x[i][0], x[i][1]), cvt_pk_bf16(x[i][2], x[i][3])}); ss += x[i][0] * x[i][0] + x[i][1] * x[i][1] + x[i][2] * x[i][2] + x[i][3] * x[i][3]; }
        ss = wave_sum_l(ss, lane);
        const float rstd = __builtin_amdgcn_rsqf(ss * (1.0f / DM) + EPSN);
        const float* mod = (const float*)(F.ws + WS_MOD) + (size_t)(l * 9 + row_mrow(row)) * 6144;
        bf16_t* hp = (bf16_t*)(F.ws + WS_H) + (size_t)row * DM;
        float dt[8];
#pragma unroll
        for (int j = 0; j < 8; ++j) dt[j] = 0.f;
#pragma unroll
        for (int i = 0; i < 4; ++i) {
            const int c = lane * 4 + 256 * i;
            const f32x4 sh = *(const f32x4*)(mod + c), sc = *(const f32x4*)(mod + 1024 + c);
            const f32x4 h = x[i] * rstd * g[i] * (sc + 1.0f) + sh;
            st_wt(hp + c, (u32x2){cvt_pk_bf16(h[0], h[1]), cvt_pk_bf16(h[2], h[3])});
#pragma unroll
            for (int j = 0; j < 8; ++j) { const f32x4 w = *(LAS f32x4*)(wdt + j * 1024 + c); dt[j] += h[0] * w[0] + h[1] * w[1] + h[2] * w[2] + h[3] * w[3]; }
        }
#pragma unroll
        for (int j = 0; j < 8; ++j) dt[j] = wave_sum_l(dt[j], lane);
        if (lane == 0) { float* dp = (float*)(F.ws + WS_DTRAW) + (size_t)row * 8;
            *(f32x4*)dp = (f32x4){dt[0], dt[1], dt[2], dt[3]}; *(f32x4*)(dp + 4) = (f32x4){dt[4], dt[5], dt[6], dt[7]}; }
    }
    __syncthreads();
}

namespace gm {
constexpr int BM = 256, BK = 64, HALF = 128, HTB = HALF * BK * 2, STAGE_BYTES = 8 * HTB;
__device__ __forceinline__ int lds_byte(int r, int c) { const int st = (r >> 4) * 2 + (c >> 5), rr = r & 15, cc = c & 31, ob = rr * 64 + cc * 2; return st * 1024 + (ob ^ (((ob >> 9) & 1) << 5)); }
__device__ __forceinline__ void stage_rc(int b, int& R, int& C) { const int st = b / 1024, sb = b % 1024, swz = sb ^ (((sb >> 9) & 1) << 5); R = (st >> 1) * 16 + swz / 64; C = (st & 1) * 32 + (swz % 64) / 2; }
__device__ __forceinline__ int perm32(int rho) { const int n = rho >> 4, i = rho & 15; return 8 * (i >> 2) + 4 * n + (i & 3); }
struct GU { int m0, nrows, pn, e, rbg; const char* bptr; };

template <bool PERM, bool GATHER, class Sched, class Epi>
__device__ __forceinline__ void gemm_phase(LAS unsigned char* lds, const char* Abase, const Sched& S, const Epi& E, const int wave_s) {
    constexpr int K = 1024, nt = K / BK;
    constexpr size_t kstep = (size_t)(BK * 2), hstep = (size_t)HALF * K * 2;
    const int tid = tid_fresh(wave_s);
    __builtin_amdgcn_s_waitcnt(0x0F70);
    const int wid = wave_s, lane = tid & 63, wr = wid >> 2, wc = wid & 3, fr = lane & 15, fq = lane >> 4;
    unsigned voffB[2], voffA[2];
#pragma unroll
    for (int i = 0; i < 2; ++i) { int R, C; stage_rc(tid * 16 + i * 8192, R, C); const int Rb = PERM ? ((R & ~31) + perm32(R & 31)) : R; voffB[i] = (unsigned)(Rb * K + C) * 2u;
        voffA[i] = GATHER ? (unsigned)C * 2u : (unsigned)(R * K + C) * 2u; }
    const unsigned ldsw = (unsigned)wid * 1024u, lds0 = (unsigned)(unsigned long)lds;
    const int aoff = lds_byte(wr * 64 + fr, fq * 8), boff = lds_byte(wc * 32 + fr, fq * 8);
#define GM_SA(b, h) (((b) * 2 + (h)) * HTB)
#define GM_SB(b, h) ((4 + (b) * 2 + (h)) * HTB)
#define GM_STAGE(bufoff, gbase, voff) do { _Pragma("unroll") for (int _i = 0; _i < 2; ++_i) \
        glds16_s((voff)[_i], (const void*)(gbase), (unsigned)__builtin_amdgcn_readfirstlane((int)(lds0 + (unsigned)(bufoff) + ldsw + _i * 8192u))); } while (0)
#define GM_STAGE_A(bufoff, ub, pk, h, ko) do { _Pragma("unroll") for (int _i = 0; _i < 2; ++_i) { \
        if (GATHER) glds16_s((((pk)[_i] >> (16 * (h))) & 0xffffu) * (unsigned)(K * 2) + voffA[_i], (const void*)(Abase + (ko)), (unsigned)__builtin_amdgcn_readfirstlane((int)(lds0 + (unsigned)(bufoff) + ldsw + _i * 8192u))); \
        else glds16_s(voffA[_i], (const void*)((ub) + (ko) + (size_t)(h) * hstep), (unsigned)__builtin_amdgcn_readfirstlane((int)(lds0 + (unsigned)(bufoff) + ldsw + _i * 8192u))); } } while (0)
#define GM_LDA(dst, b, h) do { _Pragma("unroll") for (int m = 0; m < 4; ++m) _Pragma("unroll") for (int k = 0; k < 2; ++k) dst[m][k] = *(const LAS bf16x8*)(lds + GM_SA(b, h) + aoff + m * 2048 + k * 1024); } while (0)
#define GM_LDB(dst, b, h) do { _Pragma("unroll") for (int n = 0; n < 2; ++n) _Pragma("unroll") for (int k = 0; k < 2; ++k) dst[n][k] = *(const LAS bf16x8*)(lds + GM_SB(b, h) + boff + n * 2048 + k * 1024); } while (0)
#define GM_MMA(ai, bj, At, Bt) do { __builtin_amdgcn_s_setprio(1); _Pragma("unroll") for (int m = 0; m < 4; ++m) _Pragma("unroll") for (int n = 0; n < 2; ++n) _Pragma("unroll") for (int k = 0; k < 2; ++k) \
        acc[ai][bj][m][n] = __builtin_amdgcn_mfma_f32_16x16x32_bf16(Bt[n][k], At[m][k], acc[ai][bj][m][n], 0, 0, 0); __builtin_amdgcn_s_setprio(0); } while (0)
#define GM_WAIT_V(n) asm volatile("s_waitcnt vmcnt(" #n ")" ::: "memory")
#define GM_WAIT_L(n) asm volatile("s_waitcnt lgkmcnt(" #n ")" ::: "memory")
#define GM_BAR __builtin_amdgcn_s_barrier()
#define GM_SCHED __builtin_amdgcn_sched_barrier(0)
#define GM_MKA(u, pk) do { if (GATHER) { _Pragma("unroll") for (int _i = 0; _i < 2; ++_i) { int R_, C_; stage_rc(tid * 16 + _i * 8192, R_, C_); \
        pk[_i] = S.arow(u, R_) | (S.arow(u, HALF + R_) << 16); } } } while (0)
#define GM_KITER(W1, U2, P2, KO2, B2) do { \
            GM_LDB(B0, 0, 0); GM_SCHED; GM_LDA(At, 0, 0); \
            GM_WAIT_L(8); GM_BAR; GM_WAIT_L(0); GM_MMA(0, 0, At, B0); GM_BAR; GM_SCHED; \
            GM_LDB(B1, 0, 1); GM_STAGE(GM_SB(0, 0), B2, voffB); \
            GM_BAR; GM_WAIT_L(0); GM_MMA(0, 1, At, B1); GM_BAR; \
            GM_LDA(At, 0, 1); GM_STAGE_A(GM_SA(0, 0), U2, P2, 0, KO2); \
            GM_BAR; GM_WAIT_L(0); GM_MMA(1, 0, At, B0); GM_BAR; GM_SCHED; \
            GM_STAGE(GM_SB(0, 1), (B2) + hstep, voffB); \
            W1; GM_BAR; GM_MMA(1, 1, At, B1); GM_BAR; \
            GM_LDB(B0, 1, 0); GM_SCHED; GM_LDA(At, 1, 0); GM_STAGE_A(GM_SA(0, 1), U2, P2, 1, KO2); \
            GM_WAIT_L(8); GM_BAR; GM_WAIT_L(0); GM_MMA(0, 0, At, B0); GM_BAR; GM_SCHED; \
            GM_LDB(B1, 1, 1); GM_STAGE(GM_SB(1, 0), (B2) + kstep, voffB); \
            GM_BAR; GM_WAIT_L(0); GM_MMA(0, 1, At, B1); GM_BAR; \
            GM_LDA(At, 1, 1); GM_STAGE_A(GM_SA(1, 0), U2, P2, 0, (KO2) + kstep); \
            GM_BAR; GM_WAIT_L(0); GM_MMA(1, 0, At, B0); GM_BAR; GM_SCHED; \
            GM_STAGE(GM_SB(1, 1), (B2) + kstep + hstep, voffB); GM_STAGE_A(GM_SA(1, 1), U2, P2, 1, (KO2) + kstep); \
            GM_WAIT_V(8); GM_BAR; GM_MMA(1, 1, At, B1); GM_BAR; } while (0)
    constexpr int NPRE = (GATHER ? 4 : 0) + (Epi::META ? 2 : 0) + (Epi::BIAS ? 1 : 0), NW1 = 6 + NPRE + Epi::NST;
    static_assert(NW1 < 64, "vmcnt is 6 bits");
    GU cur, nxt; int ui = 0;
    if (!S.next(0, cur)) return;
    f32x4 acc[2][2][4][2];
    bf16x8 At[4][2], B0[2][2], B1[2][2];
    unsigned cP[2] = {0u, 0u}, nP[2] = {0u, 0u};
    GM_MKA(cur, cP);
    const char* cB = cur.bptr;
    const char* cU = Abase + (size_t)cur.m0 * (K * 2);
    GM_STAGE(GM_SB(0, 0), cB, voffB); GM_STAGE_A(GM_SA(0, 0), cU, cP, 0, 0); GM_STAGE(GM_SB(0, 1), cB + hstep, voffB); GM_STAGE_A(GM_SA(0, 1), cU, cP, 1, 0);
    if (wr == 1) GM_BAR;
    GM_WAIT_V(4); GM_BAR;
    GM_STAGE(GM_SB(1, 0), cB + kstep, voffB); GM_STAGE_A(GM_SA(1, 0), cU, cP, 0, kstep); GM_STAGE(GM_SB(1, 1), cB + hstep + kstep, voffB); GM_STAGE_A(GM_SA(1, 1), cU, cP, 1, kstep);
    GM_WAIT_V(8); GM_BAR;
    GM_SCHED;
#pragma unroll
    for (int a = 0; a < 2; ++a)
#pragma unroll
        for (int b = 0; b < 2; ++b)
#pragma unroll
            for (int m = 0; m < 4; ++m)
#pragma unroll
                for (int n = 0; n < 2; ++n) acc[a][b][m][n] = (f32x4){0.f, 0.f, 0.f, 0.f};
    for (;;) {
        const bool has_next = S.next(ui + 1, nxt);
        if (!has_next) nxt = cur;
        const char* nB = nxt.bptr;
        const char* nU = Abase + (size_t)nxt.m0 * (K * 2);
        int tq = 0; if constexpr (GATHER || Epi::META || Epi::BIAS) tq = tid_fresh(wave_s);
        if (GATHER) { int R0, C0, R1, C1; stage_rc(tq * 16, R0, C0); stage_rc(tq * 16 + 8192, R1, C1);
            const unsigned d0 = (unsigned)__builtin_amdgcn_readfirstlane((int)(lds0 + STAGE_BYTES + 8192 + wid * 256));
            glds4_v(S.lptr(nxt, R0), d0); glds4_v(S.lptr(nxt, HALF + R0), d0 + 2048); glds4_v(S.lptr(nxt, R1), d0 + 4096); glds4_v(S.lptr(nxt, HALF + R1), d0 + 6144); }
        if constexpr (Epi::META) { const unsigned d0 = (unsigned)__builtin_amdgcn_readfirstlane((int)(lds0 + STAGE_BYTES + (wid < 4 ? 4096 + (ui & 1) * 2048 + wid * 256 : 20480 + (wid - 4) * 256)));
            glds4_v(E.mptr0(cur, tq & 255), d0); glds4_v(E.mptr1(cur, tq & 255), d0 + 1024); }
        if constexpr (Epi::BIAS) { const unsigned d0 = (unsigned)__builtin_amdgcn_readfirstlane((int)(lds0 + STAGE_BYTES + (wid < 4 ? 16384 + (ui & 1) * 2048 + wid * 256 : 22528 + (wid - 4) * 256)));
            glds4_v(E.bptr(cur, tq & 255), d0); }
        for (int t = 0; t < nt - 2; t += 2) {
            const size_t ko2 = (size_t)(t + 2) * kstep;
            const char* b2 = cB + ko2;
            const bool after_epi = (t == 0 && ui > 0);
#define GM_W1SEL do { if (after_epi) asm volatile("s_waitcnt vmcnt(%0)" :: "n"(NW1) : "memory"); else GM_WAIT_V(6); } while (0)
            GM_KITER(GM_W1SEL, cU, cP, ko2, b2);
#undef GM_W1SEL
        }
        if (GATHER) { if (has_next) { const LAS unsigned* gr = (const LAS unsigned*)(lds + STAGE_BYTES + 8192) + tid;
                nP[0] = (gr[0] >> 2) | ((gr[512] >> 2) << 16); nP[1] = (gr[1024] >> 2) | ((gr[1536] >> 2) << 16); } else { nP[0] = cP[0]; nP[1] = cP[1]; } }
        GM_KITER(GM_WAIT_V(6), nU, nP, (size_t)0, nB);
        { int tz = tid; asm volatile("" : "+v"(tz)); E(acc, cur, tz, lds + (ui & 1) * 2048); }
        if (!has_next) break;
#pragma unroll
        for (int a = 0; a < 2; ++a)
#pragma unroll
            for (int b = 0; b < 2; ++b)
#pragma unroll
                for (int m = 0; m < 4; ++m)
#pragma unroll
                    for (int n = 0; n < 2; ++n) acc[a][b][m][n] = (f32x4){0.f, 0.f, 0.f, 0.f};
        cur = nxt; cB = nB; cU = nU; cP[0] = nP[0]; cP[1] = nP[1]; ++ui; asm volatile("" : "+s"(ui));
    }
    GM_WAIT_V(0);
    if (wr == 0) GM_BAR;
    GM_BAR;
#undef GM_SA
#undef GM_SB
#undef GM_STAGE
#undef GM_STAGE_A
#undef GM_LDA
#undef GM_LDB
#undef GM_MMA
#undef GM_WAIT_V
#undef GM_WAIT_L
#undef GM_BAR
#undef GM_SCHED
#undef GM_MKA
#undef GM_KITER
}

struct DenseSched {
    int nrb, npn, x, j, wpx; const char* Bt; size_t btile; int skipctx;
    __device__ __forceinline__ bool next(int i, GU& u) const {
        const int v = i * wpx + j, rbl = v / npn; int rb;
        if (skipctx) { const int q = rbl * 8 + x; rb = q + q / 16 + 1; } else rb = rbl * 8 + x;
        if (rb >= nrb) return false;
        u.pn = v - rbl * npn; u.m0 = rb * BM; u.nrows = BM; u.e = 0; u.rbg = rb; u.bptr = Bt + (size_t)u.pn * btile; return true;
    }
    __device__ __forceinline__ unsigned arow(const GU& u, int r) const { return (unsigned)(u.m0 + r); }
    __device__ __forceinline__ const int* lptr(const GU&, int) const { return nullptr; }
};
}

struct EpiProj {
    static constexpr bool META = false, BIAS = false; static constexpr int NST = 16;
    bf16_t* O;
    __device__ __forceinline__ const int* mptr0(const gm::GU&, int) const { return nullptr; }
    __device__ __forceinline__ const int* mptr1(const gm::GU&, int) const { return nullptr; }
    __device__ __forceinline__ void operator()(const f32x4 (&acc)[2][2][4][2], const gm::GU& u, int tz, LAS unsigned char*) const {
        const int wid = tz >> 6, lane = tz & 63, wr = wid >> 2, wc = wid & 3, fr = lane & 15, fq = lane >> 4;
        const int row0 = u.m0 + wr * 64 + fr, col0 = u.pn * 256 + wc * 32 + 8 * fq;
#pragma unroll
        for (int ai = 0; ai < 2; ++ai)
#pragma unroll
            for (int m = 0; m < 4; ++m) { bf16_t* rowp = O + (size_t)(row0 + ai * 128 + m * 16) * NPROJ + col0;
#pragma unroll
                for (int bj = 0; bj < 2; ++bj) { const f32x4 v0 = acc[ai][bj][m][0], v1 = acc[ai][bj][m][1];
                    *(u32x4*)(rowp + bj * 128) = (u32x4){cvt_pk_bf16(v0[0], v0[1]), cvt_pk_bf16(v0[2], v0[3]), cvt_pk_bf16(v1[0], v1[1]), cvt_pk_bf16(v1[2], v1[3])}; } }
    }
};
__device__ __forceinline__ void p_inproj(const Frame& F, int l) {
    gm::DenseSched S; S.nrb = NROW / 256; S.npn = NPROJ / 256; S.x = F.gx; S.j = F.gj; S.wpx = F.gn;
    S.Bt = (const char*)(F.ws + WS_WIN) + (size_t)l * NPROJ * 1024 * 2; S.btile = (size_t)256 * 1024 * 2; S.skipctx = 0;
    if (slack_on(F)) { if (F.gj >= F.gn - SLK_IN) { cvt_slack(F, l * CVB_L, SLK_A, F.gx * SLK_IN + (F.gj - (F.gn - SLK_IN)), 8 * SLK_IN); return; } S.wpx = F.gn - SLK_IN; }
    EpiProj E{(bf16_t*)(F.ws + WS_PROJ)};
    gm::gemm_phase<true, false>(F.lds, (const char*)(F.ws + WS_H), S, E, F.wave_s);
}

#if MK_DUP == 11
struct EpiNull {
    static constexpr bool META = false, BIAS = false; static constexpr int NST = 0;
    bf16_t* O;
    __device__ __forceinline__ const int* mptr0(const gm::GU&, int) const { return nullptr; }
    __device__ __forceinline__ const int* mptr1(const gm::GU&, int) const { return nullptr; }
    __device__ __forceinline__ void operator()(const f32x4 (&acc)[2][2][4][2], const gm::GU& u, int tz, LAS unsigned char*) const {
        float s = 0.f;
#pragma unroll
        for (int ai = 0; ai < 2; ++ai)
#pragma unroll
            for (int bj = 0; bj < 2; ++bj)
#pragma unroll
                for (int m = 0; m < 4; ++m)
#pragma unroll
                    for (int n = 0; n < 2; ++n) s += acc[ai][bj][m][n][0] + acc[ai][bj][m][n][1] + acc[ai][bj][m][n][2] + acc[ai][bj][m][n][3];
        if (s == 12345.6789f) O[(size_t)u.m0 * NPROJ + tz] = 0;
    }
};
__device__ __forceinline__ void p_inproj_null(const Frame& F, int l) {
    gm::DenseSched S; S.nrb = NROW / 256; S.npn = NPROJ / 256; S.x = F.gx; S.j = F.gj; S.wpx = F.gn;
    S.Bt = (const char*)(F.ws + WS_WIN) + (size_t)l * NPROJ * 1024 * 2; S.btile = (size_t)256 * 1024 * 2; S.skipctx = 0;
    EpiNull E{(bf16_t*)(F.ws + WS_PROJ)};
    gm::gemm_phase<true, false>(F.lds, (const char*)(F.ws + WS_H), S, E, F.wave_s);
}
#endif

constexpr float QSCALE = 0.125f * 1.4426950408889634f;
__device__ __forceinline__ void c1_setup(const Frame& F, LAS float* tab) {
    for (int idx = F.tid; idx < 1024; idx += NTHR) { const int p = idx >> 4, i = idx & 15; const float inv = exp2f(-(float)i * (13.287712379549449f / 16.0f));
        const float xa = (float)p * inv, k = rintf(xa * 0.15915494309189535f);
        float rr = __builtin_fmaf(-k, 6.28125f, xa); rr = __builtin_fmaf(-k, 1.9353071795864769e-3f, rr);
        tab[2 * idx] = __cosf(rr); tab[2 * idx + 1] = __sinf(rr); }
    __syncthreads();
}
__device__ __forceinline__ void c1_unit(const Frame& F, int l, int u, const LAS float* tab) {
    const int b = u / 68, pos0 = (u - b * 68) * 64, row0 = b * TPB + pos0;
    const bf16_t* proj = (const bf16_t*)(F.ws + WS_PROJ);
    LAS bf16_t* vt = (LAS bf16_t*)(F.lds + 8192);
#pragma unroll
    for (int j = 0; j < 8; ++j) { const int p = F.tid + NTHR * j, r = p >> 6, c8 = (p & 63) * 8;
        *(LAS u32x4*)(vt + r * 520 + c8) = *(const u32x4*)(proj + (size_t)(row0 + r) * NPROJ + C_V + c8); }
    __syncthreads();
    { const int t = F.tid, h = t >> 7, dv = t & 127;
      bf16_t* dst = (bf16_t*)(F.ws + WS_VT) + ((size_t)((b * 4 + h) * 128 + dv)) * TPB + pos0;
#pragma unroll
      for (int g = 0; g < 4; ++g) { unsigned w[8];
#pragma unroll
          for (int pp = 0; pp < 16; pp += 2) { const int k0 = 16 * g + 8 * ((pp & 7) >> 2) + 4 * (pp >> 3) + (pp & 3);
              w[pp >> 1] = (unsigned)vt[k0 * 520 + t] | ((unsigned)vt[(k0 + 1) * 520 + t] << 16); }
          *(u32x4*)(dst + 16 * g) = (u32x4){w[0], w[1], w[2], w[3]}; *(u32x4*)(dst + 16 * g + 8) = (u32x4){w[4], w[5], w[6], w[7]}; } }
    const int hw = F.tid >> 5, i = F.tid & 31;
    const bool lat = pos0 >= CTXL;
    u32x4 tv[8];
#pragma unroll
    for (int j = 0; j < 8; ++j) { const int p = F.tid + NTHR * j, r = p >> 6, c8 = (p & 63) * 8; tv[j] = *(const u32x4*)(proj + (size_t)(row0 + r) * NPROJ + C_Q + c8); }
#pragma unroll 1
    for (int which = 0; which < 2; ++which) {
        __syncthreads();
#pragma unroll
        for (int j = 0; j < 8; ++j) { const int p = F.tid + NTHR * j, r = p >> 6, c8 = (p & 63) * 8; *(LAS u32x4*)(vt + r * 520 + c8) = tv[j]; }
        if (which == 0) {
#pragma unroll
            for (int j = 0; j < 8; ++j) { const int p = F.tid + NTHR * j, r = p >> 6, c8 = (p & 63) * 8; tv[j] = *(const u32x4*)(proj + (size_t)(row0 + r) * NPROJ + C_K + c8); } }
        __syncthreads();
        const int j8 = F.tid & 7;
        const float* g = F.in[which ? I_KN : I_QN] + l * 64; const f32x4 g1 = *(const f32x4*)(g + 4 * j8), g2 = *(const f32x4*)(g + 32 + 4 * j8);
        const float qs = which ? 1.0f : QSCALE;
        bf16_t* dbase = (bf16_t*)(F.ws + (which ? WS_KB : WS_QB));
        LAS bf16_t* ot = (LAS bf16_t*)(F.lds + 75776);
#pragma unroll 2
        for (int it = 0; it < 8; ++it) {
            const int item = it * 64 + (F.tid >> 3), rl = item >> 3, hs8 = item & 7;
            const LAS bf16_t* src = vt + rl * 520 + hs8 * 64 + 4 * j8;
            const u32x2 wa = *(const LAS u32x2*)src, wb = *(const LAS u32x2*)(src + 32);
            const f32x4 t1 = (f32x4){bflo(wa.x), bfhi(wa.x), bflo(wa.y), bfhi(wa.y)}, t2 = (f32x4){bflo(wb.x), bfhi(wb.x), bflo(wb.y), bfhi(wb.y)};
            float ss = t1[0] * t1[0] + t1[1] * t1[1] + t1[2] * t1[2] + t1[3] * t1[3] + t2[0] * t2[0] + t2[1] * t2[1] + t2[2] * t2[2] + t2[3] * t2[3];
            ss += dppf<0xB1>(ss); ss += dppf<0x4E>(ss); ss += dppf<0x141>(ss);
            const float rstd = __builtin_amdgcn_rsqf(ss * (1.0f / 64.0f) + EPSN) * qs;
            f32x4 n1 = t1 * rstd * g1, n2 = t2 * rstd * g2;
            if (lat) { const int tp = pos0 + rl - CTXL, pp = (j8 < 4) ? (tp >> 6) : (tp & 63);
                const LAS float* tp2 = tab + 2 * (pp * 16 + ((4 * j8) & 15));
                const f32x4 c01 = *(const LAS f32x4*)tp2, c23 = *(const LAS f32x4*)(tp2 + 4);
                const f32x4 cs = (f32x4){c01[0], c01[2], c23[0], c23[2]}, sn = (f32x4){c01[1], c01[3], c23[1], c23[3]};
                const f32x4 o1 = n1 * cs - n2 * sn, o2 = n2 * cs + n1 * sn; n1 = o1; n2 = o2; }
            LAS bf16_t* od = ot + (hs8 * 64 + rl) * 72 + 4 * j8;
            *(LAS u32x2*)od = (u32x2){cvt_pk_bf16(n1[0], n1[1]), cvt_pk_bf16(n1[2], n1[3])}; *(LAS u32x2*)(od + 32) = (u32x2){cvt_pk_bf16(n2[0], n2[1]), cvt_pk_bf16(n2[2], n2[3])};
        }
        __syncthreads();
#pragma unroll
        for (int j = 0; j < 8; ++j) { const int p = F.tid + NTHR * j, hs = p >> 9, rem = p & 511, row = rem >> 3, pc = rem & 7;
            *(u32x4*)(dbase + ((size_t)((b * 4 + (hs >> 1)) * 2 + (hs & 1)) * TPB + pos0 + row) * 64 + pc * 8) = *(const LAS u32x4*)(ot + (hs * 64 + row) * 72 + pc * 8); }
    }
    __syncthreads();
}

__device__ __forceinline__ int crow(int r, int hi) { return (r & 3) + 8 * (r >> 2) + 4 * hi; }
#define MFMA32(a, b, c) __builtin_amdgcn_mfma_f32_32x32x16_bf16(a, b, c, 0, 0, 0)
#define ZERO16 ((f32x16){0.f, 0.f, 0.f, 0.f, 0.f, 0.f, 0.f, 0.f, 0.f, 0.f, 0.f, 0.f, 0.f, 0.f, 0.f, 0.f})
__device__ __forceinline__ void attn_unit(const Frame& F, int l, int b, int h, int qb, const float shift, const float lam, const float oml) {
    LAS unsigned char* lds = F.lds;
    const int t0 = tid_fresh(F.wave_s);
    const int lane = t0 & 63, wid = __builtin_amdgcn_readfirstlane(t0 >> 6), r32 = lane & 31, hi = lane >> 5;
    const int nkt = (qb == 0) ? 8 : 136;
    const bf16_t* Kg = (const bf16_t*)(F.ws + WS_KB) + (size_t)((b * 4 + h) * 2) * TPB * 64;
    const bf16_t* Vg = (const bf16_t*)(F.ws + WS_VT) + (size_t)((b * 4 + h) * 128) * TPB;
    const bf16_t* Qg = (const bf16_t*)(F.ws + WS_QB) + ((size_t)((b * 4 + h) * 2) * TPB + qb * 256) * 64;
    const unsigned lds0 = (unsigned)(unsigned long)lds;
#define AT_DMA(base, voff32, off) glds16_s((voff32), (const void*)(base), (unsigned)__builtin_amdgcn_readfirstlane((int)(lds0 + (unsigned)(off))))
    const unsigned koff = (unsigned)((((wid >> 2) * TPB + (lane & 31)) * 64 + (2 * (wid & 3) + (lane >> 5)) * 8) * 2);
    const unsigned voff = (unsigned)((((wid & 1) * 64 + lane) * TPB + (wid >> 1) * 8) * 2);
#define AT_K(t, s) AT_DMA((const char*)Kg + (size_t)(t) * (32 * 64 * 2), koff, (s) * 16384 + (wid >> 2) * 4096 + (wid & 3) * 1024)
#define AT_V(t, s) AT_DMA((const char*)Vg + (size_t)(t) * (32 * 2), voff, (s) * 16384 + 8192 + (wid >> 1) * 2048 + (wid & 1) * 1024)
#pragma unroll
    for (int j = 0; j < 8; ++j) { const int idx = wid * 8 + j, sub = idx >> 5, ch = (idx >> 2) & 7, rg = idx & 3;
        AT_DMA((const char*)Qg, (unsigned)((sub * TPB * 64 + (rg * 64 + lane) * 64 + ch * 8) * 2), 65536 + sub * 32768 + ch * 4096 + rg * 1024); }
    AT_K(0, 0);
    f32x16 O[2][4];
#pragma unroll
    for (int a = 0; a < 2; ++a)
#pragma unroll
        for (int v = 0; v < 4; ++v)
#pragma unroll
            for (int r = 0; r < 16; ++r) O[a][v][r] = 0.f;
    float lsum0 = 0.f, lsum1 = 0.f;
    const LAS unsigned char* qbase = lds + 65536 + (wid * 32 + r32) * 16 + hi * 4096;
    f32x16 X0, X2;
#pragma unroll
    for (int r = 0; r < 16; ++r) { X0[r] = 0.f; X2[r] = 0.f; }
    const int grp = wid >> 2;
#define AT_VF(f) (*(const LAS bf16x8*)(vb + ((f) >> 2) * 4096 + ((f) & 3) * 512))
#define AT_PVSTEP(f, vcur, vnext2) do { if ((f) + 2 < 8) vnext2 = AT_VF((f) + 2); \
            { const int ks_ = (f) >> 2, v4_ = (f) & 3; \
            const bf16x8 pa = __builtin_bit_cast(bf16x8, (f32x4){X0[4 * ks_], X0[4 * ks_ + 1], X0[4 * ks_ + 2], X0[4 * ks_ + 3]}); \
            const bf16x8 pb = __builtin_bit_cast(bf16x8, (f32x4){X2[4 * ks_], X2[4 * ks_ + 1], X2[4 * ks_ + 2], X2[4 * ks_ + 3]}); \
            O[0][v4_] = MFMA32(pa, vcur, O[0][v4_]); O[1][v4_] = MFMA32(pb, vcur, O[1][v4_]); } } while (0)
#define AT_PV(tp) do { const LAS unsigned char* vb = lds + ((tp) & 1) * 16384 + 8192 + hi * 2048 + r32 * 16; bf16x8 v0_ = AT_VF(0), v1_ = AT_VF(1), v2_; \
        AT_PVSTEP(0, v0_, v2_); AT_PVSTEP(1, v1_, v0_); AT_PVSTEP(2, v2_, v1_); AT_PVSTEP(3, v0_, v2_); AT_PVSTEP(4, v1_, v0_); AT_PVSTEP(5, v2_, v1_); \
        AT_PVSTEP(6, v0_, v2_); AT_PVSTEP(7, v1_, v0_); } while (0)
#define AT_S(ts) do { const LAS unsigned char* kb = lds + ((ts) & 1) * 16384 + hi * 512 + r32 * 16; \
        _Pragma("unroll") for (int ds = 0; ds < 4; ++ds) { \
            const bf16x8 ka = *(const LAS bf16x8*)(kb + ds * 1024), kc = *(const LAS bf16x8*)(kb + 4096 + ds * 1024); \
            const bf16x8 qb2 = *(const LAS bf16x8*)(qbase + 32768 + ds * 8192); const bf16x8 qa = (ds < 2) ? qf[ds & 1] : *(const LAS bf16x8*)(qbase + ds * 8192); \
            if (ds == 0) { X0 = MFMA32(ka, qa, ZERO16); X2 = MFMA32(kc, qb2, ZERO16); } else { X0 = MFMA32(ka, qa, X0); X2 = MFMA32(kc, qb2, X2); } } } while (0)
#define AT_EXP8(S, base, D, dbase, LS) do { const float e0 = __builtin_amdgcn_exp2f(S[base]), e1 = __builtin_amdgcn_exp2f(S[base + 1]), e2 = __builtin_amdgcn_exp2f(S[base + 2]), e3 = __builtin_amdgcn_exp2f(S[base + 3]), \
        e4 = __builtin_amdgcn_exp2f(S[base + 4]), e5 = __builtin_amdgcn_exp2f(S[base + 5]), e6 = __builtin_amdgcn_exp2f(S[base + 6]), e7 = __builtin_amdgcn_exp2f(S[base + 7]); \
        LS += ((e0 + e1) + (e2 + e3)) + ((e4 + e5) + (e6 + e7)); \
        D[dbase] = __uint_as_float(cvt_pk_bf16(e0, e1)); D[dbase + 1] = __uint_as_float(cvt_pk_bf16(e2, e3)); D[dbase + 2] = __uint_as_float(cvt_pk_bf16(e4, e5)); D[dbase + 3] = __uint_as_float(cvt_pk_bf16(e6, e7)); } while (0)
#define AT_EXP() do { if (shift > 0.f) { _Pragma("unroll") for (int r = 0; r < 16; ++r) { X0[r] -= shift; X2[r] -= shift; } } \
        AT_EXP8(X0, 0, X0, 0, lsum0); AT_EXP8(X0, 8, X0, 4, lsum0); AT_EXP8(X2, 0, X2, 0, lsum1); AT_EXP8(X2, 8, X2, 4, lsum1); } while (0)
#define AT_ISSUE(t) do { if ((t) + 1 < nkt) AT_K((t) + 1, ((t) + 1) & 1); if ((t) < nkt) AT_V((t), (t) & 1); } while (0)
#define AT_BAR() do { __builtin_amdgcn_sched_barrier(0); __builtin_amdgcn_s_barrier(); __builtin_amdgcn_sched_barrier(0); } while (0)
#define AT_WAITBAR() do { __builtin_amdgcn_sched_barrier(0); asm volatile("s_waitcnt vmcnt(0)" ::: "memory"); __builtin_amdgcn_s_barrier(); __builtin_amdgcn_sched_barrier(0); } while (0)
    AT_WAITBAR();
    bf16x8 qf[2];
#pragma unroll
    for (int ds = 0; ds < 2; ++ds) qf[ds] = *(const LAS bf16x8*)(qbase + ds * 8192);
    if (grp == 0) {
        AT_ISSUE(0); AT_S(0); AT_BAR();
#pragma unroll 1
        for (int t = 0; t < nkt; ++t) {
            AT_EXP(); AT_WAITBAR();
            AT_ISSUE(t + 1); AT_PV(t); { const int ts = (t + 1 < nkt) ? t + 1 : nkt - 1; AT_S(ts); } AT_BAR();
        }
        AT_WAITBAR();
    } else {
        AT_ISSUE(0); AT_BAR();
        AT_S(0); AT_WAITBAR();
#pragma unroll 1
        for (int t = 0; t < nkt; ++t) {
            AT_ISSUE(t + 1); AT_EXP(); AT_BAR();
            AT_PV(t); { const int ts = (t + 1 < nkt) ? t + 1 : nkt - 1; AT_S(ts); } AT_WAITBAR();
        }
    }
#undef AT_PV
#undef AT_S
#undef AT_VF
#undef AT_PVSTEP
#undef AT_EXP8
#undef AT_EXP
#undef AT_ISSUE
#undef AT_BAR
#undef AT_WAITBAR
    const int tz = tid_fresh(F.wave_s);
    const int lane2 = tz & 63, wid2 = tz >> 6, r32b = lane2 & 31, hib = lane2 >> 5;
    lsum0 = x32_red<OpAdd>(lsum0); lsum1 = x32_red<OpAdd>(lsum1);
    LAS float* wl = (LAS float*)(lds + 131072) + wid2 * 64;
    if (hib == 0) { wl[r32b] = __builtin_amdgcn_rcpf(lsum0); wl[32 + r32b] = lam * __builtin_amdgcn_rcpf(lsum1); }
    asm volatile("s_waitcnt lgkmcnt(0)" ::: "memory");
    float ss[16];
#pragma unroll
    for (int r = 0; r < 16; ++r) { const int q = crow(r, hib); const float i0 = wl[q], i1 = wl[32 + q]; float sacc = 0.f;
#pragma unroll
        for (int v4 = 0; v4 < 4; ++v4) { const float o = O[0][v4][r] * i0 - O[1][v4][r] * i1; O[0][v4][r] = o; sacc += o * o; }
        ss[r] = sacc; }
#pragma unroll
    for (int r = 0; r < 16; ++r) ss[r] = half32_red<OpAdd>(ss[r]);
    const float* gs = F.in[I_SUBG] + l * 128;
    float gv[4];
    unsigned omb = (l == 0) ? 0x3f4ccccdu : 0x3f24fe8cu; asm volatile("" : "+s"(omb));
#pragma unroll
    for (int v4 = 0; v4 < 4; ++v4) gv[v4] = gs[v4 * 32 + r32b] * __uint_as_float(omb);
    LAS bf16_t* stg = (LAS bf16_t*)(lds + wid2 * 8704);
#pragma unroll
    for (int r = 0; r < 16; ++r) { const float sc = __builtin_amdgcn_rsqf(ss[r] * (1.0f / 128.0f) + EPSN); LAS bf16_t* yr = stg + crow(r, hib) * 136 + r32b;
#pragma unroll
        for (int v4 = 0; v4 < 4; ++v4) yr[v4 * 32] = f2bf(O[0][v4][r] * sc * gv[v4]); }
    bf16_t* yb = (bf16_t*)(F.ws + WS_YMIX) + (size_t)(b * TPB + qb * 256 + wid2 * 32) * DM + 512 + h * 128;
#pragma unroll
    for (int j = 0; j < 8; ++j) { const int p = lane2 + 64 * j, row = p >> 4, pc = p & 15; *(u32x4*)(yb + (size_t)row * DM + pc * 8) = *(const LAS u32x4*)(stg + row * 136 + pc * 8); }
    __syncthreads();
#undef AT_DMA
#undef AT_K
#undef AT_V
}
__device__ __forceinline__ void conv_unit(const Frame& F, int l, int u) {
    const int t0 = tid_fresh(F.wave_s);
    const int tid = t0;
    const int b = u / 68, pos0 = (u - b * 68) * 64;
    const int seg_lo = pos0 < CTXL ? 0 : CTXL, seg_hi = pos0 < CTXL ? CTXL : TPB;
    const bf16_t* proj = (const bf16_t*)(F.ws + WS_PROJ);
    LAS bf16_t* tile = (LAS bf16_t*)F.lds;
    {   u32x4 v[17];
#pragma unroll
        for (int j = 0; j < 17; ++j) { const int p = tid + NTHR * j, r = p >> 7, c8 = (p & 127) * 8, pos = pos0 - 2 + r, col = c8 < 256 ? 256 + c8 : 512 + c8;
            v[j] = (r < 67 && pos >= seg_lo && pos < seg_hi) ? *(const u32x4*)(proj + (size_t)(b * TPB + pos) * NPROJ + col) : (u32x4){0u, 0u, 0u, 0u}; }
#pragma unroll
        for (int j = 0; j < 17; ++j) { const int p = tid + NTHR * j, r = p >> 7, c8 = (p & 127) * 8; if (r < 67) *(LAS u32x4*)(tile + r * 1032 + c8) = v[j]; }
    }
    __syncthreads();
    {   const int c0 = tid * 2;
        const bool lru = c0 < 256; const int cc = lru ? c0 : c0 - 256;
        const float* cw = lru ? F.in[I_LCW] + l * 1024 : F.in[I_SCW] + l * 3072; const int cs = lru ? 256 : 768;
        const f32x2 w0 = *(const f32x2*)(cw + cc), w1 = *(const f32x2*)(cw + cs + cc), w2 = *(const f32x2*)(cw + 2 * cs + cc), w3 = *(const f32x2*)(cw + 3 * cs + cc);
        const f32x2 cb = *(const f32x2*)((lru ? F.in[I_LCB] + l * 256 : F.in[I_SCB] + l * 768) + cc);
        const bool tr = (c0 >= 256 && c0 < 768);
        bf16_t* trp = (bf16_t*)(F.ws + WS_XBT) + ((size_t)(b * 34 + (pos0 >> 7)) * 512 + (c0 - 256)) * 136 + (pos0 & 127);
        unsigned x0 = *(const LAS unsigned*)(tile + c0), x1 = *(const LAS unsigned*)(tile + 1032 + c0), x2 = *(const LAS unsigned*)(tile + 2 * 1032 + c0);
#pragma unroll 1
        for (int t8 = 0; t8 < 8; ++t8) { unsigned o[8];
#pragma unroll
            for (int j = 0; j < 8; ++j) { const unsigned x3 = *(const LAS unsigned*)(tile + (t8 * 8 + j + 3) * 1032 + c0);
                float a = cb.x + w0.x * bflo(x0) + w1.x * bflo(x1) + w2.x * bflo(x2) + w3.x * bflo(x3);
                float c = cb.y + w0.y * bfhi(x0) + w1.y * bfhi(x1) + w2.y * bfhi(x2) + w3.y * bfhi(x3);
                if (!lru) { a = siluf_(a); c = siluf_(c); }
                o[j] = cvt_pk_bf16(a, c); *(LAS unsigned*)(tile + (t8 * 8 + j) * 1032 + c0) = o[j];
                x0 = x1; x1 = x2; x2 = x3; }
            if (tr) {
                *(u32x4*)(trp + t8 * 8) = (u32x4){(o[0] & 0xffffu) | (o[1] << 16), (o[2] & 0xffffu) | (o[3] << 16), (o[4] & 0xffffu) | (o[5] << 16), (o[6] & 0xffffu) | (o[7] << 16)};
                *(u32x4*)(trp + 136 + t8 * 8) = (u32x4){(o[0] >> 16) | (o[1] & 0xffff0000u), (o[2] >> 16) | (o[3] & 0xffff0000u), (o[4] >> 16) | (o[5] & 0xffff0000u), (o[6] >> 16) | (o[7] & 0xffff0000u)}; }
        }
    }
    __syncthreads();
    {
        bf16_t* outp = (bf16_t*)(F.ws + WS_CONV) + (size_t)(b * TPB + pos0) * 1024;
#pragma unroll
        for (int j = 0; j < 16; ++j) { const int p = tid + NTHR * j, r = p >> 7, c8 = (p & 127) * 8; st_wt(outp + (size_t)r * 1024 + c8, *(const LAS u32x4*)(tile + r * 1032 + c8)); }
    }
    __syncthreads();
}
__device__ __forceinline__ void p_conv(const Frame& F, int l) { for (int u = F.bx; u < 544; u += F.G) conv_unit(F, l, u); }

constexpr float NL2E = -1.4426950408889634f;
struct LruW { bf16x8 wa[4][2], wx[4][2]; float ba[2], bx[2], sp[2]; };
__device__ __forceinline__ void lru_load_w(const Frame& F, int l, LruW& W) {
    const int lane = F.lane, r32 = lane & 31, hi = lane >> 5, h = F.wid & 3, dir = F.wid >> 2;
    const float* wa = F.in[I_LWA] + (size_t)((l * 2 + dir) * 4 + h) * 4096;
    const float* wx = F.in[I_LWX] + (size_t)((l * 2 + dir) * 4 + h) * 4096;
#pragma unroll
    for (int ks = 0; ks < 4; ++ks)
#pragma unroll
        for (int nb = 0; nb < 2; ++nb) { unsigned a[4], x[4];
#pragma unroll
            for (int j = 0; j < 4; ++j) { const int i0 = 16 * ks + 8 * hi + 2 * j, c = nb * 32 + r32;
                a[j] = cvt_pk_bf16(NL2E * wa[i0 * 64 + c], NL2E * wa[(i0 + 1) * 64 + c]); x[j] = cvt_pk_bf16(NL2E * wx[i0 * 64 + c], NL2E * wx[(i0 + 1) * 64 + c]); }
            W.wa[ks][nb] = __builtin_bit_cast(bf16x8, (u32x4){a[0], a[1], a[2], a[3]}); W.wx[ks][nb] = __builtin_bit_cast(bf16x8, (u32x4){x[0], x[1], x[2], x[3]}); }
#pragma unroll
    for (int nb = 0; nb < 2; ++nb) { const int ch = (l * 2 + dir) * 256 + h * 64 + nb * 32 + r32;
        W.ba[nb] = NL2E * F.in[I_LBA][ch]; W.bx[nb] = NL2E * F.in[I_LBX][ch]; W.sp[nb] = 8.0f * NL2E * softplusf_(-F.in[I_LLAM][ch]); }
}
__device__ __forceinline__ float gelu_tanh(float x) { const float u = x * fmaf(0.044715f, x * x, 1.0f); return x * __builtin_amdgcn_rcpf(1.0f + __builtin_amdgcn_exp2f(u * (-2.0f * 0.7978845608028654f * 1.4426950408889634f))); }
template <int PASS>
__device__ __forceinline__ void lru_unit(const Frame& F, int l, int u, const LruW& W) {
    const int t0 = tid_fresh(F.wave_s);
    const int tid = t0, lane = tid & 63, wid = __builtin_amdgcn_readfirstlane(tid >> 6), r32 = lane & 31, hi = lane >> 5;
    const int b = u / 136, c32 = u - b * 136, pos0 = c32 * 32, row0 = b * TPB + pos0;
    const bf16_t* proj = (const bf16_t*)(F.ws + WS_PROJ);
    LAS bf16_t* xcb = (LAS bf16_t*)F.lds;
    LAS f32x2* au = (LAS f32x2*)(F.lds + 16896);
    {
        const bf16_t* cv = (const bf16_t*)(F.ws + WS_CONV) + (size_t)row0 * 1024;
#pragma unroll
        for (int j = 0; j < 2; ++j) { const int p = tid + NTHR * j, r = p >> 5, c8 = (p & 31) * 8; *(LAS u32x4*)(xcb + r * 264 + c8) = *(const u32x4*)(cv + (size_t)r * 1024 + c8); }
    }
    __syncthreads();
    {
        const int h = wid & 3, dir = wid >> 2;
        f32x16 Da[2], Dx[2];
#pragma unroll
        for (int nb = 0; nb < 2; ++nb)
#pragma unroll
            for (int r = 0; r < 16; ++r) { Da[nb][r] = 0.f; Dx[nb][r] = 0.f; }
#pragma unroll
        for (int ks = 0; ks < 4; ++ks) { const bf16x8 a = *(const LAS bf16x8*)(xcb + r32 * 264 + h * 64 + 16 * ks + 8 * hi);
#pragma unroll
            for (int nb = 0; nb < 2; ++nb) { Da[nb] = MFMA32(a, W.wa[ks][nb], Da[nb]); Dx[nb] = MFMA32(a, W.wx[ks][nb], Dx[nb]); } }
#pragma unroll
        for (int nb = 0; nb < 2; ++nb) { const int ch = h * 64 + nb * 32 + r32;
#pragma unroll
            for (int r = 0; r < 16; ++r) { const int tok = crow(r, hi);
                const float ra = __builtin_amdgcn_rcpf(1.0f + __builtin_amdgcn_exp2f(Da[nb][r] + W.ba[nb])), ix = __builtin_amdgcn_rcpf(1.0f + __builtin_amdgcn_exp2f(Dx[nb][r] + W.bx[nb]));
                const float a = __builtin_amdgcn_exp2f(ra * W.sp[nb]), xcv = bf2f(xcb[tok * 264 + ch]);
                const float uu = __builtin_amdgcn_sqrtf(fmaf(-a, a, 1.0f)) * ix * xcv;
                au[(dir * 32 + tok) * 256 + ch] = (f32x2){a, uu}; } }
    }
    __syncthreads();
    {
        const int dir = tid >> 8, ch = tid & 255; const size_t sidx = ((size_t)(b * 136 + c32) * 2 + dir) * 256 + ch;
        if (PASS == 1) { float A = 1.f, H = 0.f;
#pragma unroll 8
            for (int s2 = 0; s2 < 32; ++s2) { const int tok = dir ? 31 - s2 : s2; const f32x2 v = au[(dir * 32 + tok) * 256 + ch]; H = v.x * H + v.y; A *= v.x; }
            ((f32x2*)(F.ws + WS_LRUS))[sidx] = (f32x2){A, H};
        } else { float hh = ((const float*)(F.ws + WS_LRUC))[sidx];
#pragma unroll 8
            for (int s2 = 0; s2 < 32; ++s2) { const int tok = dir ? 31 - s2 : s2; f32x2 v = au[(dir * 32 + tok) * 256 + ch]; hh = v.x * hh + v.y; v.y = hh; au[(dir * 32 + tok) * 256 + ch] = v; }
        }
    }
    __syncthreads();
    if (PASS == 2) { const int c2 = (tid & 127) * 2, tq = tid >> 7;
        unsigned gg[8];
#pragma unroll
        for (int j = 0; j < 8; ++j) gg[j] = *(const unsigned*)(proj + (size_t)(row0 + tq * 8 + j) * NPROJ + C_LG + c2);
#pragma unroll
        for (int j = 0; j < 8; ++j) { const int tok = tq * 8 + j;
            const float y0 = gelu_tanh(bflo(gg[j])) * (au[tok * 256 + c2].y + au[(32 + tok) * 256 + c2].y), y1 = gelu_tanh(bfhi(gg[j])) * (au[tok * 256 + c2 + 1].y + au[(32 + tok) * 256 + c2 + 1].y);
            *(unsigned*)((bf16_t*)(F.ws + WS_YMIX) + (size_t)(row0 + tok) * DM + c2) = cvt_pk_bf16(y0, y1); }
        __syncthreads();
    }
}
__device__ __forceinline__ void lru_carry_unit(const Frame& F, int u) {
    const int b = u >> 3, dir = (u >> 2) & 1, cg = u & 3, tid = F.tid;
    LAS f32x2* sm = (LAS f32x2*)F.lds;
    for (int idx = tid; idx < 136 * 64; idx += NTHR) { const int c = idx >> 6, cl = idx & 63; sm[idx] = ((const f32x2*)(F.ws + WS_LRUS))[((size_t)(b * 136 + c) * 2 + dir) * 256 + cg * 64 + cl]; }
    __syncthreads();
    if (tid < 64) { float h = 0.f; float* cr = (float*)(F.ws + WS_LRUC);
        for (int s2 = 0; s2 < 136; ++s2) { const int c = dir ? (s2 < 8 ? 7 - s2 : 143 - s2) : s2; const f32x2 v = sm[c * 64 + tid];
            cr[((size_t)(b * 136 + c) * 2 + dir) * 256 + cg * 64 + tid] = h; h = v.x * h + v.y; } }
    __syncthreads();
}

__device__ __forceinline__ float wave_incl_scan(float v, int lane) {
#pragma unroll
    for (int o = 1; o < 64; o <<= 1) { const float t = __shfl_up(v, o); if (lane >= o) v += t; }
    return v;
}
#define SSD_CONV128(COL, CCH, EMIT) do { \
        const float* cw_ = F.in[I_SCW] + l * 4 * 768; const float w0_ = cw_[CCH], w1_ = cw_[768 + (CCH)], w2_ = cw_[1536 + (CCH)], w3_ = cw_[2304 + (CCH)], cb_ = F.in[I_SCB][l * 768 + (CCH)]; \
        const bf16_t* pc_ = proj + (size_t)(b * TPB) * NPROJ + (COL); \
        float xm2_ = (pos0 - 2 >= seg_lo) ? bf2f(pc_[(size_t)(pos0 - 2) * NPROJ]) : 0.f, xm1_ = (pos0 - 1 >= seg_lo) ? bf2f(pc_[(size_t)(pos0 - 1) * NPROJ]) : 0.f, x0_ = bf2f(pc_[(size_t)pos0 * NPROJ]); \
        for (int t8_ = 0; t8_ < 16; ++t8_) { float xn_[8], o_[8]; \
            _Pragma("unroll") for (int j_ = 0; j_ < 8; ++j_) { const int p_ = pos0 + t8_ * 8 + j_ + 1; xn_[j_] = (p_ < seg_hi) ? bf2f(pc_[(size_t)p_ * NPROJ]) : 0.f; } \
            _Pragma("unroll") for (int j_ = 0; j_ < 8; ++j_) { const float v_ = cb_ + w0_ * xm2_ + w1_ * xm1_ + w2_ * x0_ + w3_ * xn_[j_]; o_[j_] = siluf_(v_); xm2_ = xm1_; xm1_ = x0_; x0_ = xn_[j_]; } \
            EMIT(t8_, o_); } } while (0)
#define SSD_EMIT_T(rowptr) [&](int t8, const float (&o)[8]) { *(LAS u32x4*)((rowptr) + t8 * 8) = (u32x4){cvt_pk_bf16(o[0], o[1]), cvt_pk_bf16(o[2], o[3]), cvt_pk_bf16(o[4], o[5]), cvt_pk_bf16(o[6], o[7])}; }

__device__ __forceinline__ void ssd_p1_unit(const Frame& F, int l, int u) {
    const int t0 = tid_fresh(F.wave_s);
    const int tid = t0, lane = tid & 63, wid = __builtin_amdgcn_readfirstlane(tid >> 6), r32 = lane & 31, hi = lane >> 5;
    const int b = u / 34, c = u - b * 34, pos0 = c * 128, row0 = b * TPB + pos0;
    const int seg_lo = pos0 < CTXL ? 0 : CTXL, seg_hi = pos0 < CTXL ? CTXL : TPB;
    const bf16_t* proj = (const bf16_t*)(F.ws + WS_PROJ);
    LAS bf16_t* XsT = (LAS bf16_t*)F.lds;
    LAS bf16_t* Bt = (LAS bf16_t*)(F.lds + 69632);
    LAS float* dtf = (LAS float*)(F.lds + 139264);
    LAS float* dtb = dtf + 512; LAS float* wf = dtf + 1024; LAS float* wb = dtf + 1536;
    {
        const char* img = (const char*)(F.ws + WS_XBT) + (size_t)(b * 34 + c) * 512 * 136 * 2; const unsigned lds0 = (unsigned)(unsigned long)F.lds;
#pragma unroll
        for (int j = 0; j < 17; ++j) { const int ck = wid * 17 + j; glds16_s((unsigned)(ck * 1024 + lane * 16), img, (unsigned)__builtin_amdgcn_readfirstlane((int)(lds0 + ck * 1024))); }
    }
    if (tid < 128) { const float* dr = (const float*)(F.ws + WS_DTRAW) + (size_t)(row0 + tid) * 8;
#pragma unroll
        for (int h = 0; h < 4; ++h) { dtf[h * 128 + tid] = softplusf_(dr[h] + F.in[I_SDTB][l * 8 + h]); dtb[h * 128 + tid] = softplusf_(dr[4 + h] + F.in[I_SDTB][l * 8 + 4 + h]); } }
    asm volatile("s_waitcnt vmcnt(0)" ::: "memory");
    __syncthreads();
    {
        const int h = wid & 3, dir = wid >> 2; const float a = -__expf(F.in[I_SALOG][l * 8 + dir * 4 + h]);
        const LAS float* dsrc = (dir ? dtb : dtf) + h * 128; LAS float* wdst = (dir ? wb : wf) + h * 128;
        const int tA = dir ? 2 * lane : 127 - 2 * lane, tB = dir ? 2 * lane + 1 : 126 - 2 * lane;
        const float dA = dsrc[tA], dB = dsrc[tB], pr = (dA + dB) * a, incl = wave_incl_scan(pr, lane), excl = incl - pr;
        wdst[tA] = dA * __expf(excl); wdst[tB] = dB * __expf(excl + dA * a);
        if (lane == 63) ((float*)(F.ws + WS_SSDD))[((size_t)(b * 34 + c) * 4 + h) * 2 + dir] = __expf(incl); }
    __syncthreads();
    {   const int h = wid & 3, dir = wid >> 2, g = h >> 1;
        const LAS float* wv = (dir ? wb : wf) + h * 128;
        f32x16 D[2][4];
#pragma unroll
        for (int pb = 0; pb < 2; ++pb)
#pragma unroll
            for (int nb = 0; nb < 4; ++nb)
#pragma unroll
                for (int r = 0; r < 16; ++r) D[pb][nb][r] = 0.f;
#pragma unroll 2
        for (int ks = 0; ks < 8; ++ks) {
            const f32x4 s0 = *(const LAS f32x4*)(wv + 16 * ks + 8 * hi), s1 = *(const LAS f32x4*)(wv + 16 * ks + 8 * hi + 4);
            bf16x8 Af[2];
#pragma unroll
            for (int pb = 0; pb < 2; ++pb) { const u32x4 x = *(const LAS u32x4*)(XsT + (h * 64 + pb * 32 + r32) * 136 + 16 * ks + 8 * hi);
                const u32x4 y = (u32x4){cvt_pk_bf16(bflo(x.x) * s0[0], bfhi(x.x) * s0[1]), cvt_pk_bf16(bflo(x.y) * s0[2], bfhi(x.y) * s0[3]), cvt_pk_bf16(bflo(x.z) * s1[0], bfhi(x.z) * s1[1]), cvt_pk_bf16(bflo(x.w) * s1[2], bfhi(x.w) * s1[3])};
                Af[pb] = __builtin_bit_cast(bf16x8, y); }
#pragma unroll
            for (int nb = 0; nb < 4; ++nb) { const bf16x8 bfr = *(const LAS bf16x8*)(Bt + (g * 128 + nb * 32 + r32) * 136 + 16 * ks + 8 * hi);
                D[0][nb] = MFMA32(Af[0], bfr, D[0][nb]); D[1][nb] = MFMA32(Af[1], bfr, D[1][nb]); }
        }
        float* sp = (float*)(F.ws + WS_SSDS) + (((size_t)(b * 34 + c) * 4 + h) * 2 + dir) * 8192;
        __syncthreads();
        LAS float* stg = (LAS float*)(F.lds + wid * 16896);
#pragma unroll
        for (int pb = 0; pb < 2; ++pb) {
#pragma unroll
            for (int nb = 0; nb < 4; ++nb)
#pragma unroll
                for (int r = 0; r < 16; ++r) stg[crow(r, hi) * 132 + nb * 32 + r32] = D[pb][nb][r];
#pragma unroll
            for (int j = 0; j < 16; ++j) { const int p = lane + 64 * j, row = p >> 5, pc = p & 31; *(f32x4*)(sp + (size_t)(pb * 32 + row) * 128 + pc * 4) = *(const LAS f32x4*)(stg + row * 132 + pc * 4); }
        }
    }
    __syncthreads();
}
__device__ __forceinline__ void ssd_carry_unit(const Frame& F, int u) {
    const int q = u & 3, dir = (u >> 2) & 1, h = (u >> 3) & 3, b = u >> 5, e = q * 2048 + F.tid * 4;
    const float* __restrict__ sl = (const float*)(F.ws + WS_SSDS); const float* __restrict__ dc = (const float*)(F.ws + WS_SSDD); bf16_t* __restrict__ si = (bf16_t*)(F.ws + WS_SSDI);
    f32x4 S = (f32x4){0.f, 0.f, 0.f, 0.f};
#pragma unroll 1
    for (int half = 0; half < 2; ++half) {
        f32x4 loc[17]; float dec[17];
#pragma unroll
        for (int j = 0; j < 17; ++j) { const int s2 = half * 17 + j, c = dir ? (s2 < 2 ? 1 - s2 : 35 - s2) : s2; const size_t base = ((size_t)(b * 34 + c) * 4 + h) * 2 + dir;
            loc[j] = *(const f32x4*)(sl + base * 8192 + e); dec[j] = dc[base]; }
#pragma unroll
        for (int j = 0; j < 17; ++j) { const int s2 = half * 17 + j, c = dir ? (s2 < 2 ? 1 - s2 : 35 - s2) : s2; const size_t base = ((size_t)(b * 34 + c) * 4 + h) * 2 + dir;
            *(u32x2*)(si + base * 8192 + e) = (u32x2){cvt_pk_bf16(S[0], S[1]), cvt_pk_bf16(S[2], S[3])};
            S = S * dec[j] + loc[j]; }
    }
}
__device__ __forceinline__ void ssd_p2_unit(const Frame& F, int l, int u) {
    const int t0 = tid_fresh(F.wave_s);
    const int tid = t0, lane = tid & 63, wid = __builtin_amdgcn_readfirstlane(tid >> 6), r32 = lane & 31, hi = lane >> 5;
    const int b = u / 34, c = u - b * 34, pos0 = c * 128, row0 = b * TPB + pos0;
    const int seg_lo = pos0 < CTXL ? 0 : CTXL, seg_hi = pos0 < CTXL ? CTXL : TPB;
    const bf16_t* proj = (const bf16_t*)(F.ws + WS_PROJ);
    LAS bf16_t* Cn = (LAS bf16_t*)F.lds;
    LAS bf16_t* Bn = (LAS bf16_t*)(F.lds + 34816);
    LAS bf16_t* XsT = (LAS bf16_t*)(F.lds + 69632);
    LAS f32x4* vec = (LAS f32x4*)(F.lds + 104448);
    LAS float* ssq = (LAS float*)(F.lds + 112640);
    LAS bf16_t* SinL = (LAS bf16_t*)(F.lds + 113152);
    if (tid < 128) { const float* dr = (const float*)(F.ws + WS_DTRAW) + (size_t)(row0 + tid) * 8; ssq[tid] = 0.f;
#pragma unroll
        for (int h = 0; h < 4; ++h) vec[h * 128 + tid] = (f32x4){0.f, 0.f, softplusf_(dr[h] + F.in[I_SDTB][l * 8 + h]), softplusf_(dr[4 + h] + F.in[I_SDTB][l * 8 + 4 + h])}; }
    __syncthreads();
    {
        const int h = wid & 3, dir = wid >> 2; const float a = -__expf(F.in[I_SALOG][l * 8 + dir * 4 + h]); LAS float* vf = (LAS float*)(vec + h * 128);
        const int tA = dir ? 127 - 2 * lane : 2 * lane, tB = dir ? 126 - 2 * lane : 2 * lane + 1;
        const float dA = vf[4 * tA + 2 + dir] * a, dB = vf[4 * tB + 2 + dir] * a, incl = wave_incl_scan(dA + dB, lane);
        vf[4 * tA + dir] = incl - dB; vf[4 * tB + dir] = incl; }
    f32x16 Y[2], Yk0, Yk1;
#pragma unroll
    for (int r = 0; r < 16; ++r) { Yk0[r] = 0.f; Yk1[r] = 0.f; }
#pragma unroll 1
    for (int g = 0; g < 2; ++g) {
        __syncthreads();
        {
            const bf16_t* cv = (const bf16_t*)(F.ws + WS_CONV) + (size_t)row0 * 1024;
            const bf16_t* xt = (const bf16_t*)(F.ws + WS_XBT) + ((size_t)(b * 34 + c) * 512 + g * 128) * 136;
            u32x4 vc[4], vb[4], vx[5];
#pragma unroll
            for (int j = 0; j < 4; ++j) { const int p = tid + NTHR * j, r = p >> 4, c8 = (p & 15) * 8;
                vc[j] = *(const u32x4*)(cv + (size_t)r * 1024 + 768 + g * 128 + c8); vb[j] = *(const u32x4*)(cv + (size_t)r * 1024 + 512 + g * 128 + c8); }
#pragma unroll
            for (int j = 0; j < 5; ++j) { const int p = tid + NTHR * j; vx[j] = (p < 2176) ? *(const u32x4*)(xt + (size_t)p * 8) : (u32x4){0u, 0u, 0u, 0u}; }
#pragma unroll
            for (int j = 0; j < 4; ++j) { const int p = tid + NTHR * j, r = p >> 4, c8 = (p & 15) * 8; *(LAS u32x4*)(Cn + r * 136 + c8) = vc[j]; *(LAS u32x4*)(Bn + r * 136 + c8) = vb[j]; }
#pragma unroll
            for (int j = 0; j < 5; ++j) { const int p = tid + NTHR * j; if (p < 2176) *(LAS u32x4*)(XsT + p * 8) = vx[j]; }
        }
        __syncthreads();
        const int tq = tid_fresh(F.wave_s);
        const int lane_ = tq & 63, wid_ = __builtin_amdgcn_readfirstlane(tq >> 6), r32 = lane_ & 31, hi = lane_ >> 5;
        const int hg = wid_ >> 2, lb = wid_ & 3, h = 2 * g + hg;
        const LAS f32x4* vh = vec + h * 128;
        const int lme = lb * 32 + r32; const f32x4 vl = vh[lme];
        bf16x8 Pf[8];
#pragma unroll
        for (int sb = 0; sb < 4; ++sb) {
            f32x16 GT;
#pragma unroll
            for (int r = 0; r < 16; ++r) GT[r] = 0.f;
#pragma unroll
            for (int ks = 0; ks < 8; ++ks) { const bf16x8 cf = *(const LAS bf16x8*)(Cn + (lb * 32 + r32) * 136 + 16 * ks + 8 * hi);
                const bf16x8 bf = *(const LAS bf16x8*)(Bn + (sb * 32 + r32) * 136 + 16 * ks + 8 * hi); GT = MFMA32(bf, cf, GT); }
            float pm[16];
#pragma unroll
            for (int r = 0; r < 16; ++r) { const int sidx = sb * 32 + crow(r, hi); const f32x4 vs = vh[sidx];
                const float mf = (sidx <= lme) ? __expf(vl[0] - vs[0]) * vs[2] : 0.f, mb = (sidx >= lme) ? __expf(vl[1] - vs[1]) * vs[3] : 0.f;
                pm[r] = GT[r] * (mf + mb); }
            Pf[sb * 2] = __builtin_bit_cast(bf16x8, (u32x4){cvt_pk_bf16(pm[0], pm[1]), cvt_pk_bf16(pm[2], pm[3]), cvt_pk_bf16(pm[4], pm[5]), cvt_pk_bf16(pm[6], pm[7])});
            Pf[sb * 2 + 1] = __builtin_bit_cast(bf16x8, (u32x4){cvt_pk_bf16(pm[8], pm[9]), cvt_pk_bf16(pm[10], pm[11]), cvt_pk_bf16(pm[12], pm[13]), cvt_pk_bf16(pm[14], pm[15])});
            __builtin_amdgcn_sched_barrier(0);
        }
#pragma unroll
        for (int pb = 0; pb < 2; ++pb)
#pragma unroll
            for (int r = 0; r < 16; ++r) Y[pb][r] = 0.f;
#pragma unroll
        for (int k2 = 0; k2 < 8; ++k2)
#pragma unroll
            for (int pb = 0; pb < 2; ++pb) { const LAS bf16_t* xr = XsT + (hg * 64 + pb * 32 + r32) * 136 + 16 * k2 + 4 * hi;
                const u32x2 lo = *(const LAS u32x2*)xr, hi2 = *(const LAS u32x2*)(xr + 8);
                Y[pb] = MFMA32(Pf[k2], __builtin_bit_cast(bf16x8, (u32x4){lo.x, lo.y, hi2.x, hi2.y}), Y[pb]); }
#pragma unroll 1
        for (int dir = 0; dir < 2; ++dir) {
            {
                u32x4 vs[4];
#pragma unroll
                for (int j = 0; j < 4; ++j) { const int p = tq + NTHR * j, hh = p >> 10, pr = (p >> 4) & 63, c8 = (p & 15) * 8;
                    vs[j] = *(const u32x4*)((const bf16_t*)(F.ws + WS_SSDI) + (((size_t)(b * 34 + c) * 4 + 2 * g + hh) * 2 + dir) * 8192 + pr * 128 + c8); }
                __syncthreads();
#pragma unroll
                for (int j = 0; j < 4; ++j) { const int p = tq + NTHR * j, hh = p >> 10, pr = (p >> 4) & 63, c8 = (p & 15) * 8; *(LAS u32x4*)(SinL + (hh * 64 + pr) * 136 + c8) = vs[j]; }
                __syncthreads();
            }
            f32x16 T[2];
#pragma unroll
            for (int pb = 0; pb < 2; ++pb)
#pragma unroll
                for (int r = 0; r < 16; ++r) T[pb][r] = 0.f;
#pragma unroll 2
            for (int ks = 0; ks < 8; ++ks) { const bf16x8 cf = *(const LAS bf16x8*)(Cn + (lb * 32 + r32) * 136 + 16 * ks + 8 * hi);
#pragma unroll
                for (int pb = 0; pb < 2; ++pb) { const bf16x8 sf = *(const LAS bf16x8*)(SinL + (hg * 64 + pb * 32 + r32) * 136 + 16 * ks + 8 * hi); T[pb] = MFMA32(cf, sf, T[pb]); } }
#pragma unroll
            for (int r = 0; r < 16; ++r) { const f32x4 vr = vh[lb * 32 + crow(r, hi)]; const float sc = __expf(dir ? vr[1] : vr[0]);
                Y[0][r] += sc * T[0][r]; Y[1][r] += sc * T[1][r]; }
        }
        { const float dsk = F.in[I_SD][l * 4 + h];
#pragma unroll
          for (int r = 0; r < 16; ++r) { const int ll = lb * 32 + crow(r, hi); float sq = 0.f;
#pragma unroll
              for (int pb = 0; pb < 2; ++pb) { const int pc = hg * 64 + pb * 32 + r32;
                  const float xs = bf2f(XsT[pc * 136 + ll]), z = bf2f(proj[(size_t)(row0 + ll) * NPROJ + C_SZ + g * 128 + pc]);
                  const float y = (Y[pb][r] + dsk * xs) * siluf_(z); Y[pb][r] = y; sq += y * y; }
sq = half32_red<OpAdd>(sq);
              if (r32 == 0) atomicAdd((float*)(ssq + ll), sq); } }
        if (g == 0) { Yk0 = Y[0]; Yk1 = Y[1]; }
    }
    __syncthreads();
    { const int t1 = tid_fresh(F.wave_s); const int lane2 = t1 & 63, wid2 = t1 >> 6, r32b = lane2 & 31, hib = lane2 >> 5, hg = wid2 >> 2, lb = wid2 & 3;
      LAS bf16_t* stg = (LAS bf16_t*)F.lds;
      const float* gn = F.in[I_SNG] + l * 256 + hg * 64 + r32b;
      const float g00 = gn[0], g01 = gn[32], g10 = gn[128], g11 = gn[160];
#pragma unroll
      for (int r = 0; r < 16; ++r) { const int ll = lb * 32 + crow(r, hib); const float rs = __builtin_amdgcn_rsqf(ssq[ll] * (1.0f / 256.0f) + EPSN);
          LAS bf16_t* sr = stg + ll * 264 + hg * 64 + r32b;
          sr[0] = f2bf(Yk0[r] * rs * g00); sr[32] = f2bf(Yk1[r] * rs * g01); sr[128] = f2bf(Y[0][r] * rs * g10); sr[160] = f2bf(Y[1][r] * rs * g11); }
      __syncthreads();
      bf16_t* yb = (bf16_t*)(F.ws + WS_YMIX) + (size_t)row0 * DM + 256;
#pragma unroll
      for (int j = 0; j < 8; ++j) { const int p = t1 + NTHR * j, row = p >> 5, pc = p & 31; *(u32x4*)(yb + (size_t)row * DM + pc * 8) = *(const LAS u32x4*)(stg + row * 264 + pc * 8); } }
    __syncthreads();
}

struct AttnConsts { float Mb, lam, lam_init, shift, oml; };
__device__ __forceinline__ AttnConsts attn_consts(const Frame& F, int l) {
    AttnConsts c; const int lane = F.lane;
    float gq = fabsf(F.in[I_QN][l * 64 + lane]), gk = fabsf(F.in[I_KN][l * 64 + lane]);
gq = wave64_red<OpMax>(gq); gk = wave64_red<OpMax>(gk);
    c.Mb = __uint_as_float(__builtin_amdgcn_readfirstlane(__float_as_uint(64.0f * gq * gk * QSCALE * 1.001f)));
    const float d0 = wave_sum_l(F.in[I_LAMQ][l * 128 + lane] * F.in[I_LAMK][l * 128 + lane], lane);
    const float d1 = wave_sum_l(F.in[I_LAMQ][l * 128 + 64 + lane] * F.in[I_LAMK][l * 128 + 64 + lane], lane);
    c.lam_init = (l == 0) ? 0.2f : 0.8f - 0.6f * 0.7408182206817179f;
    c.lam = __uint_as_float(__builtin_amdgcn_readfirstlane(__float_as_uint(expf(d0) - expf(d1) + c.lam_init)));
    c.shift = __uint_as_float(__builtin_amdgcn_readfirstlane(__float_as_uint((c.Mb > 40.f) ? (c.Mb - 40.f) : 0.f)));
    c.oml = __uint_as_float(__builtin_amdgcn_readfirstlane(__float_as_uint(1.0f - c.lam_init)));
    return c;
}
__device__ __forceinline__ void p_post(const Frame& F, int l) {
    for (int rep = 0; rep < (MK_DUP == 31 ? 2 : 1); ++rep)
    for (int u = F.bx; u < 272; u += F.G) ssd_p1_unit(F, l, u);
    { LruW W; lru_load_w(F, l, W);
      for (int rep = 0; rep < (MK_DUP == 32 ? 2 : 1); ++rep)
      for (int u = (F.bx + F.G - 48) % F.G; u < 1088; u += F.G) lru_unit<1>(F, l, u, W); }
    __syncthreads();
    LAS float* tab = (LAS float*)F.lds;
    c1_setup(F, tab);
    for (int rep = 0; rep < (MK_DUP == 33 ? 2 : 1); ++rep)
    for (int u = (F.bx + F.G - 16) % F.G; u < 544; u += F.G) c1_unit(F, l, u, tab);
}
__device__ __forceinline__ void p_mix2(const Frame& F, int l) {
    if (l == 0) {
        for (int u = F.bx; u < 272; u += F.G) ssd_p2_unit(F, l, u);
        if (F.bx >= 16 || F.G < 64) { LruW W; lru_load_w(F, l, W); const int nw = (F.G >= 64) ? F.G - 16 : F.G, w0 = (F.G >= 64) ? F.bx - 16 : F.bx;
          for (int u = w0; u < 1088; u += nw) lru_unit<2>(F, l, u, W); }
    } else {
        for (int i = F.bx; i < 256; i += F.G) ssd_p2_unit(F, l, (i >> 5) * 34 + 2 + (i & 31));
        LruW W; lru_load_w(F, l, W);
        for (int i = F.bx; i < 1024; i += F.G) lru_unit<2>(F, l, (i >> 7) * 136 + 8 + (i & 127), W);
    }
}
__device__ __forceinline__ void p_attn(const Frame& F, int l) {
    for (int u = F.bx; u < 256; u += F.G) ssd_carry_unit(F, u);
    for (int u = F.bx; u < 64; u += F.G) lru_carry_unit(F, u);
    const AttnConsts c = attn_consts(F, l);
    if (l == 0) for (int t = F.G - 1 - F.bx; t < 32; t += F.G) attn_unit(F, l, t >> 2, t & 3, 0, c.shift, c.lam, c.oml);
    for (int u = F.bx; u < 512; u += F.G) { const int bh = u % 32, qi = u / 32; attn_unit(F, l, bh >> 2, bh & 3, qi + 1, c.shift, c.lam, c.oml); }
}

struct EpiOut {
    static constexpr bool META = false, BIAS = false; static constexpr int NST = 16;
    bf16_t* O;
    __device__ __forceinline__ const int* mptr0(const gm::GU&, int) const { return nullptr; }
    __device__ __forceinline__ const int* mptr1(const gm::GU&, int) const { return nullptr; }
    __device__ __forceinline__ void operator()(const f32x4 (&acc)[2][2][4][2], const gm::GU& u, int tz, LAS unsigned char*) const {
        const int wid = tz >> 6, lane = tz & 63, wr = wid >> 2, wc = wid & 3, fr = lane & 15, fq = lane >> 4;
        const int row0 = u.m0 + wr * 64 + fr, col0 = u.pn * 256 + wc * 32 + 8 * fq;
#pragma unroll
        for (int ai = 0; ai < 2; ++ai)
#pragma unroll
            for (int m = 0; m < 4; ++m) { bf16_t* rowp = O + (size_t)(row0 + ai * 128 + m * 16) * DM + col0;
#pragma unroll
                for (int bj = 0; bj < 2; ++bj) { const f32x4 v0 = acc[ai][bj][m][0], v1 = acc[ai][bj][m][1];
                    *(u32x4*)(rowp + bj * 128) = (u32x4){cvt_pk_bf16(v0[0], v0[1]), cvt_pk_bf16(v0[2], v0[3]), cvt_pk_bf16(v1[0], v1[1]), cvt_pk_bf16(v1[2], v1[3])}; } }
    }
};
__device__ __forceinline__ void p_outproj(const Frame& F, int l, bool dummy = false) {
    gm::DenseSched S; S.nrb = NROW / 256; S.npn = 4; S.x = F.gx; S.j = F.gj; S.wpx = F.gn;
    S.Bt = (const char*)(F.ws + WS_WOUT) + (size_t)l * 1024 * 1024 * 2; S.btile = (size_t)256 * 1024 * 2; S.skipctx = (l == 1);
    if (slack_on(F) && l == 0 && !dummy) { if (F.gj >= F.gn - SLK_OUT0) { cvt_slack(F, SLK_A, SLK_B, F.gx * SLK_OUT0 + (F.gj - (F.gn - SLK_OUT0)), 8 * SLK_OUT0); return; } S.wpx = F.gn - SLK_OUT0; }
    EpiOut E{(bf16_t*)(F.ws + (dummy ? WS_YSLOT : WS_CONV))};
    gm::gemm_phase<true, false>(F.lds, (const char*)(F.ws + WS_YMIX), S, E, F.wave_s);
}

__device__ __forceinline__ void p_norm2(const Frame& F, int l, bool dummy = false) {
    constexpr int HSTR = 1032;
    LAS bf16_t* hbH = (LAS bf16_t*)F.lds;
    LAS bf16_t* hbL = hbH + 8 * HSTR;
    LAS float* part = (LAS float*)(hbL + 8 * HSTR);
    constexpr int NTR = 40;
    LAS int* ent = (LAS int*)(F.lds + 131072);
    LAS int* lcnt = ent + 8 * NTR * 4;
    LAS int* gb = lcnt + 32;
    LAS float* entg = (LAS float*)(gb + 32);
    const int tid = F.tid, lane = F.lane, wid = F.wid;
    bf16x8 wh[4][2], wl[4][2];
    { const float* src = F.in[I_RW] + (size_t)l * 1024 * 32 + (size_t)(wid * 128 + 8 * (lane >> 4)) * 32 + (lane & 15);
#pragma unroll
      for (int ks = 0; ks < 4; ++ks)
#pragma unroll
          for (int eh = 0; eh < 2; ++eh) { unsigned ph[4], pl[4];
#pragma unroll
              for (int q = 0; q < 4; ++q) { const float w0 = src[(size_t)(32 * ks + 2 * q) * 32 + 16 * eh], w1 = src[(size_t)(32 * ks + 2 * q + 1) * 32 + 16 * eh];
                  ph[q] = cvt_pk_bf16(w0, w1); pl[q] = cvt_pk_bf16(w0 - bflo(ph[q]), w1 - bfhi(ph[q])); }
              wh[ks][eh] = __builtin_bit_cast(bf16x8, (u32x4){ph[0], ph[1], ph[2], ph[3]}); wl[ks][eh] = __builtin_bit_cast(bf16x8, (u32x4){pl[0], pl[1], pl[2], pl[3]}); } }
    for (int idx = tid; idx < 8 * NTR * 4; idx += NTHR) ent[idx] = -1;
    if (tid < 32) lcnt[tid] = 0;
    __syncthreads();
    const float* ng = F.in[I_N2G] + l * DM;
    f32x4 g[4];
#pragma unroll
    for (int i = 0; i < 4; ++i) g[i] = *(const f32x4*)(ng + lane * 4 + 256 * i);
    const float rbias = F.in[I_RB][l * 32 + (lane >> 1)];
    const int ntrip0 = (NROW + F.G * 8 - 1) / (F.G * 8), ntrip = ntrip0 < NTR ? ntrip0 : NTR;
    for (int it = 0; it < ntrip; ++it) {
        const int row = F.bx * 8 + wid + it * F.G * 8;
        const int bq = row / TPB, pos = row - bq * TPB;
        const bool ok = row < NROW && !(l == 1 && pos < CTXL);
        if (ok) {
            const float* mod = (const float*)(F.ws + WS_MOD) + (size_t)(l * 9 + (pos < CTXL ? 8 : bq)) * 6144;
            const float* xr = row_input(F, row); const bf16_t* xb = (const bf16_t*)(F.ws + WS_XRES) + (size_t)row * DM;
            const bf16_t* orow = (const bf16_t*)(F.ws + WS_CONV) + (size_t)row * DM;
            bf16_t* xw = (bf16_t*)(F.ws + (dummy ? WS_YSLOT + (128u << 20) : WS_XRES)) + (size_t)(dummy ? 0 : row) * DM;
            f32x4 x[4]; float ss = 0.f;
#pragma unroll
            for (int i = 0; i < 4; ++i) { const int c = lane * 4 + 256 * i; const u32x2 ow = *(const u32x2*)(orow + c);
                f32x4 xin; if (l == 0) xin = *(const f32x4*)(xr + c); else { const u32x2 xv = *(const u32x2*)(xb + c); xin = (f32x4){bflo(xv.x), bfhi(xv.x), bflo(xv.y), bfhi(xv.y)}; }
                x[i] = xin + *(const f32x4*)(mod + 2 * 1024 + c) * (f32x4){bflo(ow.x), bfhi(ow.x), bflo(ow.y), bfhi(ow.y)};
                st_wt(xw + c, (u32x2){cvt_pk_bf16(x[i][0], x[i][1]), cvt_pk_bf16(x[i][2], x[i][3])});
                ss += x[i][0] * x[i][0] + x[i][1] * x[i][1] + x[i][2] * x[i][2] + x[i][3] * x[i][3]; }
            ss = wave_sum_l(ss, lane);
            const float rstd = __builtin_amdgcn_rsqf(ss * (1.0f / DM) + EPSN);
            bf16_t* hp = (bf16_t*)(F.ws + WS_H) + (size_t)row * DM;
#pragma unroll
            for (int i = 0; i < 4; ++i) { const int c = lane * 4 + 256 * i;
                const f32x4 sh = *(const f32x4*)(mod + 3 * 1024 + c), sc = *(const f32x4*)(mod + 4 * 1024 + c);
                const f32x4 h = x[i] * rstd * g[i] * (sc + 1.0f) + sh;
                st_wt(hp + c, (u32x2){cvt_pk_bf16(h[0], h[1]), cvt_pk_bf16(h[2], h[3])});
                const unsigned h01 = cvt_pk_bf16(h[0], h[1]), h23 = cvt_pk_bf16(h[2], h[3]);
                *(LAS u32x2*)(hbH + wid * HSTR + c) = (u32x2){h01, h23};
                *(LAS u32x2*)(hbL + wid * HSTR + c) = (u32x2){cvt_pk_bf16(h[0] - bflo(h01), h[1] - bfhi(h01)), cvt_pk_bf16(h[2] - bflo(h23), h[3] - bfhi(h23))}; }
        }
        __syncthreads();
        {
            const LAS bf16_t* ah = hbH + (lane & 7) * HSTR + wid * 128 + 8 * (lane >> 4); const LAS bf16_t* al = hbL + (lane & 7) * HSTR + wid * 128 + 8 * (lane >> 4);
            f32x4 d0 = (f32x4){0.f, 0.f, 0.f, 0.f}, d1 = (f32x4){0.f, 0.f, 0.f, 0.f};
#pragma unroll
            for (int ks = 0; ks < 4; ++ks) { const bf16x8 xh = *(const LAS bf16x8*)(ah + 32 * ks), xl = *(const LAS bf16x8*)(al + 32 * ks);
                d0 = __builtin_amdgcn_mfma_f32_16x16x32_bf16(xh, wh[ks][0], d0, 0, 0, 0); d1 = __builtin_amdgcn_mfma_f32_16x16x32_bf16(xh, wh[ks][1], d1, 0, 0, 0);
                d0 = __builtin_amdgcn_mfma_f32_16x16x32_bf16(xh, wl[ks][0], d0, 0, 0, 0); d1 = __builtin_amdgcn_mfma_f32_16x16x32_bf16(xh, wl[ks][1], d1, 0, 0, 0);
                d0 = __builtin_amdgcn_mfma_f32_16x16x32_bf16(xl, wh[ks][0], d0, 0, 0, 0); d1 = __builtin_amdgcn_mfma_f32_16x16x32_bf16(xl, wh[ks][1], d1, 0, 0, 0); }
            if (lane < 32) { LAS float* pp = part + (wid * 8 + 4 * (lane >> 4)) * 32 + (lane & 15);
#pragma unroll
                for (int i = 0; i < 4; ++i) { pp[i * 32] = d0[i]; pp[i * 32 + 16] = d1[i]; } }
        }
        __syncthreads();
        if (ok) {
            float logit = rbias;
#pragma unroll
            for (int w = 0; w < 8; ++w) logit += part[(w * 8 + wid) * 32 + (lane >> 1)];
            int sel0 = 0, sel1 = 0, sel2 = 0, sel3 = 0; float val0 = 0.f, val1 = 0.f, val2 = 0.f, val3 = 0.f;
#pragma unroll
            for (int r = 0; r < 4; ++r) { float m = logit;
m = wave64_red<OpMax>(m);
                const unsigned long long bal = __ballot(logit == m); const int first = bal ? (__builtin_ctzll(bal) >> 1) : 0;
                if (r == 0) { sel0 = first; val0 = m; } else if (r == 1) { sel1 = first; val1 = m; } else if (r == 2) { sel2 = first; val2 = m; } else { sel3 = first; val3 = m; }
                if ((lane >> 1) == first) logit = -INFINITY; }
            const float e1 = __expf(val1 - val0), e2 = __expf(val2 - val0), e3 = __expf(val3 - val0), inv = 1.0f / (1.0f + e1 + e2 + e3);
            if (lane < 4) { const int e = lane == 0 ? sel0 : (lane == 1 ? sel1 : (lane == 2 ? sel2 : sel3));
                const float gt = (lane == 0 ? 1.0f : (lane == 1 ? e1 : (lane == 2 ? e2 : e3))) * inv;
                const int lp = atomicAdd((int*)(lcnt + e), 1);
                ent[(wid * NTR + it) * 4 + lane] = e | (lp << 8); entg[(wid * NTR + it) * 4 + lane] = gt;
                ((float*)(F.ws + (dummy ? WS_YSLOT + (64u << 20) : WS_TOKG)))[(size_t)row * 4 + lane] = gt; ((int*)(F.ws + (dummy ? WS_YSLOT + (96u << 20) : WS_TOKE)))[(size_t)row * 4 + lane] = e; }
        }
    }
    __syncthreads();
    if (tid < 32) gb[tid] = atomicAdd((int*)(F.ws + WS_CNT) + (dummy ? 64 : 0) + l * 32 + tid, lcnt[tid]);
    __syncthreads();
    for (int idx = tid; idx < 8 * NTR * 4; idx += NTHR) { const int v = ent[idx]; if (v < 0) continue;
        const int w = idx / (NTR * 4), it2 = (idx - w * (NTR * 4)) >> 2, r = idx & 3, row = F.bx * 8 + w + it2 * F.G * 8, e = v & 255, lp = v >> 8;
        ((int*)(F.ws + (dummy ? WS_YSLOT : WS_LIST)))[(size_t)e * NROW + gb[e] + lp] = row * 4 + r;
        ((float*)(F.ws + (dummy ? WS_YSLOT + (32u << 20) : WS_LISTG)))[(size_t)e * NROW + gb[e] + lp] = entg[idx]; }
    __syncthreads();
}

struct MoeTab { LAS int* first; LAS int* cntl; LAS int* tabe; int nbt; };
__device__ __forceinline__ MoeTab moe_tables(const Frame& F, int l) {
    MoeTab T; T.first = (LAS int*)(F.lds + 131072); T.cntl = T.first + 40; T.tabe = T.cntl + 32;
    if (F.tid < 32) T.cntl[F.tid] = ((const int*)(F.ws + WS_CNT))[l * 32 + F.tid];
    __syncthreads();
    if (F.tid == 0) { int a = 0; for (int e = 0; e < 32; ++e) { T.first[e] = a; a += (T.cntl[e] + 255) >> 8; } T.first[32] = a; }
    __syncthreads();
    T.nbt = T.first[32];
    for (int rb = F.tid; rb < T.nbt; rb += NTHR) { int e = 0; while (rb >= T.first[e + 1]) ++e; T.tabe[rb] = e; }
    __syncthreads();
    return T;
}
struct MoeSched {
    MoeTab T; int npn, x, j, wpx, gsz, gather; const char* W; size_t wexp; const int* list;
    __device__ __forceinline__ bool next(int i, gm::GU& u) const {
        const int v = i * wpx + j, rbl = v / npn, gq = rbl / gsz, rbg = gq * (8 * gsz) + x * gsz + (rbl - gq * gsz);
        if (rbg >= T.nbt) return false;
        const int e = __builtin_amdgcn_readfirstlane(T.tabe[rbg]), f = __builtin_amdgcn_readfirstlane(T.first[e]), cn = __builtin_amdgcn_readfirstlane(T.cntl[e]);
        const int rb = rbg - f, nr = cn - rb * 256;
        u.pn = v - rbl * npn; u.e = e; u.rbg = rbg; u.m0 = gather ? rb * 256 : rbg * 256; u.nrows = nr < 256 ? nr : 256;
        u.bptr = W + (size_t)e * wexp + (size_t)u.pn * (256 * 1024 * 2); return true;
    }
    __device__ __forceinline__ const int* lptr(const gm::GU& u, int r) const { const int rc = r < u.nrows ? r : u.nrows - 1; return list + (size_t)u.e * NROW + u.m0 + rc; }
    __device__ __forceinline__ unsigned arow(const gm::GU& u, int r) const { return (unsigned)(*lptr(u, r) >> 2); }
};
struct EpiGU {
    static constexpr bool META = false, BIAS = true; static constexpr int NST = 8;
    bf16_t* act; const float* bgu;
    __device__ __forceinline__ const int* mptr0(const gm::GU&, int) const { return nullptr; }
    __device__ __forceinline__ const int* mptr1(const gm::GU&, int) const { return nullptr; }
    __device__ __forceinline__ const float* bptr(const gm::GU& u, int i) const { return bgu + (size_t)u.e * 2048 + u.pn * 256 + i; }
    __device__ __forceinline__ void operator()(const f32x4 (&acc)[2][2][4][2], const gm::GU& u, int tz, LAS unsigned char* lds) const {
        const int wid = tz >> 6, lane = tz & 63, wr = wid >> 2, wc = wid & 3, fr = lane & 15, fq = lane >> 4;
        const int a0 = u.pn * 128 + wc * 32 + 8 * fq;
        const LAS float* bp = (const LAS float*)(lds + gm::STAGE_BYTES + 16384) + 2 * (wc * 32 + 8 * fq);
        f32x4 bb[4];
#pragma unroll
        for (int q = 0; q < 4; ++q) bb[q] = *(const LAS f32x4*)(bp + 4 * q);
        bf16_t* base = act + (size_t)(u.rbg * 256 + wr * 64 + fr) * DEXP + a0;
#pragma unroll
        for (int ai = 0; ai < 2; ++ai)
#pragma unroll
            for (int m = 0; m < 4; ++m) { float o[8];
#pragma unroll
                for (int n = 0; n < 2; ++n)
#pragma unroll
                    for (int jx = 0; jx < 4; ++jx) { const int a = 4 * n + jx; const float bg = bb[a >> 1][(a & 1) * 2], bu = bb[a >> 1][(a & 1) * 2 + 1];
                        float gt = acc[ai][0][m][n][jx] + bg, up = acc[ai][1][m][n][jx] + bu;
                        gt = fminf(gt, 7.0f); up = fminf(fmaxf(up, -7.0f), 7.0f);
                        o[a] = (up + 1.0f) * gt * __builtin_amdgcn_rcpf(1.0f + __builtin_amdgcn_exp2f(gt * (-1.702f * 1.4426950408889634f))); }
                *(u32x4*)(base + (size_t)(ai * 128 + m * 16) * DEXP) = (u32x4){cvt_pk_bf16(o[0], o[1]), cvt_pk_bf16(o[2], o[3]), cvt_pk_bf16(o[4], o[5]), cvt_pk_bf16(o[6], o[7])}; }
    }
};
struct EpiDown {
    static constexpr bool META = true, BIAS = true; static constexpr int NST = 16;
    bf16_t* ys; const float* bd; const int* list; const float* listg; const LAS int* first;
    __device__ __forceinline__ const float* bptr(const gm::GU& u, int i) const { return bd + (size_t)u.e * 1024 + u.pn * 256 + i; }
    __device__ __forceinline__ size_t lpos(const gm::GU& u, int r) const { const int rc = r < u.nrows ? r : u.nrows - 1; return (size_t)u.e * NROW + (size_t)((u.rbg - first[u.e]) * 256 + rc); }
    __device__ __forceinline__ const int* mptr0(const gm::GU& u, int r) const { return list + lpos(u, r); }
    __device__ __forceinline__ const int* mptr1(const gm::GU& u, int r) const { return (const int*)listg + lpos(u, r); }
    __device__ __forceinline__ void operator()(const f32x4 (&acc)[2][2][4][2], const gm::GU& u, int tz, LAS unsigned char* lds) const {
        const int wid = tz >> 6, lane = tz & 63, wr = wid >> 2, wc = wid & 3, fr = lane & 15, fq = lane >> 4;
        const int col0 = u.pn * 256 + wc * 32 + 8 * fq;
        const LAS unsigned* mslot = (const LAS unsigned*)(lds + gm::STAGE_BYTES + 4096); const LAS float* mgate = (const LAS float*)(lds + gm::STAGE_BYTES + 5120);
        const LAS float* bl = (const LAS float*)(lds + gm::STAGE_BYTES + 16384) + wc * 32 + 8 * fq;
        f32x4 bv[2][2];
#pragma unroll
        for (int bj = 0; bj < 2; ++bj)
#pragma unroll
            for (int n = 0; n < 2; ++n) bv[bj][n] = *(const LAS f32x4*)(bl + bj * 128 + 4 * n);
#pragma unroll
        for (int ai = 0; ai < 2; ++ai)
#pragma unroll
            for (int m = 0; m < 4; ++m) { const int r = ai * 128 + wr * 64 + m * 16 + fr;
                const float gt = mgate[r]; const unsigned sl = r < u.nrows ? mslot[r] : (unsigned)(NROW * 4); bf16_t* rowp = ys + (size_t)sl * DM + col0;
#pragma unroll
                for (int bj = 0; bj < 2; ++bj) { const f32x4 v0 = (acc[ai][bj][m][0] + bv[bj][0]) * gt, v1 = (acc[ai][bj][m][1] + bv[bj][1]) * gt;
                    *(u32x4*)(rowp + bj * 128) = (u32x4){cvt_pk_bf16(v0[0], v0[1]), cvt_pk_bf16(v0[2], v0[3]), cvt_pk_bf16(v1[0], v1[1]), cvt_pk_bf16(v1[2], v1[3])}; } }
    }
};
__device__ __forceinline__ void p_moe_gu(const Frame& F, int l) {
    MoeSched S; S.T = moe_tables(F, l); S.npn = 8; S.x = F.gx; S.j = F.gj; S.wpx = F.gn; S.gsz = F.gn >= 8 ? F.gn / 8 : 1; S.gather = 1;
    S.W = (const char*)(F.ws + WS_WGU) + (size_t)l * 32 * 2048 * 1024 * 2; S.wexp = (size_t)2048 * 1024 * 2; S.list = (const int*)(F.ws + WS_LIST);
    EpiGU E{(bf16_t*)(F.ws + WS_ACT), F.in[I_BGU] + (size_t)l * 32 * 2048};
    gm::gemm_phase<true, true>(F.lds, (const char*)(F.ws + WS_H), S, E, F.wave_s);
}
__device__ __forceinline__ void p_moe_down(const Frame& F, int l) {
    MoeSched S; S.T = moe_tables(F, l); S.npn = 4; S.x = F.gx; S.j = F.gj; S.wpx = F.gn; S.gsz = F.gn >= 4 ? F.gn / 4 : 1; S.gather = 0;
    S.W = (const char*)(F.ws + WS_WD) + (size_t)l * 32 * 1024 * 1024 * 2; S.wexp = (size_t)1024 * 1024 * 2; S.list = (const int*)(F.ws + WS_LIST);
    EpiDown E{(bf16_t*)(F.ws + WS_YSLOT), F.in[I_BD] + (size_t)l * 32 * 1024, (const int*)(F.ws + WS_LIST), (const float*)(F.ws + WS_LISTG), S.T.first};
    gm::gemm_phase<true, false>(F.lds, (const char*)(F.ws + WS_ACT), S, E, F.wave_s);
}
__device__ __forceinline__ void p_final(const Frame& F) {
    const int lane = F.lane;
    for (int r = F.bx * 8 + F.wid; r < NBATCH * SEQ; r += F.G * 8) { const int b = r >> 12, t = r & 4095, row = b * TPB + CTXL + t;
        f32x4 x[4]; load_row_x(F, 2, row, x);
        float* op = F.out + (size_t)r * DM;
#pragma unroll
        for (int i = 0; i < 4; ++i) *(f32x4*)(op + lane * 4 + 256 * i) = x[i]; }
}

#if MK_DBG
__device__ __forceinline__ void dbg_acc(const Frame& F, int chk, float got, float ref) {
    float* d = (float*)(F.ws + WS_DBG);
    float e = got - ref; float n = e * e, q = ref * ref;
    if (!(n == n) || n > 1e30f) n = 1e30f;
    atomicAdd(d + 2 * chk, n); atomicAdd(d + 2 * chk + 1, q);
}
__device__ __forceinline__ unsigned hash_u(unsigned x) { x ^= x >> 16; x *= 0x7feb352du; x ^= x >> 15; x *= 0x846ca68bu; x ^= x >> 16; return x; }
__device__ void dbg_check_01(const Frame& F, int l) {
    const int gt = F.bx * NTHR + F.tid;
    { const unsigned hsh = hash_u(gt * 2654435761u + 17u + l); const int r = hsh % 9, j = (hsh >> 8) % 6144; float s = 0.f;
      for (int k = 0; k < 1024; ++k) { const float v = r < 8 ? F.in[I_C][r * 1024 + k] : F.in[I_CCTX][k]; s += siluf_(v) * F.in[I_WMOD][((size_t)l * 1024 + k) * 6144 + j]; }
      s += F.in[I_BMOD][l * 6144 + j];
      dbg_acc(F, 0, ((const float*)(F.ws + WS_MOD))[(size_t)(l * 9 + r) * 6144 + j], s); }
    LAS float* hrow = (LAS float*)F.lds; LAS float* red = hrow + 1024;
    const int row = hash_u(F.bx * 977u + 5u) % NROW;
    const float* xr = (const float*)(F.ws + WS_XRES) + (size_t)row * DM;
    float ss = 0.f; for (int k = F.tid; k < 1024; k += NTHR) ss += xr[k] * xr[k];
    ss = wave_sum(ss); if (F.lane == 0) red[F.wid] = ss; __syncthreads();
    float tot = 0.f; for (int w = 0; w < 8; ++w) tot += red[w];
    const float rstd = 1.0f / sqrtf(tot / 1024.f + EPSN);
    const float* mod = (const float*)(F.ws + WS_MOD) + (size_t)(l * 9 + row_mrow(row)) * 6144;
    for (int k = F.tid; k < 1024; k += NTHR) hrow[k] = xr[k] * rstd * F.in[I_N1G][l * 1024 + k] * (1.f + mod[1024 + k]) + mod[k];
    __syncthreads();
    for (int q = 0; q < 2; ++q) { const int n = hash_u(gt * 31u + q) % 3080; float s = 0.f;
        for (int k = 0; k < 1024; ++k) s += hrow[k] * F.in[I_WIN][((size_t)l * 1024 + k) * 3080 + n];
        float got;
        if (n >= 1536 && n < 1544) got = ((const float*)(F.ws + WS_DTRAW))[(size_t)row * 8 + n - 1536];
        else got = bf2f(((const bf16_t*)(F.ws + WS_PROJ))[(size_t)row * NPROJ + (n < 1536 ? n : n - 8)]);
        dbg_acc(F, 1, got, s); }
    __syncthreads();
}
__device__ void dbg_check_2(const Frame& F, int l) {
    LAS float* qh = (LAS float*)F.lds;
    LAS float* w = qh + 128;
    LAS float* red = w + 2 * TPB;
    LAS float* ov = red + 64;
    const bf16_t* proj = (const bf16_t*)(F.ws + WS_PROJ);
    const unsigned hs = hash_u(F.bx * 7919u + 13u + l);
    const int b = hs & 7, h = (hs >> 3) & 3; int pos = (hs >> 5) % TPB; if (l == 1 && pos < CTXL) pos += CTXL;
    const bool lat = pos >= CTXL; const int nk = lat ? TPB : CTXL; const int row = b * TPB + pos;
    const AttnConsts ac = attn_consts(F, l);
    if (F.tid < 128) { const int sub = F.tid >> 6, d = F.tid & 63; const bf16_t* src = proj + (size_t)row * NPROJ + C_Q + h * 128 + sub * 64; float ss = 0.f;
        for (int k = 0; k < 64; ++k) ss += bf2f(src[k]) * bf2f(src[k]);
        const float rstd = 1.0f / sqrtf(ss / 64.f + EPSN); const int dp = d ^ 32;
        float n = bf2f(src[d]) * rstd * F.in[I_QN][l * 64 + d], m = bf2f(src[dp]) * rstd * F.in[I_QN][l * 64 + dp];
        if (lat) { const int tp = pos - CTXL, i = d & 31; const float ang = (float)((i < 16) ? (tp >> 6) : (tp & 63)) * powf(10000.f, -(float)(i & 15) / 16.f);
            n = (d < 32) ? n * cosf(ang) - m * sinf(ang) : n * cosf(ang) + m * sinf(ang); }
        qh[F.tid] = n; }
    __syncthreads();
    for (int j = F.tid; j < nk; j += NTHR) {
        for (int sub = 0; sub < 2; ++sub) { const bf16_t* src = proj + (size_t)(b * TPB + j) * NPROJ + C_K + h * 128 + sub * 64; float ss = 0.f;
            for (int k = 0; k < 64; ++k) ss += bf2f(src[k]) * bf2f(src[k]);
            const float rstd = 1.0f / sqrtf(ss / 64.f + EPSN); float dot = 0.f;
            for (int i = 0; i < 32; ++i) { float n1 = bf2f(src[i]) * rstd * F.in[I_KN][l * 64 + i], n2 = bf2f(src[i + 32]) * rstd * F.in[I_KN][l * 64 + i + 32];
                if (j >= CTXL) { const int tp = j - CTXL; const float ang = (float)((i < 16) ? (tp >> 6) : (tp & 63)) * powf(10000.f, -(float)(i & 15) / 16.f); const float cs = cosf(ang), sn = sinf(ang);
                    const float o1 = n1 * cs - n2 * sn, o2 = n2 * cs + n1 * sn; n1 = o1; n2 = o2; }
                dot += qh[sub * 64 + i] * n1 + qh[sub * 64 + i + 32] * n2; }
            w[sub * TPB + j] = dot * 0.125f; } }
    __syncthreads();
    float inv[2];
    for (int sub = 0; sub < 2; ++sub) {
        float mx = -1e30f; for (int j = F.tid; j < nk; j += NTHR) mx = fmaxf(mx, w[sub * TPB + j]);
        for (int o = 32; o >= 1; o >>= 1) mx = fmaxf(mx, __shfl_xor(mx, o));
        if (F.lane == 0) red[F.wid] = mx; __syncthreads();
        mx = red[0]; for (int k = 1; k < 8; ++k) mx = fmaxf(mx, red[k]); __syncthreads();
        float sm = 0.f; for (int j = F.tid; j < nk; j += NTHR) { const float e = expf(w[sub * TPB + j] - mx); w[sub * TPB + j] = e; sm += e; }
        sm = wave_sum(sm); if (F.lane == 0) red[F.wid] = sm; __syncthreads();
        sm = 0.f; for (int k = 0; k < 8; ++k) sm += red[k]; __syncthreads();
        inv[sub] = 1.0f / sm; }
    if (F.tid < 128) { float o = 0.f;
        for (int j = 0; j < nk; ++j) o += (w[j] * inv[0] - ac.lam * w[TPB + j] * inv[1]) * bf2f(proj[(size_t)(b * TPB + j) * NPROJ + C_V + h * 128 + F.tid]);
        ov[F.tid] = o; }
    __syncthreads();
    if (F.tid < 128) { float ss = 0.f; for (int k = 0; k < 128; ++k) ss += ov[k] * ov[k];
        const float ref = ov[F.tid] / sqrtf(ss / 128.f + EPSN) * F.in[I_SUBG][l * 128 + F.tid] * (1.f - ac.lam_init);
        dbg_acc(F, 2, bf2f(((const bf16_t*)(F.ws + WS_YMIX))[(size_t)row * DM + 512 + h * 128 + F.tid]), ref); }
    __syncthreads();
}
__device__ __forceinline__ void dbg_acc2(const Frame& F, int chk, float num, float den) {
    num = wave_sum(num); den = wave_sum(den);
    if (F.lane == 0) { if (!(num == num) || num > 1e30f) num = 1e30f; float* d = (float*)(F.ws + WS_DBG); atomicAdd(d + 2 * chk, num); atomicAdd(d + 2 * chk + 1, den); }
}
__device__ __forceinline__ float dbg_px(const Frame& F, int b, int pos, int col, int seg_lo, int seg_hi) {
    return (pos >= seg_lo && pos < seg_hi) ? bf2f(((const bf16_t*)(F.ws + WS_PROJ))[(size_t)(b * TPB + pos) * NPROJ + col]) : 0.f; }
__device__ void dbg_check_3(const Frame& F, int l) {
    LAS float* A = (LAS float*)F.lds;
    const unsigned hs = hash_u(F.bx * 131u + 7u + l); const int b = hs & 7, ch = (hs >> 3) & 255, h = ch >> 6, cj = ch & 63;
    for (int pos = F.tid; pos < TPB; pos += NTHR) { const int seg_lo = pos < CTXL ? 0 : CTXL, seg_hi = pos < CTXL ? CTXL : TPB;
        float da0 = 0.f, dx0 = 0.f, da1 = 0.f, dx1 = 0.f, xself = 0.f;
        for (int i = 0; i < 64; ++i) { const int ci = h * 64 + i; float xc = F.in[I_LCB][l * 256 + ci];
            for (int j = 0; j < 4; ++j) xc += F.in[I_LCW][(l * 4 + j) * 256 + ci] * dbg_px(F, b, pos + j - 2, C_LX + ci, seg_lo, seg_hi);
            if (i == cj) xself = xc;
            da0 += xc * F.in[I_LWA][(size_t)(((l * 2 + 0) * 4 + h) * 64 + i) * 64 + cj]; dx0 += xc * F.in[I_LWX][(size_t)(((l * 2 + 0) * 4 + h) * 64 + i) * 64 + cj];
            da1 += xc * F.in[I_LWA][(size_t)(((l * 2 + 1) * 4 + h) * 64 + i) * 64 + cj]; dx1 += xc * F.in[I_LWX][(size_t)(((l * 2 + 1) * 4 + h) * 64 + i) * 64 + cj]; }
        for (int dir = 0; dir < 2; ++dir) { const int pi = (l * 2 + dir) * 256 + ch; const float da = dir ? da1 : da0, dx = dir ? dx1 : dx0;
            const float r = 1.f / (1.f + expf(-(da + F.in[I_LBA][pi]))), ii = 1.f / (1.f + expf(-(dx + F.in[I_LBX][pi])));
            const float la = -8.f * r * log1pf(expf(-F.in[I_LLAM][pi])); A[(2 * dir) * TPB + pos] = expf(la); A[(2 * dir + 1) * TPB + pos] = sqrtf(-expm1f(2.f * la)) * ii * xself; } }
    __syncthreads();
    if (F.tid == 0) { float hh = 0.f; for (int pos = 0; pos < TPB; ++pos) { hh = A[pos] * hh + A[TPB + pos]; A[TPB + pos] = hh; } }
    if (F.tid == 64) { float hh = 0.f; for (int pos = CTXL - 1; pos >= 0; --pos) { hh = A[2 * TPB + pos] * hh + A[3 * TPB + pos]; A[3 * TPB + pos] = hh; }
        for (int pos = TPB - 1; pos >= CTXL; --pos) { hh = A[2 * TPB + pos] * hh + A[3 * TPB + pos]; A[3 * TPB + pos] = hh; } }
    __syncthreads();
    float num = 0.f, den = 0.f;
    for (int pos = F.tid; pos < TPB; pos += NTHR) { const size_t row = (size_t)b * TPB + pos; const float g = bf2f(((const bf16_t*)(F.ws + WS_PROJ))[row * NPROJ + C_LG + ch]);
        const float ref = 0.5f * g * (1.f + tanhf(0.7978845608f * (g + 0.044715f * g * g * g))) * (A[TPB + pos] + A[3 * TPB + pos]);
        const float got = bf2f(((const bf16_t*)(F.ws + WS_YMIX))[row * DM + ch]); num += (got - ref) * (got - ref); den += ref * ref; }
    dbg_acc2(F, 3, num, den);
    __syncthreads();
}
__device__ __forceinline__ float dbg_convsilu(const Frame& F, int l, int b, int pos, int col, int cch) {
    const int seg_lo = pos < CTXL ? 0 : CTXL, seg_hi = pos < CTXL ? CTXL : TPB; float v = F.in[I_SCB][l * 768 + cch];
    for (int j = 0; j < 4; ++j) v += F.in[I_SCW][(l * 4 + j) * 768 + cch] * dbg_px(F, b, pos + j - 2, col, seg_lo, seg_hi);
    return v / (1.f + expf(-v)); }
__device__ void dbg_check_45(const Frame& F, int l) {
    LAS float* yp = (LAS float*)F.lds;
    const unsigned hs = hash_u(F.bx * 733u + 3u + l); const int b = hs & 7, h = (hs >> 3) & 3, p = (hs >> 5) & 63, g = h >> 1;
    if (F.tid < 256) { const int dir = F.tid >> 7, n = F.tid & 127; float st = 0.f;
        const float a = -expf(F.in[I_SALOG][l * 8 + dir * 4 + h]), bias = F.in[I_SDTB][l * 8 + dir * 4 + h];
        for (int s2 = 0; s2 < TPB; ++s2) { const int pos = dir ? (s2 < CTXL ? CTXL - 1 - s2 : TPB - 1 - (s2 - CTXL)) : s2;
            const float xs = dbg_convsilu(F, l, b, pos, C_XS + h * 64 + p, h * 64 + p), bn = dbg_convsilu(F, l, b, pos, C_BM + g * 128 + n, 256 + g * 128 + n), cn = dbg_convsilu(F, l, b, pos, C_CM + g * 128 + n, 512 + g * 128 + n);
            const float draw = ((const float*)(F.ws + WS_DTRAW))[(size_t)(b * TPB + pos) * 8 + dir * 4 + h] + bias; const float dt = draw > 20.f ? draw : log1pf(expf(draw));
            st = expf(dt * a) * st + bn * dt * xs; const float part = wave_sum(cn * st); if (F.lane == 0) yp[F.wid * TPB + pos] = part; } }
    __syncthreads();
    float num = 0.f, den = 0.f;
    for (int pos = F.tid; pos < TPB; pos += NTHR) { const size_t row = (size_t)b * TPB + pos; const float xs = dbg_convsilu(F, l, b, pos, C_XS + h * 64 + p, h * 64 + p);
        const float z = bf2f(((const bf16_t*)(F.ws + WS_PROJ))[row * NPROJ + C_SZ + h * 64 + p]);
        const float ref = (yp[pos] + yp[TPB + pos] + yp[2 * TPB + pos] + yp[3 * TPB + pos] + F.in[I_SD][l * 4 + h] * xs) * (z / (1.f + expf(-z)));
        const float got = ((const float*)(F.ws + WS_YPRE))[row * 256 + h * 64 + p]; num += (got - ref) * (got - ref); den += ref * ref; }
    dbg_acc2(F, 4, num, den);
    { const int row = hash_u((F.bx * 8 + F.wid) * 977u + 11u) % NROW; const float* yr = (const float*)(F.ws + WS_YPRE) + (size_t)row * 256; float v[4], ss = 0.f;
      for (int i = 0; i < 4; ++i) { v[i] = yr[F.lane + 64 * i]; ss += v[i] * v[i]; }
      ss = wave_sum(ss); const float rs = 1.f / sqrtf(ss / 256.f + EPSN); float n5 = 0.f, d5 = 0.f;
      for (int i = 0; i < 4; ++i) { const float ref = v[i] * rs * F.in[I_SNG][l * 256 + F.lane + 64 * i], got = bf2f(((const bf16_t*)(F.ws + WS_YMIX))[(size_t)row * DM + 256 + F.lane + 64 * i]); n5 += (got - ref) * (got - ref); d5 += ref * ref; }
      dbg_acc2(F, 5, n5, d5); }
    __syncthreads();
}
__device__ void dbg_check_6(const Frame& F, int l) {
    const int gt = F.bx * NTHR + F.tid; const unsigned hs = hash_u(gt * 2246822519u + 3u);
    const int row = hs % NROW, n = (hs >> 16) & 1023; float sacc = 0.f;
    for (int k = 0; k < 1024; ++k) sacc += bf2f(((const bf16_t*)(F.ws + WS_YMIX))[(size_t)row * DM + k]) * F.in[I_WOUT][((size_t)l * 1024 + k) * 1024 + n];
    const float ref = row_input(F, row)[n] + ((const float*)(F.ws + WS_MOD))[(size_t)(l * 9 + row_mrow(row)) * 6144 + 2 * 1024 + n] * sacc;
    dbg_acc2(F, 6, (((const float*)(F.ws + WS_XRES))[(size_t)row * DM + n] - ref) * (((const float*)(F.ws + WS_XRES))[(size_t)row * DM + n] - ref), ref * ref);
}
__device__ void dbg_check_78(const Frame& F, int l) {
    LAS float* hrow = (LAS float*)F.lds; LAS float* red = hrow + 1024; LAS float* lg = red + 16;
    const int row = hash_u(F.bx * 1597u + 29u) % NROW;
    const float* xr = (const float*)(F.ws + WS_XRES) + (size_t)row * DM;
    float ss = 0.f; for (int k = F.tid; k < 1024; k += NTHR) ss += xr[k] * xr[k];
    ss = wave_sum(ss); if (F.lane == 0) red[F.wid] = ss; __syncthreads();
    float tot = 0.f; for (int w = 0; w < 8; ++w) tot += red[w];
    const float rstd = 1.0f / sqrtf(tot / 1024.f + EPSN);
    const float* mod = (const float*)(F.ws + WS_MOD) + (size_t)(l * 9 + row_mrow(row)) * 6144;
    float num = 0.f, den = 0.f;
    for (int k = F.tid; k < 1024; k += NTHR) { const float h = xr[k] * rstd * F.in[I_N2G][l * 1024 + k] * (1.f + mod[4 * 1024 + k]) + mod[3 * 1024 + k]; hrow[k] = h;
        const float got = bf2f(((const bf16_t*)(F.ws + WS_H))[(size_t)row * DM + k]); num += (got - h) * (got - h); den += h * h; }
    __syncthreads();
    if (F.tid < 32) { float a = F.in[I_RB][l * 32 + F.tid]; for (int k = 0; k < 1024; ++k) a += hrow[k] * F.in[I_RW][((size_t)l * 1024 + k) * 32 + F.tid]; lg[F.tid] = a; }
    __syncthreads();
    if (F.tid == 0) { LAS float* sv = lg + 32; LAS int* se = (LAS int*)(lg + 40); unsigned used = 0u;
        for (int r = 0; r < 4; ++r) { float m = -1e30f; int bi = 0; for (int j = 0; j < 32; ++j) if (!((used >> j) & 1u) && lg[j] > m) { m = lg[j]; bi = j; } used |= 1u << bi; sv[r] = m; se[r] = bi; }
        float sm = 0.f; for (int r = 0; r < 4; ++r) sm += expf(sv[r] - sv[0]);
        float n8 = 0.f;
        for (int r = 0; r < 4; ++r) { const float ref = expf(sv[r] - sv[0]) / sm, got = ((const float*)(F.ws + WS_TOKG))[(size_t)row * 4 + r]; num += (got - ref) * (got - ref); den += ref * ref;
            n8 += (((const int*)(F.ws + WS_TOKE))[(size_t)row * 4 + r] != se[r]) ? 1.f : 0.f; }
        float* d = (float*)(F.ws + WS_DBG); atomicAdd(d + 16, n8); atomicAdd(d + 17, 4.f * 1000.f); }
    dbg_acc2(F, 7, num, den);
    __syncthreads();
}
__device__ void dbg_check_9(const Frame& F, int l) {
    LAS float* hrow = (LAS float*)F.lds; LAS float* act = hrow + 1024;
    const unsigned hs = hash_u(F.bx * 2971u + 41u); int row = hs % NROW; if (l == 1 && (row % TPB) < CTXL) row += CTXL; const int r = (hs >> 20) & 3, slot = row * 4 + r;
    const int e = ((const int*)(F.ws + WS_TOKE))[slot]; const float gate = ((const float*)(F.ws + WS_TOKG))[slot];
    for (int k = F.tid; k < 1024; k += NTHR) hrow[k] = bf2f(((const bf16_t*)(F.ws + WS_H))[(size_t)row * DM + k]);
    __syncthreads();
    const float* wgu = F.in[I_WGU] + ((size_t)l * 32 + e) * 1024 * 2048; const float* bgu = F.in[I_BGU] + ((size_t)l * 32 + e) * 2048;
    for (int j = F.tid; j < 1024; j += NTHR) { float g = bgu[2 * j], u = bgu[2 * j + 1];
        for (int k = 0; k < 1024; ++k) { const f32x2 w = *(const f32x2*)(wgu + (size_t)k * 2048 + 2 * j); g += hrow[k] * w.x; u += hrow[k] * w.y; }
        g = fminf(g, 7.f); u = fminf(fmaxf(u, -7.f), 7.f); act[j] = (u + 1.f) * g / (1.f + expf(-1.702f * g)); }
    __syncthreads();
    const float* wd = F.in[I_WD] + ((size_t)l * 32 + e) * 1024 * 1024; float num = 0.f, den = 0.f;
    for (int n = F.tid; n < 1024; n += NTHR) { float y = F.in[I_BD][((size_t)l * 32 + e) * 1024 + n]; for (int j = 0; j < 1024; ++j) y += act[j] * wd[(size_t)j * 1024 + n];
        y *= gate; const float got = bf2f(((const bf16_t*)(F.ws + WS_YSLOT))[(size_t)slot * DM + n]); num += (got - y) * (got - y); den += y * y; }
    dbg_acc2(F, 9, num, den);
    __syncthreads();
}
__device__ void dbg_report(const Frame& F, int nchk) {
    const float* d = (const float*)(F.ws + WS_DBG);
    int bad = -1; float rel = 0.f;
    for (int i = 0; i < nchk; ++i) { const float n = d[2 * i], q = d[2 * i + 1]; float r = (q > 0.f) ? sqrtf(n / q) : 1e9f; if (!(r == r)) r = 1e9f; if (r > 0.03f) { bad = i; rel = r; break; } }
    float V = 0.f;
    if (bad >= 0) { float m = 5.f + log10f(rel); m = m < 1.f ? 1.f : (m > 9.9f ? 9.9f : m); V = m * powf(10.f, (float)(3 + bad)); }
    else return;
    for (size_t i = (size_t)F.bx * NTHR + F.tid; i < (size_t)NBATCH * SEQ * DM; i += (size_t)F.G * NTHR) F.out[i] = V;
}
#endif

#if MK_DBG
__global__ void __launch_bounds__(NTHR) hymba_dbg(Args args) {
    extern __shared__ __attribute__((aligned(16))) unsigned char lds_raw[];
    Frame F; F.in = args.in; F.in0 = args.in; F.out = args.out; F.ws = args.ws; F.ws0 = args.ws; F.lds = (LAS unsigned char*)lds_raw;
    F.tid = threadIdx.x; F.lane = F.tid & 63; F.wid = __builtin_amdgcn_readfirstlane(F.tid >> 6); F.G = gridDim.x; F.bx = blockIdx.x;
    const int lo = args.lo, hi = args.hi;
    if (lo == 1001) dbg_check_01(F, hi);
    if (lo == 1002) dbg_check_2(F, hi);
    if (lo == 1003) dbg_check_3(F, hi);
    if (lo == 1004) dbg_check_45(F, hi);
    if (lo == 1006) dbg_check_6(F, hi);
    if (lo == 1007) dbg_check_78(F, hi);
    if (lo == 1009) dbg_check_9(F, hi);
    if (lo == 1099) dbg_report(F, hi);
}
#endif

__global__ void __launch_bounds__(NTHR, 2) hymba_fwd(Args args) {
    extern __shared__ __attribute__((aligned(16))) unsigned char lds_raw[];
    Frame F; F.in = args.in; F.in0 = args.in; F.out = args.out; F.ws = args.ws; F.ws0 = args.ws; F.lds = (LAS unsigned char*)lds_raw;
    F.tid = threadIdx.x; F.lane = F.tid & 63; F.wid = __builtin_amdgcn_readfirstlane(F.tid >> 6); F.wave_s = F.wid; F.G = gridDim.x; F.bx = blockIdx.x;
    const int lo = args.lo, hi = args.hi;
#define IN(k) (lo <= (k) && (k) < hi)
#define BOTH(k) (IN(k) && IN((k) + 1))
#if MK_ONE_LAUNCH
    volatile LAS unsigned* misc = (volatile LAS unsigned*)(F.lds + LDS_MISC);
    if (F.tid < 4) misc[F.tid] = 0u;
    __syncthreads();
    XcdBarrier bar = xcd_barrier_post((unsigned*)(F.ws + WS_BAR), misc, F.wave_s);
#define GRID_BAR() xcd_barrier(bar)
#else
#define GRID_BAR() do {} while (0)
#endif
#if MK_PA >= 0
#define STAMP(k) do { if (blockIdx.x == 0 && xb_thread0(F.wave_s)) { unsigned long long z_; asm volatile("s_mov_b64 %0, 0" : "=s"(z_)); ((unsigned*)(args.ws + WS_DBG + z_))[8 + (k)] = (unsigned)__builtin_amdgcn_s_memrealtime(); } } while (0)
#else
#define STAMP(k) do {} while (0)
#endif
    STAMP(-1);
    F.gx = F.bx & 7; F.gj = F.bx >> 3; F.gn = F.G >> 3;
    if (IN(0)) { F.refresh(); p0_prologue(F); if (MK_DUP == 100) { GRID_BAR(); F.refresh(); p0_prologue(F); } if (BOTH(0)) GRID_BAR(); STAMP(0); }
#if MK_ONE_LAUNCH
    if (lo == 0 && hi > 1) {
        const unsigned nloc = misc[0], rank = misc[2];
        unsigned tot = 0u, minc = 0xffffffffu; bool all8 = true;
#pragma unroll
        for (int j = 0; j < 8; ++j) { const unsigned cj = xb_ld(&bar.bar[XB_XCNT(j)]); tot += cj; all8 = all8 && (cj > 0u); minc = cj < minc ? cj : minc; }
        if (all8 && tot == (unsigned)F.G && minc >= 16u) { F.gx = (int)bar.x; F.gj = __builtin_amdgcn_readfirstlane((int)rank); F.gn = __builtin_amdgcn_readfirstlane((int)nloc); }
    }
#endif
    for (int l = 0; l < 2; ++l) {
        const int pb = 1 + 10 * l;
        if (IN(pb + 0)) { F.refresh(); p_norm1(F, l); if (MK_DUP == 0 && l == 0) { GRID_BAR(); F.refresh(); p_norm1(F, l); } if (BOTH(pb + 0)) GRID_BAR(); STAMP(pb + 0); }
#if MK_DUP == 11
        { F.refresh(); p_inproj_null(F, l); GRID_BAR(); }
#endif
        if (IN(pb + 1)) { F.refresh(); p_inproj(F, l); if (MK_DUP == 1) { GRID_BAR(); F.refresh(); p_inproj(F, l); } if (BOTH(pb + 1)) GRID_BAR(); STAMP(pb + 1); }
        if (IN(pb + 2)) { F.refresh(); p_conv(F, l); if (MK_DUP == 2) { GRID_BAR(); F.refresh(); p_conv(F, l); } if (BOTH(pb + 2)) GRID_BAR(); STAMP(pb + 2); }
        if (IN(pb + 3)) { F.refresh(); p_post(F, l); if (MK_DUP == 3) { GRID_BAR(); F.refresh(); p_post(F, l); } if (BOTH(pb + 3)) GRID_BAR(); STAMP(pb + 3); }
        if (IN(pb + 4)) { F.refresh(); p_attn(F, l); if (MK_DUP == 4) { GRID_BAR(); F.refresh(); p_attn(F, l); } if (BOTH(pb + 4)) GRID_BAR(); STAMP(pb + 4); }
        if (IN(pb + 5)) { F.refresh(); p_mix2(F, l); if (MK_DUP == 5) { GRID_BAR(); F.refresh(); p_mix2(F, l); } if (BOTH(pb + 5)) GRID_BAR(); STAMP(pb + 5); }
        if (IN(pb + 6)) { if (MK_DUP == 6) { F.refresh(); p_outproj(F, l, true); GRID_BAR(); } F.refresh(); p_outproj(F, l); if (BOTH(pb + 6)) GRID_BAR(); STAMP(pb + 6); }
        if (IN(pb + 7)) { if (MK_DUP == 7) { F.refresh(); p_norm2(F, l, true); GRID_BAR(); } F.refresh(); p_norm2(F, l); if (BOTH(pb + 7)) GRID_BAR(); STAMP(pb + 7); }
        if (IN(pb + 8)) { F.refresh(); p_moe_gu(F, l); if (MK_DUP == 8) { GRID_BAR(); F.refresh(); p_moe_gu(F, l); } if (BOTH(pb + 8)) GRID_BAR(); STAMP(pb + 8); }
        if (IN(pb + 9)) { F.refresh(); p_moe_down(F, l); if (MK_DUP == 9) { GRID_BAR(); F.refresh(); p_moe_down(F, l); } if (BOTH(pb + 9)) GRID_BAR(); STAMP(pb + 9); }
    }
    if (IN(21)) { F.refresh(); p_final(F); }
#if MK_PA >= 0
    {
        GRID_BAR();
        const unsigned* st = (const unsigned*)(args.ws + WS_DBG) + 8;
        const float va = (float)(__hip_atomic_load(st + MK_PA, __ATOMIC_RELAXED, __HIP_MEMORY_SCOPE_AGENT) - __hip_atomic_load(st + MK_PA - 1, __ATOMIC_RELAXED, __HIP_MEMORY_SCOPE_AGENT)) * 30.f;
        const float vb = (float)(__hip_atomic_load(st + MK_PB, __ATOMIC_RELAXED, __HIP_MEMORY_SCOPE_AGENT) - __hip_atomic_load(st + MK_PB - 1, __ATOMIC_RELAXED, __HIP_MEMORY_SCOPE_AGENT)) * 1.f;
        for (size_t i = (size_t)blockIdx.x * NTHR + threadIdx.x; i < (size_t)NBATCH * SEQ * DM; i += (size_t)gridDim.x * NTHR) args.out[i] = (i == 0) ? va : vb;
    }
#endif
#undef IN
#undef BOTH
}

extern "C" void kernel_launch(void* const* d_in, const int* in_sizes, int n_in, void* d_out, int out_size, void* d_ws, size_t ws_size, hipStream_t stream) {
    static int grid = 0;
    if (grid == 0) {
        if (n_in != N_IN || out_size != NBATCH * SEQ * DM || ws_size < WS_END) { fprintf(stderr, "kernel_launch: unexpected shapes (n_in %d, out %d, ws %zu < %zu)\n", n_in, out_size, ws_size, (size_t)WS_END); grid = -1; return; }
        int dev = 0, cus = 0;
        if (hipGetDevice(&dev) != hipSuccess || hipDeviceGetAttribute(&cus, hipDeviceAttributeMultiprocessorCount, dev) != hipSuccess) { grid = -1; return; }
        if (hipFuncSetAttribute((const void*)hymba_fwd, hipFuncAttributeMaxDynamicSharedMemorySize, LDS_BYTES) != hipSuccess) { fprintf(stderr, "kernel_launch: hipFuncSetAttribute failed\n"); grid = -1; return; }
#if MK_DBG
        (void)hipFuncSetAttribute((const void*)hymba_dbg, hipFuncAttributeMaxDynamicSharedMemorySize, LDS_BYTES);
#endif
        int per_cu = 0;
        if (hipOccupancyMaxActiveBlocksPerMultiprocessor(&per_cu, (const void*)hymba_fwd, NTHR, LDS_BYTES) != hipSuccess || per_cu < 1) fprintf(stderr, "kernel_launch: occupancy query says %d\n", per_cu);
        (void)hipGetLastError();
        grid = (cus / 8) * 8;
        if (grid < 8) grid = 8;
    }
    if (grid < 0) return;
    (void)hipMemsetAsync(d_ws, 0, WS_ZERO_END, stream);
    Args a{};
    for (int i = 0; i < N_IN; ++i) a.in[i] = (const float*)d_in[i];
    a.out = (float*)d_out; a.ws = (unsigned char*)d_ws;
    auto launch = [&](int lo, int hi) { a.lo = lo; a.hi = hi;
#if MK_DBG
        if (lo >= 1000) { hipLaunchKernelGGL(hymba_dbg, dim3(grid), dim3(NTHR), LDS_BYTES, stream, a); return; }
#endif
        hipLaunchKernelGGL(hymba_fwd, dim3(grid), dim3(NTHR), LDS_BYTES, stream, a); };
#if MK_ONE_LAUNCH
    launch(0, 22);
#else
    const int last = MK_LAST_PHASE;
    for (int p = 0; p <= last; ++p) {
        launch(p, p + 1);
#if MK_DBG
        if (p == 2) launch(1001, 0);
        if (p == 5) launch(1002, 0);
        if (p == 6) { launch(1003, 0); launch(1004, 0); }
        if (p == 7) launch(1006, 0);
        if (p == 8) launch(1007, 0);
        if (p == 10) launch(1009, 0);
#endif
    }
#if MK_DBG
    launch(1099, 10);
#endif
#endif
}
```

```cpp
#include <hip/hip_runtime.h>
#include <stdint.h>
#include <stdio.h>

#ifndef MK_ONE_LAUNCH
#define MK_ONE_LAUNCH 1
#endif
#ifndef MK_DBG
#define MK_DBG 0
#endif
#ifndef MK_PA
#define MK_PA -1
#endif
#ifndef MK_PB
#define MK_PB -1
#endif
#ifndef MK_DUP
#define MK_DUP -1
#endif
#ifndef MK_SLACK
#define MK_SLACK 1
#endif
#ifndef MK_LAST_PHASE
#define MK_LAST_PHASE 21
#endif

#define LAS __attribute__((address_space(3)))
typedef unsigned short bf16_t;
typedef short bf16x8 __attribute__((ext_vector_type(8)));
typedef float f32x4 __attribute__((ext_vector_type(4)));
typedef float f32x2 __attribute__((ext_vector_type(2)));
typedef float f32x16 __attribute__((ext_vector_type(16)));
typedef unsigned u32x4 __attribute__((ext_vector_type(4)));
typedef unsigned u32x2 __attribute__((ext_vector_type(2)));

constexpr int DM = 1024, NBATCH = 8, SEQ = 4096, CTXL = 256, TPB = SEQ + CTXL, NROW = NBATCH * TPB;
constexpr int NPROJ = 3072;
constexpr int C_LG = 0, C_LX = 256, C_SZ = 512, C_XS = 768, C_BM = 1024, C_CM = 1280, C_Q = 1536, C_K = 2048, C_V = 2560;
constexpr int NEXP = 32, DEXP = 1024;
constexpr float EPSN = 1e-6f;
constexpr int LDS_BYTES = 160 * 1024, LDS_MISC = LDS_BYTES - 256;
constexpr int NTHR = 512;

enum { I_X = 0, I_C, I_CTX, I_CCTX, I_WMOD, I_BMOD, I_N1G, I_N2G, I_WIN, I_WOUT, I_LCW, I_LCB, I_LWA, I_LBA, I_LWX, I_LBX, I_LLAM,
       I_SCW, I_SCB, I_SALOG, I_SDTB, I_SD, I_SNG, I_QN, I_KN, I_LAMQ, I_LAMK, I_SUBG, I_RW, I_RB, I_WGU, I_BGU, I_WD, I_BD, N_IN };

constexpr size_t al256(size_t x) { return (x + 255) & ~(size_t)255; }
constexpr size_t WS_BAR = 0;
constexpr size_t WS_DBG = 16384;
constexpr size_t WS_CNT = WS_DBG + 4096;
constexpr size_t WS_ZERO_END = WS_CNT + 1024;
constexpr size_t WS_MOD = al256(WS_ZERO_END);
constexpr size_t WS_WDT = WS_MOD + al256((size_t)2 * 9 * 6144 * 4);
constexpr size_t WS_WIN = WS_WDT + al256((size_t)2 * 8 * 1024 * 4);
constexpr size_t WS_WOUT = WS_WIN + (size_t)2 * NPROJ * 1024 * 2;
constexpr size_t WS_WGU = WS_WOUT + (size_t)2 * 1024 * 1024 * 2;
constexpr size_t WS_WD = WS_WGU + (size_t)2 * 32 * 2048 * 1024 * 2;
constexpr size_t WS_XRES = WS_WD + (size_t)2 * 32 * 1024 * 1024 * 2;
constexpr size_t WS_H = WS_XRES + (size_t)NROW * 1024 * 4;
constexpr size_t WS_DTRAW = WS_H + (size_t)NROW * 1024 * 2;
constexpr size_t WS_PROJ = WS_DTRAW + al256((size_t)NROW * 8 * 4);
constexpr size_t WS_QB = WS_PROJ + (size_t)NROW * NPROJ * 2;
constexpr size_t WS_KB = WS_QB + (size_t)NROW * 512 * 2;
constexpr size_t WS_VT = WS_KB + (size_t)NROW * 512 * 2;
constexpr size_t WS_ACT = WS_PROJ;
constexpr size_t WS_YMIX = WS_VT + (size_t)NROW * 512 * 2;
constexpr size_t WS_LRUS = WS_YMIX + (size_t)NROW * 1024 * 2;
constexpr size_t WS_LRUC = WS_LRUS + (size_t)8 * 136 * 2 * 256 * 8;
constexpr size_t WS_SSDS = WS_LRUC + (size_t)8 * 136 * 2 * 256 * 4;
constexpr size_t WS_SSDI = WS_SSDS + (size_t)8 * 34 * 8 * 8192 * 4;
constexpr size_t WS_SSDD = WS_SSDI + (size_t)8 * 34 * 8 * 8192 * 2;
constexpr size_t WS_TOKG = WS_SSDD + al256((size_t)8 * 34 * 8 * 4);
constexpr size_t WS_TOKE = WS_TOKG + (size_t)NROW * 4 * 4;
constexpr size_t WS_LIST = WS_TOKE + (size_t)NROW * 4 * 4;
constexpr size_t WS_LISTG = WS_LIST + (size_t)NEXP * NROW * 4;
constexpr size_t WS_YSLOT = WS_LISTG + (size_t)NEXP * NROW * 4;
constexpr size_t WS_YPRE = WS_YSLOT + (size_t)NROW * 4 * 1024 * 2;
constexpr size_t WS_CONV = WS_YPRE + (size_t)NROW * 256 * 4;
constexpr size_t WS_XBT = WS_CONV + (size_t)NROW * 1024 * 2;
constexpr size_t WS_END = WS_XBT + (size_t)8 * 34 * 512 * 136 * 2;
static_assert((size_t)576 * 256 * 1024 * 2 <= WS_YMIX - WS_PROJ, "act alias");
static_assert(WS_END < (size_t)2000 * 1024 * 1024, "workspace");

struct Args { const float* in[N_IN]; float* out; unsigned char* ws; int lo, hi; };

#define XB_TMO      128
#define XB_XCNT(j)  (256  + 64 * (j))
#define XB_XSUB(j)  (1280 + 64 * (j))
#define XB_XGEN(j)  (2304 + 64 * (j))
#define XB_TOP      3328
#define XB_TOPGEN   3392
#define XCD_BAR_WORDS 3456
#define XB_SPIN_CAP (1u << 18)
__device__ __forceinline__ unsigned xb_ld(unsigned* p)              { return __hip_atomic_load(p, __ATOMIC_RELAXED, __HIP_MEMORY_SCOPE_AGENT); }
__device__ __forceinline__ unsigned xb_add(unsigned* p, unsigned v) { return __hip_atomic_fetch_add(p, v, __ATOMIC_RELAXED, __HIP_MEMORY_SCOPE_AGENT); }
__device__ __forceinline__ unsigned xb_xcc_id() { return (unsigned)__builtin_amdgcn_s_getreg((3 << 11) | 20) & 0xFu; }
#define XB_SPIN(cond, bar) do { unsigned _sp = 0; while (cond) { __builtin_amdgcn_s_sleep(1); \
    if ((++_sp & 255u) == 0u) { if (xb_ld(&(bar)[XB_TMO])) break; if (_sp > XB_SPIN_CAP) { atomicAdd(&(bar)[XB_TMO], 1u); break; } } } } while (0)
struct XcdBarrier { unsigned* bar; unsigned x; volatile LAS unsigned* st; int wave_s; };
__device__ __forceinline__ bool xb_thread0(int wave_s) { int l; asm volatile("v_mbcnt_lo_u32_b32 %0, -1, 0\n\tv_mbcnt_hi_u32_b32 %0, -1, %0" : "=v"(l)); return wave_s == 0 && l == 0; }
__device__ __forceinline__ XcdBarrier xcd_barrier_post(unsigned* bar, volatile LAS unsigned* st, int wave_s) {
    XcdBarrier b; b.bar = bar; b.x = xb_xcc_id(); b.st = st; b.wave_s = wave_s;
    if (xb_thread0(wave_s)) st[2] = xb_add(&bar[XB_XCNT(b.x)], 1u);
    return b;
}
__device__ __forceinline__ void xcd_barrier_complete(unsigned* bar, unsigned x, unsigned& nloc, unsigned& nx) {
    const unsigned G = gridDim.x * gridDim.y * gridDim.z;
    unsigned sum, cnt, mine, sp = 0u;
    for (;;) {
        sum = 0u; cnt = 0u; mine = 0u;
#pragma unroll
        for (unsigned j = 0; j < 16; ++j) { const unsigned c = xb_ld(&bar[XB_XCNT(j)]); sum += c; cnt += (c > 0u) ? 1u : 0u; mine = (j == x) ? c : mine; }
        if (sum == G) break;
        __builtin_amdgcn_s_sleep(1);
        if ((++sp & 255u) == 0u) { if (xb_ld(&bar[XB_TMO])) break; if (sp > XB_SPIN_CAP) { atomicAdd(&bar[XB_TMO], 1u); break; } }
    }
    nloc = mine > 0u ? mine : 1u; nx = cnt > 0u ? cnt : 1u;
}
__device__ __forceinline__ void xcd_barrier(const XcdBarrier& b) {
    asm volatile("s_waitcnt vmcnt(0)" ::: "memory");
    __syncthreads();
    if (xb_thread0(b.wave_s)) {
        unsigned* bar = b.bar;
        __builtin_amdgcn_s_waitcnt(0);
        unsigned nloc = b.st[0], nx = b.st[1];
        if (nloc == 0u) { xcd_barrier_complete(bar, b.x, nloc, nx); b.st[0] = nloc; b.st[1] = nx; }
        const unsigned old = xb_add(&bar[XB_XSUB(b.x)], 1u);
        const unsigned gen = old / nloc;
        if (old + 1u == (gen + 1u) * nloc) {
            __builtin_amdgcn_fence(__ATOMIC_RELEASE, "agent");
            asm volatile("s_waitcnt vmcnt(0)" ::: "memory");
            const unsigned og = xb_add(&bar[XB_TOP], 1u);
            const unsigned tg = og / nx;
            if (og + 1u == (tg + 1u) * nx) xb_add(&bar[XB_TOPGEN], 1u);
            else XB_SPIN(xb_ld(&bar[XB_TOPGEN]) == tg, bar);
            __builtin_amdgcn_fence(__ATOMIC_ACQUIRE, "agent");
            xb_add(&bar[XB_XGEN(b.x)], 1u);
            asm volatile("s_waitcnt vmcnt(0)" ::: "memory");
        } else {
            XB_SPIN(xb_ld(&bar[XB_XGEN(b.x)]) == gen, bar);
            __builtin_amdgcn_fence(__ATOMIC_ACQUIRE, "agent");
            asm volatile("s_waitcnt vmcnt(0)" ::: "memory");
        }
    }
    __syncthreads();
}

__device__ __forceinline__ unsigned cvt_pk_bf16(float lo, float hi) { unsigned r; asm("v_cvt_pk_bf16_f32 %0, %1, %2" : "=v"(r) : "v"(lo), "v"(hi)); return r; }
__device__ __forceinline__ bf16_t f2bf(float f) { return (bf16_t)(cvt_pk_bf16(f, 0.f) & 0xffffu); }
__device__ __forceinline__ float bf2f(bf16_t b) { return __uint_as_float(((unsigned)b) << 16); }
__device__ __forceinline__ float bflo(unsigned w) { return __uint_as_float(w << 16); }
__device__ __forceinline__ float bfhi(unsigned w) { return __uint_as_float(w & 0xffff0000u); }
__device__ __forceinline__ float wave_sum(float v) {
#pragma unroll
    for (int o = 32; o >= 1; o >>= 1) v += __shfl_xor(v, o);
    return v;
}
__device__ __forceinline__ float shfl_x(float v, int lane, int o) { return __uint_as_float((unsigned)__builtin_amdgcn_ds_bpermute((lane ^ o) << 2, (int)__float_as_uint(v))); }
template <int CTRL> __device__ __forceinline__ float dppf(float v) { return __uint_as_float((unsigned)__builtin_amdgcn_update_dpp(0, (int)__float_as_uint(v), CTRL, 0xf, 0xf, true)); }
struct OpAdd { static __device__ __forceinline__ float f(float a, float b) { return a + b; } };
struct OpMax { static __device__ __forceinline__ float f(float a, float b) { return fmaxf(a, b); } };
template <class Op> __device__ __forceinline__ float row16_red(float v) { v = Op::f(v, dppf<0xB1>(v)); v = Op::f(v, dppf<0x4E>(v)); v = Op::f(v, dppf<0x124>(v)); v = Op::f(v, dppf<0x128>(v)); return v; }
template <class Op> __device__ __forceinline__ float x16_red(float v) { const auto r = __builtin_amdgcn_permlane16_swap(__float_as_uint(v), __float_as_uint(v), false, false); return Op::f(__uint_as_float(r[0]), __uint_as_float(r[1])); }
template <class Op> __device__ __forceinline__ float x32_red(float v) { const auto r = __builtin_amdgcn_permlane32_swap(__float_as_uint(v), __float_as_uint(v), false, false); return Op::f(__uint_as_float(r[0]), __uint_as_float(r[1])); }
template <class Op> __device__ __forceinline__ float half32_red(float v) { return x16_red<Op>(row16_red<Op>(v)); }
template <class Op> __device__ __forceinline__ float wave64_red(float v) { return x32_red<Op>(half32_red<Op>(v)); }
__device__ __forceinline__ float wave_sum_l(float v, int) { return wave64_red<OpAdd>(v); }
__device__ __forceinline__ float sigmoidf_(float x) { return __builtin_amdgcn_rcpf(1.0f + __expf(-x)); }
__device__ __forceinline__ float siluf_(float x) { return x * __builtin_amdgcn_rcpf(1.0f + __expf(-x)); }
__device__ __forceinline__ float log1p_fast(float t) { return t < 0.01f ? t * (1.0f + t * (-0.5f + t * (1.0f / 3.0f))) : __logf(1.0f + t); }
__device__ __forceinline__ float softplusf_(float x) { return fmaxf(x, 0.f) + log1p_fast(__expf(-fabsf(x))); }
__device__ __forceinline__ float one_minus_exp(float x) { const float p = -x * (1.0f + x * (0.5f + x * (1.0f / 6.0f + x * (1.0f / 24.0f)))), e = 1.0f - __expf(x); return x > -0.05f ? p : e; }
__device__ __forceinline__ float tanh_fast(float x) { const float e = __expf(2.0f * fminf(x, 15.f)); return 1.0f - 2.0f * __builtin_amdgcn_rcpf(e + 1.0f); }

__device__ __forceinline__ void glds16_s(unsigned voff, const void* sbase, unsigned lds_addr) {
    unsigned sv;
    asm volatile("s_mov_b32 %0, m0\n\ts_mov_b32 m0, %3\n\ts_nop 0\n\tglobal_load_lds_dwordx4 %1, %2\n\ts_mov_b32 m0, %0"
                 : "=&s"(sv) : "v"(voff), "s"(sbase), "s"(lds_addr) : "memory");
}
__device__ __forceinline__ void glds4_v(const void* vaddr, unsigned lds_addr) {
    unsigned sv;
    asm volatile("s_mov_b32 %0, m0\n\ts_mov_b32 m0, %2\n\ts_nop 0\n\tglobal_load_lds_dword %1, off\n\ts_mov_b32 m0, %0"
                 : "=&s"(sv) : "v"(vaddr), "s"(lds_addr) : "memory");
}
__device__ __forceinline__ void st_wt(void* p, u32x2 v) { asm volatile("global_store_dwordx2 %0, %1, off sc1" :: "v"(p), "v"(v) : "memory"); }
__device__ __forceinline__ void st_wt(void* p, u32x4 v) { asm volatile("global_store_dwordx4 %0, %1, off sc1\n\ts_nop 1" :: "v"(p), "v"(v) : "memory"); }
__device__ __forceinline__ int tid_fresh(int wave_s) { int l; asm volatile("v_mbcnt_lo_u32_b32 %0, -1, 0\n\tv_mbcnt_hi_u32_b32 %0, -1, %0" : "=v"(l)); return wave_s * 64 + l; }
__device__ __forceinline__ float shfl_xor_l(float v, int lane, int o) { return __uint_as_float((unsigned)__builtin_amdgcn_ds_bpermute((lane ^ o) << 2, (int)__float_as_uint(v))); }
struct Frame {
    const float* const* in; float* out; unsigned char* ws; LAS unsigned char* lds;
    int tid, lane, wid, G, bx, wave_s;
    int gx, gj, gn;
    const float* const* in0; unsigned char* ws0;
    __device__ __forceinline__ void refresh() { const int t = tid_fresh(wave_s); tid = t; lane = t & 63; wid = wave_s;
        unsigned long long z; asm volatile("s_mov_b64 %0, 0" : "=s"(z)); in = (const float* const*)((const char*)in0 + z); ws = ws0 + z; }
};
__device__ __forceinline__ int row_mrow(int r) { const int b = r / TPB, pos = r - b * TPB; return pos < CTXL ? 8 : b; }
__device__ __forceinline__ const float* row_input(const Frame& F, int r) {
    const int b = r / TPB, pos = r - b * TPB;
    return pos < CTXL ? F.in[I_CTX] + ((size_t)b * CTXL + pos) * DM : F.in[I_X] + ((size_t)b * SEQ + (pos - CTXL)) * DM;
}

__device__ __forceinline__ void cvt_block(const Frame& F, const float* src, int ld, int k0, int c0, bf16_t* dst, int mode, int d0) {
    LAS float* tile = (LAS float*)F.lds;
    const int tid = F.tid;
#pragma unroll
    for (int i = 0; i < 4; ++i) {
        const int r = (tid >> 5) + 16 * i, c4 = (tid & 31) * 4;
        const f32x4 v = *(const f32x4*)(src + (size_t)(k0 + r) * ld + c0 + c4);
        *(LAS f32x4*)(tile + r * 132 + c4) = v;
    }
    __syncthreads();
    const int nl = tid >> 2, kq = tid & 3;
    int csrc, rho;
    if (mode == 1) { const int half = nl >> 6, jj = nl & 63, a0 = c0 >> 1; csrc = 2 * jj + half; rho = (a0 >> 7) * 256 + half * 128 + (a0 & 127) + jj; }
    else { csrc = nl; rho = d0 + nl; }
    unsigned w[8];
#pragma unroll
    for (int j = 0; j < 8; ++j) w[j] = cvt_pk_bf16(tile[(kq * 16 + 2 * j) * 132 + csrc], tile[(kq * 16 + 2 * j + 1) * 132 + csrc]);
    bf16_t* dp = dst + (size_t)rho * 1024 + k0 + kq * 16;
    *(u32x4*)dp = (u32x4){w[0], w[1], w[2], w[3]};
    *(u32x4*)(dp + 8) = (u32x4){w[4], w[5], w[6], w[7]};
    __syncthreads();
}
__device__ __forceinline__ void mod_unit(const Frame& F, int l, int jb) {
    LAS float* sm = (LAS float*)F.lds;
    LAS float* red = sm + 9 * 1024;
    const int tid = F.tid;
    { float v[18];
#pragma unroll
      for (int j = 0; j < 18; ++j) { const int idx = tid + NTHR * j, r = idx >> 10, k = idx & 1023; v[j] = r < 8 ? F.in[I_C][r * 1024 + k] : F.in[I_CCTX][k]; }
#pragma unroll
      for (int j = 0; j < 18; ++j) sm[tid + NTHR * j] = siluf_(v[j]); }
    __syncthreads();
    const int kg = tid >> 6, jj = tid & 63, j = jb * 64 + jj;
    float acc[9];
#pragma unroll
    for (int r = 0; r < 9; ++r) acc[r] = 0.f;
    const float* wp = F.in[I_WMOD] + (size_t)l * 1024 * 6144 + j;
#pragma unroll 8
    for (int k = kg * 128; k < kg * 128 + 128; ++k) {
        const float w = wp[(size_t)k * 6144];
#pragma unroll
        for (int r = 0; r < 9; ++r) acc[r] += sm[r * 1024 + k] * w;
    }
#pragma unroll
    for (int r = 0; r < 9; ++r) red[(kg * 9 + r) * 64 + jj] = acc[r];
    __syncthreads();
    float* mod = (float*)(F.ws + WS_MOD);
    for (int idx = tid; idx < 576; idx += NTHR) {
        const int r = idx >> 6, j2 = idx & 63; float s = 0.f;
#pragma unroll
        for (int g = 0; g < 8; ++g) s += red[(g * 9 + r) * 64 + j2];
        mod[(size_t)(l * 9 + r) * 6144 + jb * 64 + j2] = s + F.in[I_BMOD][l * 6144 + jb * 64 + j2];
    }
    __syncthreads();
}
constexpr int CVB_L = 8192 + 4096;
constexpr int SLK_IN = 2, SLK_OUT0 = 9;
constexpr int SLK_A = 8 * SLK_IN * 72, SLK_B = 8 * SLK_OUT0 * 28;
__device__ __forceinline__ void cvt_moe_blk(const Frame& F, int m) {
    const int l = m / CVB_L; int r = m - l * CVB_L;
    if (r < 8192) { const int e = r >> 8, rr = r & 255, tk = rr >> 4, tn = rr & 15;
        cvt_block(F, F.in[I_WGU] + ((size_t)l * 32 + e) * 1024 * 2048, 2048, tk * 64, tn * 128, (bf16_t*)(F.ws + WS_WGU) + ((size_t)l * 32 + e) * 2048 * 1024, 1, 0); }
    else { r -= 8192; const int e = r >> 7, rr = r & 127, tk = rr >> 3, tn = rr & 7;
        cvt_block(F, F.in[I_WD] + ((size_t)l * 32 + e) * 1024 * 1024, 1024, tk * 64, tn * 128, (bf16_t*)(F.ws + WS_WD) + ((size_t)l * 32 + e) * 1024 * 1024, 0, tn * 128); }
}
__device__ __forceinline__ bool slack_on(const Frame& F) { return MK_SLACK && F.G == 256; }
__device__ __forceinline__ void cvt_slack(const Frame& F, int first, int count, int sidx, int nsl) { for (int m = first + sidx; m < first + count; m += nsl) cvt_moe_blk(F, m); }
__device__ __forceinline__ void p0_prologue(const Frame& F) {
    { float* wdt = (float*)(F.ws + WS_WDT);
      for (int i = F.bx * NTHR + F.tid; i < 2 * 8 * 1024; i += F.G * NTHR) { const int l = i >> 13, j = (i >> 10) & 7, k = i & 1023; wdt[i] = F.in[I_WIN][((size_t)l * 1024 + k) * 3080 + 1536 + j]; } }
    constexpr int NMOD = 192, PER_L = 384 + 128 + 8192 + 4096;
    for (int u = F.bx; u < NMOD + 2 * PER_L; u += F.G) {
        if (u < NMOD) { mod_unit(F, u / 96, u % 96); continue; }
        int r = u - NMOD; const int l = r / PER_L; r -= l * PER_L;
        if (r < 384) { const int tk = r / 24, tn = r % 24, d0 = tn * 128, c0 = d0 < 1536 ? d0 : d0 + 8;
            cvt_block(F, F.in[I_WIN] + (size_t)l * 1024 * 3080, 3080, tk * 64, c0, (bf16_t*)(F.ws + WS_WIN) + (size_t)l * NPROJ * 1024, 0, d0); }
        else if (r < 512) { r -= 384; const int tk = r / 8, tn = r % 8;
            cvt_block(F, F.in[I_WOUT] + (size_t)l * 1024 * 1024, 1024, tk * 64, tn * 128, (bf16_t*)(F.ws + WS_WOUT) + (size_t)l * 1024 * 1024, 0, tn * 128); }
        else { const int mb = r - 512;
            if (slack_on(F) && mb < (l == 0 ? SLK_A + SLK_B : SLK_A)) continue;
            cvt_moe_blk(F, l * CVB_L + mb); }
    }
}

__device__ __forceinline__ void load_row_x(const Frame& F, int l, int row, f32x4 (&x)[4]) {
    const int lane = F.lane;
    if (l == 0) { const float* p = row_input(F, row);
#pragma unroll
        for (int i = 0; i < 4; ++i) x[i] = *(const f32x4*)(p + lane * 4 + 256 * i);
    } else {
        const bf16_t* p = (const bf16_t*)(F.ws + WS_XRES) + (size_t)row * DM;
        const float* g2 = (const float*)(F.ws + WS_MOD) + (size_t)((l - 1) * 9 + row_mrow(row)) * 6144 + 5 * 1024;
        const bf16_t* ys = (const bf16_t*)(F.ws + WS_YSLOT) + (size_t)row * 4 * DM;
#pragma unroll
        for (int i = 0; i < 4; ++i) {
            const int c = lane * 4 + 256 * i; f32x4 s = (f32x4){0.f, 0.f, 0.f, 0.f};
#pragma unroll
            for (int k = 0; k < 4; ++k) { const u32x2 w = *(const u32x2*)(ys + (size_t)k * DM + c); s += (f32x4){bflo(w.x), bfhi(w.x), bflo(w.y), bfhi(w.y)}; }
            const u32x2 xw = *(const u32x2*)(p + c);
            x[i] = (f32x4){bflo(xw.x), bfhi(xw.x), bflo(xw.y), bfhi(xw.y)} + *(const f32x4*)(g2 + c) * s;
        }
    }
}
__device__ __forceinline__ void p_norm1(const Frame& F, int l) {
    LAS float* wdt = (LAS float*)F.lds;
    { const f32x4* src = (const f32x4*)((const float*)(F.ws + WS_WDT) + (size_t)l * 8192); f32x4 v[4];
#pragma unroll
      for (int j = 0; j < 4; ++j) v[j] = src[F.tid + NTHR * j];
#pragma unroll
      for (int j = 0; j < 4; ++j) ((LAS f32x4*)wdt)[F.tid + NTHR * j] = v[j]; }
    __syncthreads();
    const int lane = F.lane;
    const float* ng = F.in[I_N1G] + l * DM;
    f32x4 g[4];
#pragma unroll
    for (int i = 0; i < 4; ++i) g[i] = *(const f32x4*)(ng + lane * 4 + 256 * i);
    for (int row = F.bx * 8 + F.wid; row < NROW; row += F.G * 8) {
        f32x4 x[4]; load_row_x(F, l, row, x);
        f32x4 msh[4], msc[4];
        { const float* mod = (const float*)(F.ws + WS_MOD) + (size_t)(l * 9 + row_mrow(row)) * 6144;
#pragma unroll
          for (int i = 0; i < 4; ++i) { msh[i] = *(const f32x4*)(mod + lane * 4 + 256 * i); msc[i] = *(const f32x4*)(mod + 1024 + lane * 4 + 256 * i); } }
        bf16_t* xr = (bf16_t*)(F.ws + WS_XRES) + (size_t)row * DM;
        float ss = 0.f;
#pragma unroll
        for (int i = 0; i < 4; ++i) { if (l != 0) st_wt(xr + lane * 4 + 256 * i, (u32x2){cvt_pk_bf16(x[i][0], x[i][1]), cvt_pk_bf16(x[i][2], x[i][3])}); ss += x[i][0] * x[i][0] + x[i][1] * x[i][1] + x[i][2] * x[i][2] + x[i][3] * x[i][3]; }
        ss = wave_sum_l(ss, lane);
        const float rstd = __builtin_amdgcn_rsqf(ss * (1.0f / DM) + EPSN);
        bf16_t* hp = (bf16_t*)(F.ws + WS_H) + (size_t)row * DM;
        float dt[8];
#pragma unroll
        for (int j = 0; j < 8; ++j) dt[j] = 0.f;
        f32x4 hh[4];
#pragma unroll
        for (int i = 0; i < 4; ++i) { hh[i] = x[i] * rstd * g[i] * (msc[i] + 1.0f) + msh[i];
            st_wt(hp + lane * 4 + 256 * i, (u32x2){cvt_pk_bf16(hh[i][0], hh[i][1]), cvt_pk_bf16(hh[i][2], hh[i][3])}); }
#pragma unroll
        for (int i = 0; i < 4; ++i) {
            const int c = lane * 4 + 256 * i; const f32x4 h = hh[i];
#pragma unroll
            for (int j = 0; j < 8; ++j) { const f32x4 w = *(LAS f32x4*)(wdt + j * 1024 + c); dt[j] += h[0] * w[0] + h[1] * w[1] + h[2] * w[2] + h[3] * w[3]; }
        }
#pragma unroll
        for (int j = 0; j < 8; ++j) dt[j] = wave_sum_l(dt[j], lane);
        if (lane == 0) { float* dp = (float*)(F.ws + WS_DTRAW) + (size_t)row * 8;
            *(f32x4*)dp = (f32x4){dt[0], dt[1], dt[2], dt[3]}; *(f32x4*)(dp + 4) = (f32x4){dt[4], dt[5], dt[6], dt[7]}; }
    }
    __syncthreads();
}

namespace gm {
constexpr int BM = 256, BK = 64, HALF = 128, HTB = HALF * BK * 2, STAGE_BYTES = 8 * HTB;
__device__ __forceinline__ int lds_byte(int r, int c) { const int st = (r >> 4) * 2 + (c >> 5), rr = r & 15, cc = c & 31, ob = rr * 64 + cc * 2; return st * 1024 + (ob ^ (((ob >> 9) & 1) << 5)); }
__device__ __forceinline__ void stage_rc(int b, int& R, int& C) { const int st = b / 1024, sb = b % 1024, swz = sb ^ (((sb >> 9) & 1) << 5); R = (st >> 1) * 16 + swz / 64; C = (st & 1) * 32 + (swz % 64) / 2; }
__device__ __forceinline__ int perm32(int rho) { const int n = rho >> 4, i = rho & 15; return 8 * (i >> 2) + 4 * n + (i & 3); }
struct GU { int m0, nrows, pn, e, rbg; const char* bptr; };

template <bool PERM, bool GATHER, class Sched, class Epi>
__device__ __forceinline__ void gemm_phase(LAS unsigned char* lds, const char* Abase, const Sched& S, const Epi& E, const int wave_s) {
    constexpr int K = 1024, nt = K / BK;
    constexpr size_t kstep = (size_t)(BK * 2), hstep = (size_t)HALF * K * 2;
    const int tid = tid_fresh(wave_s);
    __builtin_amdgcn_s_waitcnt(0x0F70);
    const int wid = wave_s, lane = tid & 63, wr = wid >> 2, wc = wid & 3, fr = lane & 15, fq = lane >> 4;
    unsigned voffB[2], voffA[2];
#pragma unroll
    for (int i = 0; i < 2; ++i) { int R, C; stage_rc(tid * 16 + i * 8192, R, C); const int Rb = PERM ? ((R & ~31) + perm32(R & 31)) : R; voffB[i] = (unsigned)(Rb * K + C) * 2u;
        voffA[i] = GATHER ? (unsigned)C * 2u : (unsigned)(R * K + C) * 2u; }
    const unsigned ldsw = (unsigned)wid * 1024u, lds0 = (unsigned)(unsigned long)lds;
    const int aoff = lds_byte(wr * 64 + fr, fq * 8), boff = lds_byte(wc * 32 + fr, fq * 8);
#define GM_SA(b, h) (((b) * 2 + (h)) * HTB)
#define GM_SB(b, h) ((4 + (b) * 2 + (h)) * HTB)
#define GM_STAGE(bufoff, gbase, voff) do { _Pragma("unroll") for (int _i = 0; _i < 2; ++_i) \
        glds16_s((voff)[_i], (const void*)(gbase), (unsigned)__builtin_amdgcn_readfirstlane((int)(lds0 + (unsigned)(bufoff) + ldsw + _i * 8192u))); } while (0)
#define GM_STAGE_A(bufoff, ub, pk, h, ko) do { _Pragma("unroll") for (int _i = 0; _i < 2; ++_i) { \
        if (GATHER) glds16_s((((pk)[_i] >> (16 * (h))) & 0xffffu) * (unsigned)(K * 2) + voffA[_i], (const void*)(Abase + (ko)), (unsigned)__builtin_amdgcn_readfirstlane((int)(lds0 + (unsigned)(bufoff) + ldsw + _i * 8192u))); \
        else glds16_s(voffA[_i], (const void*)((ub) + (ko) + (size_t)(h) * hstep), (unsigned)__builtin_amdgcn_readfirstlane((int)(lds0 + (unsigned)(bufoff) + ldsw + _i * 8192u))); } } while (0)
#define GM_LDA(dst, b, h) do { _Pragma("unroll") for (int m = 0; m < 4; ++m) _Pragma("unroll") for (int k = 0; k < 2; ++k) dst[m][k] = *(const LAS bf16x8*)(lds + GM_SA(b, h) + aoff + m * 2048 + k * 1024); } while (0)
#define GM_LDB(dst, b, h) do { _Pragma("unroll") for (int n = 0; n < 2; ++n) _Pragma("unroll") for (int k = 0; k < 2; ++k) dst[n][k] = *(const LAS bf16x8*)(lds + GM_SB(b, h) + boff + n * 2048 + k * 1024); } while (0)
#define GM_MMA(ai, bj, At, Bt) do { __builtin_amdgcn_s_setprio(1); _Pragma("unroll") for (int m = 0; m < 4; ++m) _Pragma("unroll") for (int n = 0; n < 2; ++n) _Pragma("unroll") for (int k = 0; k < 2; ++k) \
        acc[ai][bj][m][n] = __builtin_amdgcn_mfma_f32_16x16x32_bf16(Bt[n][k], At[m][k], acc[ai][bj][m][n], 0, 0, 0); __builtin_amdgcn_s_setprio(0); } while (0)
#define GM_WAIT_V(n) asm volatile("s_waitcnt vmcnt(" #n ")" ::: "memory")
#define GM_WAIT_L(n) asm volatile("s_waitcnt lgkmcnt(" #n ")" ::: "memory")
#define GM_BAR __builtin_amdgcn_s_barrier()
#define GM_SCHED __builtin_amdgcn_sched_barrier(0)
#define GM_MKA(u, pk) do { if (GATHER) { _Pragma("unroll") for (int _i = 0; _i < 2; ++_i) { int R_, C_; stage_rc(tid * 16 + _i * 8192, R_, C_); \
        pk[_i] = S.arow(u, R_) | (S.arow(u, HALF + R_) << 16); } } } while (0)
#define GM_KITER(W1, U2, P2, KO2, B2) do { \
            GM_LDB(B0, 0, 0); GM_SCHED; GM_LDA(At, 0, 0); \
            GM_WAIT_L(8); GM_BAR; GM_WAIT_L(0); GM_MMA(0, 0, At, B0); GM_BAR; GM_SCHED; \
            GM_LDB(B1, 0, 1); GM_STAGE(GM_SB(0, 0), B2, voffB); \
            GM_BAR; GM_WAIT_L(0); GM_MMA(0, 1, At, B1); GM_BAR; \
            GM_LDA(At, 0, 1); GM_STAGE_A(GM_SA(0, 0), U2, P2, 0, KO2); \
            GM_BAR; GM_WAIT_L(0); GM_MMA(1, 0, At, B0); GM_BAR; GM_SCHED; \
            GM_STAGE(GM_SB(0, 1), (B2) + hstep, voffB); \
            W1; GM_BAR; GM_MMA(1, 1, At, B1); GM_BAR; \
            GM_LDB(B0, 1, 0); GM_SCHED; GM_LDA(At, 1, 0); GM_STAGE_A(GM_SA(0, 1), U2, P2, 1, KO2); \
            GM_WAIT_L(8); GM_BAR; GM_WAIT_L(0); GM_MMA(0, 0, At, B0); GM_BAR; GM_SCHED; \
            GM_LDB(B1, 1, 1); GM_STAGE(GM_SB(1, 0), (B2) + kstep, voffB); \
            GM_BAR; GM_WAIT_L(0); GM_MMA(0, 1, At, B1); GM_BAR; \
            GM_LDA(At, 1, 1); GM_STAGE_A(GM_SA(1, 0), U2, P2, 0, (KO2) + kstep); \
            GM_BAR; GM_WAIT_L(0); GM_MMA(1, 0, At, B0); GM_BAR; GM_SCHED; \
            GM_STAGE(GM_SB(1, 1), (B2) + kstep + hstep, voffB); GM_STAGE_A(GM_SA(1, 1), U2, P2, 1, (KO2) + kstep); \
            GM_WAIT_V(8); GM_BAR; GM_MMA(1, 1, At, B1); GM_BAR; } while (0)
    constexpr int NPRE = (GATHER ? 4 : 0) + (Epi::META ? 2 : 0) + (Epi::BIAS ? 1 : 0), NW1 = 6 + NPRE + Epi::NST;
    static_assert(NW1 < 64, "vmcnt is 6 bits");
    GU cur, nxt; int ui = 0;
    if (!S.next(0, cur)) return;
    f32x4 acc[2][2][4][2];
    bf16x8 At[4][2], B0[2][2], B1[2][2];
    unsigned cP[2] = {0u, 0u}, nP[2] = {0u, 0u};
    GM_MKA(cur, cP);
    const char* cB = cur.bptr;
    const char* cU = Abase + (size_t)cur.m0 * (K * 2);
    GM_STAGE(GM_SB(0, 0), cB, voffB); GM_STAGE_A(GM_SA(0, 0), cU, cP, 0, 0); GM_STAGE(GM_SB(0, 1), cB + hstep, voffB); GM_STAGE_A(GM_SA(0, 1), cU, cP, 1, 0);
    if (wr == 1) GM_BAR;
    GM_WAIT_V(4); GM_BAR;
    GM_STAGE(GM_SB(1, 0), cB + kstep, voffB); GM_STAGE_A(GM_SA(1, 0), cU, cP, 0, kstep); GM_STAGE(GM_SB(1, 1), cB + hstep + kstep, voffB); GM_STAGE_A(GM_SA(1, 1), cU, cP, 1, kstep);
    GM_WAIT_V(8); GM_BAR;
    GM_SCHED;
#pragma unroll
    for (int a = 0; a < 2; ++a)
#pragma unroll
        for (int b = 0; b < 2; ++b)
#pragma unroll
            for (int m = 0; m < 4; ++m)
#pragma unroll
                for (int n = 0; n < 2; ++n) acc[a][b][m][n] = (f32x4){0.f, 0.f, 0.f, 0.f};
    for (;;) {
        const bool has_next = S.next(ui + 1, nxt);
        if (!has_next) nxt = cur;
        const char* nB = nxt.bptr;
        const char* nU = Abase + (size_t)nxt.m0 * (K * 2);
        int tq = 0; if constexpr (GATHER || Epi::META || Epi::BIAS) tq = tid_fresh(wave_s);
        if (GATHER) { int R0, C0, R1, C1; stage_rc(tq * 16, R0, C0); stage_rc(tq * 16 + 8192, R1, C1);
            const unsigned d0 = (unsigned)__builtin_amdgcn_readfirstlane((int)(lds0 + STAGE_BYTES + 8192 + wid * 256));
            glds4_v(S.lptr(nxt, R0), d0); glds4_v(S.lptr(nxt, HALF + R0), d0 + 2048); glds4_v(S.lptr(nxt, R1), d0 + 4096); glds4_v(S.lptr(nxt, HALF + R1), d0 + 6144); }
        if constexpr (Epi::META) { const unsigned d0 = (unsigned)__builtin_amdgcn_readfirstlane((int)(lds0 + STAGE_BYTES + (wid < 4 ? 4096 + (ui & 1) * 2048 + wid * 256 : 20480 + (wid - 4) * 256)));
            glds4_v(E.mptr0(cur, tq & 255), d0); glds4_v(E.mptr1(cur, tq & 255), d0 + 1024); }
        if constexpr (Epi::BIAS) { const unsigned d0 = (unsigned)__builtin_amdgcn_readfirstlane((int)(lds0 + STAGE_BYTES + (wid < 4 ? 16384 + (ui & 1) * 2048 + wid * 256 : 22528 + (wid - 4) * 256)));
            glds4_v(E.bptr(cur, tq & 255), d0); }
        for (int t = 0; t < nt - 2; t += 2) {
            const size_t ko2 = (size_t)(t + 2) * kstep;
            const char* b2 = cB + ko2;
            const bool after_epi = (t == 0 && ui > 0);
#define GM_W1SEL do { if (after_epi) asm volatile("s_waitcnt vmcnt(%0)" :: "n"(NW1) : "memory"); else GM_WAIT_V(6); } while (0)
            GM_KITER(GM_W1SEL, cU, cP, ko2, b2);
#undef GM_W1SEL
        }
        if (GATHER) { if (has_next) { const LAS unsigned* gr = (const LAS unsigned*)(lds + STAGE_BYTES + 8192) + tid;
                nP[0] = (gr[0] >> 2) | ((gr[512] >> 2) << 16); nP[1] = (gr[1024] >> 2) | ((gr[1536] >> 2) << 16); } else { nP[0] = cP[0]; nP[1] = cP[1]; } }
        GM_KITER(GM_WAIT_V(6), nU, nP, (size_t)0, nB);
        { int tz = tid; asm volatile("" : "+v"(tz)); E(acc, cur, tz, lds + (ui & 1) * 2048); }
        if (!has_next) break;
#pragma unroll
        for (int a = 0; a < 2; ++a)
#pragma unroll
            for (int b = 0; b < 2; ++b)
#pragma unroll
                for (int m = 0; m < 4; ++m)
#pragma unroll
                    for (int n = 0; n < 2; ++n) acc[a][b][m][n] = (f32x4){0.f, 0.f, 0.f, 0.f};
        cur = nxt; cB = nB; cU = nU; cP[0] = nP[0]; cP[1] = nP[1]; ++ui; asm volatile("" : "+s"(ui));
    }
    GM_WAIT_V(0);
    if (wr == 0) GM_BAR;
    GM_BAR;
#undef GM_SA
#undef GM_SB
#undef GM_STAGE
#undef GM_STAGE_A
#undef GM_LDA
#undef GM_LDB
#undef GM_MMA
#undef GM_WAIT_V
#undef GM_WAIT_L
#undef GM_BAR
#undef GM_SCHED
#undef GM_MKA
#undef GM_KITER
}

struct DenseSched {
    int nrb, npn, x, j, wpx; const char* Bt; size_t btile; int skipctx;
    __device__ __forceinline__ bool next(int i, GU& u) const {
        const int v = i * wpx + j, rbl = v / npn; int rb;
        if (skipctx) { const int q = rbl * 8 + x; rb = q + q / 16 + 1; } else rb = rbl * 8 + x;
        if (rb >= nrb) return false;
        u.pn = v - rbl * npn; u.m0 = rb * BM; u.nrows = BM; u.e = 0; u.rbg = rb; u.bptr = Bt + (size_t)u.pn * btile; return true;
    }
    __device__ __forceinline__ unsigned arow(const GU& u, int r) const { return (unsigned)(u.m0 + r); }
    __device__ __forceinline__ const int* lptr(const GU&, int) const { return nullptr; }
};
}

struct EpiProj {
    static constexpr bool META = false, BIAS = false; static constexpr int NST = 16;
    bf16_t* O;
    __device__ __forceinline__ const int* mptr0(const gm::GU&, int) const { return nullptr; }
    __device__ __forceinline__ const int* mptr1(const gm::GU&, int) const { return nullptr; }
    __device__ __forceinline__ void operator()(const f32x4 (&acc)[2][2][4][2], const gm::GU& u, int tz, LAS unsigned char*) const {
        const int wid = tz >> 6, lane = tz & 63, wr = wid >> 2, wc = wid & 3, fr = lane & 15, fq = lane >> 4;
        const int row0 = u.m0 + wr * 64 + fr, col0 = u.pn * 256 + wc * 32 + 8 * fq;
#pragma unroll
        for (int ai = 0; ai < 2; ++ai)
#pragma unroll
            for (int m = 0; m < 4; ++m) { bf16_t* rowp = O + (size_t)(row0 + ai * 128 + m * 16) * NPROJ + col0;
#pragma unroll
                for (int bj = 0; bj < 2; ++bj) { const f32x4 v0 = acc[ai][bj][m][0], v1 = acc[ai][bj][m][1];
                    *(u32x4*)(rowp + bj * 128) = (u32x4){cvt_pk_bf16(v0[0], v0[1]), cvt_pk_bf16(v0[2], v0[3]), cvt_pk_bf16(v1[0], v1[1]), cvt_pk_bf16(v1[2], v1[3])}; } }
    }
};
__device__ __forceinline__ void p_inproj(const Frame& F, int l) {
    gm::DenseSched S; S.nrb = NROW / 256; S.npn = NPROJ / 256; S.x = F.gx; S.j = F.gj; S.wpx = F.gn;
    S.Bt = (const char*)(F.ws + WS_WIN) + (size_t)l * NPROJ * 1024 * 2; S.btile = (size_t)256 * 1024 * 2; S.skipctx = 0;
    if (slack_on(F)) { if (F.gj >= F.gn - SLK_IN) { cvt_slack(F, l * CVB_L, SLK_A, F.gx * SLK_IN + (F.gj - (F.gn - SLK_IN)), 8 * SLK_IN); return; } S.wpx = F.gn - SLK_IN; }
    EpiProj E{(bf16_t*)(F.ws + WS_PROJ)};
    gm::gemm_phase<true, false>(F.lds, (const char*)(F.ws + WS_H), S, E, F.wave_s);
}

#if MK_DUP == 11
struct EpiNull {
    static constexpr bool META = false, BIAS = false; static constexpr int NST = 0;
    bf16_t* O;
    __device__ __forceinline__ const int* mptr0(const gm::GU&, int) const { return nullptr; }
    __device__ __forceinline__ const int* mptr1(const gm::GU&, int) const { return nullptr; }
    __device__ __forceinline__ void operator()(const f32x4 (&acc)[2][2][4][2], const gm::GU& u, int tz, LAS unsigned char*) const {
        float s = 0.f;
#pragma unroll
        for (int ai = 0; ai < 2; ++ai)
#pragma unroll
            for (int bj = 0; bj < 2; ++bj)
#pragma unroll
                for (int m = 0; m < 4; ++m)
#pragma unroll
                    for (int n = 0; n < 2; ++n) s += acc[ai][bj][m][n][0] + acc[ai][bj][m][n][1] + acc[ai][bj][m][n][2] + acc[ai][bj][m][n][3];
        if (s == 12345.6789f) O[(size_t)u.m0 * NPROJ + tz] = 0;
    }
};
__device__ __forceinline__ void p_inproj_null(const Frame& F, int l) {
    gm::DenseSched S; S.nrb = NROW / 256; S.npn = NPROJ / 256; S.x = F.gx; S.j = F.gj; S.wpx = F.gn;
    S.Bt = (const char*)(F.ws + WS_WIN) + (size_t)l * NPROJ * 1024 * 2; S.btile = (size_t)256 * 1024 * 2; S.skipctx = 0;
    EpiNull E{(bf16_t*)(F.ws + WS_PROJ)};
    gm::gemm_phase<true, false>(F.lds, (const char*)(F.ws + WS_H), S, E, F.wave_s);
}
#endif

constexpr float QSCALE = 0.125f * 1.4426950408889634f;
__device__ __forceinline__ void c1_setup(const Frame& F, LAS float* tab) {
    for (int idx = F.tid; idx < 1024; idx += NTHR) { const int p = idx >> 4, i = idx & 15; const float inv = exp2f(-(float)i * (13.287712379549449f / 16.0f));
        const float xa = (float)p * inv, k = rintf(xa * 0.15915494309189535f);
        float rr = __builtin_fmaf(-k, 6.28125f, xa); rr = __builtin_fmaf(-k, 1.9353071795864769e-3f, rr);
        tab[2 * idx] = __cosf(rr); tab[2 * idx + 1] = __sinf(rr); }
    __syncthreads();
}
__device__ __forceinline__ void c1_unit(const Frame& F, int l, int u, const LAS float* tab) {
    const int b = u / 68, pos0 = (u - b * 68) * 64, row0 = b * TPB + pos0;
    const bf16_t* proj = (const bf16_t*)(F.ws + WS_PROJ);
    LAS bf16_t* vt = (LAS bf16_t*)(F.lds + 8192);
#pragma unroll
    for (int j = 0; j < 8; ++j) { const int p = F.tid + NTHR * j, r = p >> 6, c8 = (p & 63) * 8;
        *(LAS u32x4*)(vt + r * 520 + c8) = *(const u32x4*)(proj + (size_t)(row0 + r) * NPROJ + C_V + c8); }
    u32x4 tv[8];
#pragma unroll
    for (int j = 0; j < 8; ++j) { const int p = F.tid + NTHR * j, r = p >> 6, c8 = (p & 63) * 8; tv[j] = *(const u32x4*)(proj + (size_t)(row0 + r) * NPROJ + C_Q + c8); }
    const f32x4 gq1 = *(const f32x4*)(F.in[I_QN] + l * 64 + 4 * (F.tid & 7)), gq2 = *(const f32x4*)(F.in[I_QN] + l * 64 + 32 + 4 * (F.tid & 7));
    const f32x4 gk1 = *(const f32x4*)(F.in[I_KN] + l * 64 + 4 * (F.tid & 7)), gk2 = *(const f32x4*)(F.in[I_KN] + l * 64 + 32 + 4 * (F.tid & 7));
    __syncthreads();
    { const int t = F.tid, h = t >> 7, dv = t & 127;
      bf16_t* dst = (bf16_t*)(F.ws + WS_VT) + ((size_t)((b * 4 + h) * 128 + dv)) * TPB + pos0;
#pragma unroll
      for (int g = 0; g < 4; ++g) { unsigned w[8];
#pragma unroll
          for (int pp = 0; pp < 16; pp += 2) { const int k0 = 16 * g + 8 * ((pp & 7) >> 2) + 4 * (pp >> 3) + (pp & 3);
              w[pp >> 1] = (unsigned)vt[k0 * 520 + t] | ((unsigned)vt[(k0 + 1) * 520 + t] << 16); }
          *(u32x4*)(dst + 16 * g) = (u32x4){w[0], w[1], w[2], w[3]}; *(u32x4*)(dst + 16 * g + 8) = (u32x4){w[4], w[5], w[6], w[7]}; } }
    const int hw = F.tid >> 5, i = F.tid & 31;
    const bool lat = pos0 >= CTXL;
#pragma unroll 1
    for (int which = 0; which < 2; ++which) {
        __syncthreads();
#pragma unroll
        for (int j = 0; j < 8; ++j) { const int p = F.tid + NTHR * j, r = p >> 6, c8 = (p & 63) * 8; *(LAS u32x4*)(vt + r * 520 + c8) = tv[j]; }
        if (which == 0) {
#pragma unroll
            for (int j = 0; j < 8; ++j) { const int p = F.tid + NTHR * j, r = p >> 6, c8 = (p & 63) * 8; tv[j] = *(const u32x4*)(proj + (size_t)(row0 + r) * NPROJ + C_K + c8); } }
        __syncthreads();
        const int j8 = F.tid & 7;
        const f32x4 g1 = which ? gk1 : gq1, g2 = which ? gk2 : gq2;
        const float qs = which ? 1.0f : QSCALE;
        bf16_t* dbase = (bf16_t*)(F.ws + (which ? WS_KB : WS_QB));
        LAS bf16_t* ot = (LAS bf16_t*)(F.lds + 75776);
#pragma unroll 2
        for (int it = 0; it < 8; ++it) {
            const int item = it * 64 + (F.tid >> 3), rl = item >> 3, hs8 = item & 7;
            const LAS bf16_t* src = vt + rl * 520 + hs8 * 64 + 4 * j8;
            const u32x2 wa = *(const LAS u32x2*)src, wb = *(const LAS u32x2*)(src + 32);
            const f32x4 t1 = (f32x4){bflo(wa.x), bfhi(wa.x), bflo(wa.y), bfhi(wa.y)}, t2 = (f32x4){bflo(wb.x), bfhi(wb.x), bflo(wb.y), bfhi(wb.y)};
            float ss = t1[0] * t1[0] + t1[1] * t1[1] + t1[2] * t1[2] + t1[3] * t1[3] + t2[0] * t2[0] + t2[1] * t2[1] + t2[2] * t2[2] + t2[3] * t2[3];
            ss += dppf<0xB1>(ss); ss += dppf<0x4E>(ss); ss += dppf<0x141>(ss);
            const float rstd = __builtin_amdgcn_rsqf(ss * (1.0f / 64.0f) + EPSN) * qs;
            f32x4 n1 = t1 * rstd * g1, n2 = t2 * rstd * g2;
            if (lat) { const int tp = pos0 + rl - CTXL, pp = (j8 < 4) ? (tp >> 6) : (tp & 63);
                const LAS float* tp2 = tab + 2 * (pp * 16 + ((4 * j8) & 15));
                const f32x4 c01 = *(const LAS f32x4*)tp2, c23 = *(const LAS f32x4*)(tp2 + 4);
                const f32x4 cs = (f32x4){c01[0], c01[2], c23[0], c23[2]}, sn = (f32x4){c01[1], c01[3], c23[1], c23[3]};
                const f32x4 o1 = n1 * cs - n2 * sn, o2 = n2 * cs + n1 * sn; n1 = o1; n2 = o2; }
            LAS bf16_t* od = ot + (hs8 * 64 + rl) * 72 + 4 * j8;
            *(LAS u32x2*)od = (u32x2){cvt_pk_bf16(n1[0], n1[1]), cvt_pk_bf16(n1[2], n1[3])}; *(LAS u32x2*)(od + 32) = (u32x2){cvt_pk_bf16(n2[0], n2[1]), cvt_pk_bf16(n2[2], n2[3])};
        }
        __syncthreads();
#pragma unroll
        for (int j = 0; j < 8; ++j) { const int p = F.tid + NTHR * j, hs = p >> 9, rem = p & 511, row = rem >> 3, pc = rem & 7;
            *(u32x4*)(dbase + ((size_t)((b * 4 + (hs >> 1)) * 2 + (hs & 1)) * TPB + pos0 + row) * 64 + pc * 8) = *(const LAS u32x4*)(ot + (hs * 64 + row) * 72 + pc * 8); }
    }
    __syncthreads();
}

__device__ __forceinline__ int crow(int r, int hi) { return (r & 3) + 8 * (r >> 2) + 4 * hi; }
#define MFMA32(a, b, c) __builtin_amdgcn_mfma_f32_32x32x16_bf16(a, b, c, 0, 0, 0)
#define ZERO16 ((f32x16){0.f, 0.f, 0.f, 0.f, 0.f, 0.f, 0.f, 0.f, 0.f, 0.f, 0.f, 0.f, 0.f, 0.f, 0.f, 0.f})
__device__ __forceinline__ void attn_unit(const Frame& F, int l, int b, int h, int qb, const float shift, const float lam, const float oml) {
    LAS unsigned char* lds = F.lds;
    const int t0 = tid_fresh(F.wave_s);
    const int lane = t0 & 63, wid = __builtin_amdgcn_readfirstlane(t0 >> 6), r32 = lane & 31, hi = lane >> 5;
    const int nkt = (qb == 0) ? 8 : 136;
    const bf16_t* Kg = (const bf16_t*)(F.ws + WS_KB) + (size_t)((b * 4 + h) * 2) * TPB * 64;
    const bf16_t* Vg = (const bf16_t*)(F.ws + WS_VT) + (size_t)((b * 4 + h) * 128) * TPB;
    const bf16_t* Qg = (const bf16_t*)(F.ws + WS_QB) + ((size_t)((b * 4 + h) * 2) * TPB + qb * 256) * 64;
    const unsigned lds0 = (unsigned)(unsigned long)lds;
#define AT_DMA(base, voff32, off) glds16_s((voff32), (const void*)(base), (unsigned)__builtin_amdgcn_readfirstlane((int)(lds0 + (unsigned)(off))))
    const unsigned koff = (unsigned)((((wid >> 2) * TPB + (lane & 31)) * 64 + (2 * (wid & 3) + (lane >> 5)) * 8) * 2);
    const unsigned voff = (unsigned)((((wid & 1) * 64 + lane) * TPB + (wid >> 1) * 8) * 2);
#define AT_K(t, s) AT_DMA((const char*)Kg + (size_t)(t) * (32 * 64 * 2), koff, (s) * 16384 + (wid >> 2) * 4096 + (wid & 3) * 1024)
#define AT_V(t, s) AT_DMA((const char*)Vg + (size_t)(t) * (32 * 2), voff, (s) * 16384 + 8192 + (wid >> 1) * 2048 + (wid & 1) * 1024)
#pragma unroll
    for (int j = 0; j < 8; ++j) { const int idx = wid * 8 + j, sub = idx >> 5, ch = (idx >> 2) & 7, rg = idx & 3;
        AT_DMA((const char*)Qg, (unsigned)((sub * TPB * 64 + (rg * 64 + lane) * 64 + ch * 8) * 2), 65536 + sub * 32768 + ch * 4096 + rg * 1024); }
    AT_K(0, 0); AT_K(1, 1); AT_V(0, 0);
    f32x16 O[2][4];
#pragma unroll
    for (int a = 0; a < 2; ++a)
#pragma unroll
        for (int v = 0; v < 4; ++v)
#pragma unroll
            for (int r = 0; r < 16; ++r) O[a][v][r] = 0.f;
    float lsum0 = 0.f, lsum1 = 0.f;
    const LAS unsigned char* qbase = lds + 65536 + (wid * 32 + r32) * 16 + hi * 4096;
    f32x16 X0, X2;
#pragma unroll
    for (int r = 0; r < 16; ++r) { X0[r] = 0.f; X2[r] = 0.f; }
    const int grp = wid >> 2;
#define AT_VF(f) (*(const LAS bf16x8*)(vb + ((f) >> 2) * 4096 + ((f) & 3) * 512))
#define AT_PVSTEP(f, vcur, vnext2) do { if ((f) + 2 < 8) vnext2 = AT_VF((f) + 2); \
            { const int ks_ = (f) >> 2, v4_ = (f) & 3; \
            const bf16x8 pa = __builtin_bit_cast(bf16x8, (f32x4){X0[4 * ks_], X0[4 * ks_ + 1], X0[4 * ks_ + 2], X0[4 * ks_ + 3]}); \
            const bf16x8 pb = __builtin_bit_cast(bf16x8, (f32x4){X2[4 * ks_], X2[4 * ks_ + 1], X2[4 * ks_ + 2], X2[4 * ks_ + 3]}); \
            O[0][v4_] = MFMA32(pa, vcur, O[0][v4_]); O[1][v4_] = MFMA32(pb, vcur, O[1][v4_]); } } while (0)
#define AT_PV(tp) do { const LAS unsigned char* vb = lds + ((tp) & 1) * 16384 + 8192 + hi * 2048 + r32 * 16; bf16x8 v0_ = AT_VF(0), v1_ = AT_VF(1), v2_; \
        AT_PVSTEP(0, v0_, v2_); AT_PVSTEP(1, v1_, v0_); AT_PVSTEP(2, v2_, v1_); AT_PVSTEP(3, v0_, v2_); AT_PVSTEP(4, v1_, v0_); AT_PVSTEP(5, v2_, v1_); \
        AT_PVSTEP(6, v0_, v2_); AT_PVSTEP(7, v1_, v0_); } while (0)
#define AT_S(ts) do { const LAS unsigned char* kb = lds + ((ts) & 1) * 16384 + hi * 512 + r32 * 16; \
        _Pragma("unroll") for (int ds = 0; ds < 4; ++ds) { \
            const bf16x8 ka = *(const LAS bf16x8*)(kb + ds * 1024), kc = *(const LAS bf16x8*)(kb + 4096 + ds * 1024); \
            const bf16x8 qb2 = *(const LAS bf16x8*)(qbase + 32768 + ds * 8192); const bf16x8 qa = (ds < 2) ? qf[ds & 1] : *(const LAS bf16x8*)(qbase + ds * 8192); \
            if (ds == 0) { X0 = MFMA32(ka, qa, ZERO16); X2 = MFMA32(kc, qb2, ZERO16); } else { X0 = MFMA32(ka, qa, X0); X2 = MFMA32(kc, qb2, X2); } } } while (0)
#define AT_EXP8(S, base, D, dbase, LS) do { const float e0 = __builtin_amdgcn_exp2f(S[base]), e1 = __builtin_amdgcn_exp2f(S[base + 1]), e2 = __builtin_amdgcn_exp2f(S[base + 2]), e3 = __builtin_amdgcn_exp2f(S[base + 3]), \
        e4 = __builtin_amdgcn_exp2f(S[base + 4]), e5 = __builtin_amdgcn_exp2f(S[base + 5]), e6 = __builtin_amdgcn_exp2f(S[base + 6]), e7 = __builtin_amdgcn_exp2f(S[base + 7]); \
        LS += ((e0 + e1) + (e2 + e3)) + ((e4 + e5) + (e6 + e7)); \
        D[dbase] = __uint_as_float(cvt_pk_bf16(e0, e1)); D[dbase + 1] = __uint_as_float(cvt_pk_bf16(e2, e3)); D[dbase + 2] = __uint_as_float(cvt_pk_bf16(e4, e5)); D[dbase + 3] = __uint_as_float(cvt_pk_bf16(e6, e7)); } while (0)
#define AT_EXP() do { if (shift > 0.f) { _Pragma("unroll") for (int r = 0; r < 16; ++r) { X0[r] -= shift; X2[r] -= shift; } } \
        AT_EXP8(X0, 0, X0, 0, lsum0); AT_EXP8(X0, 8, X0, 4, lsum0); AT_EXP8(X2, 0, X2, 0, lsum1); AT_EXP8(X2, 8, X2, 4, lsum1); } while (0)
#define AT_ISSUE(t) do { if ((t) + 1 < nkt) AT_K((t) + 1, ((t) + 1) & 1); if ((t) < nkt) AT_V((t), (t) & 1); } while (0)
#define AT_BAR() do { __builtin_amdgcn_sched_barrier(0); __builtin_amdgcn_s_barrier(); __builtin_amdgcn_sched_barrier(0); } while (0)
#define AT_WAITBAR() do { __builtin_amdgcn_sched_barrier(0); asm volatile("s_waitcnt vmcnt(0)" ::: "memory"); __builtin_amdgcn_s_barrier(); __builtin_amdgcn_sched_barrier(0); } while (0)
    AT_WAITBAR();
    bf16x8 qf[2];
#pragma unroll
    for (int ds = 0; ds < 2; ++ds) qf[ds] = *(const LAS bf16x8*)(qbase + ds * 8192);
    if (grp == 0) {
        AT_S(0); AT_BAR();
#pragma unroll 1
        for (int t = 0; t < nkt; ++t) {
            AT_EXP(); AT_WAITBAR();
            AT_ISSUE(t + 1); AT_PV(t); { const int ts = (t + 1 < nkt) ? t + 1 : nkt - 1; AT_S(ts); } AT_BAR();
        }
        AT_WAITBAR();
    } else {
        AT_BAR();
        AT_S(0); AT_WAITBAR();
#pragma unroll 1
        for (int t = 0; t < nkt; ++t) {
            AT_ISSUE(t + 1); AT_EXP(); AT_BAR();
            AT_PV(t); { const int ts = (t + 1 < nkt) ? t + 1 : nkt - 1; AT_S(ts); } AT_WAITBAR();
        }
    }
#undef AT_PV
#undef AT_S
#undef AT_VF
#undef AT_PVSTEP
#undef AT_EXP8
#undef AT_EXP
#undef AT_ISSUE
#undef AT_BAR
#undef AT_WAITBAR
    const int tz = tid_fresh(F.wave_s);
    const int lane2 = tz & 63, wid2 = tz >> 6, r32b = lane2 & 31, hib = lane2 >> 5;
    lsum0 = x32_red<OpAdd>(lsum0); lsum1 = x32_red<OpAdd>(lsum1);
    LAS float* wl = (LAS float*)(lds + 131072) + wid2 * 64;
    if (hib == 0) { wl[r32b] = __builtin_amdgcn_rcpf(lsum0); wl[32 + r32b] = lam * __builtin_amdgcn_rcpf(lsum1); }
    asm volatile("s_waitcnt lgkmcnt(0)" ::: "memory");
    float ss[16];
#pragma unroll
    for (int r = 0; r < 16; ++r) { const int q = crow(r, hib); const float i0 = wl[q], i1 = wl[32 + q]; float sacc = 0.f;
#pragma unroll
        for (int v4 = 0; v4 < 4; ++v4) { const float o = O[0][v4][r] * i0 - O[1][v4][r] * i1; O[0][v4][r] = o; sacc += o * o; }
        ss[r] = sacc; }
#pragma unroll
    for (int r = 0; r < 16; ++r) ss[r] = half32_red<OpAdd>(ss[r]);
    const float* gs = F.in[I_SUBG] + l * 128;
    float gv[4];
    unsigned omb = (l == 0) ? 0x3f4ccccdu : 0x3f24fe8cu; asm volatile("" : "+s"(omb));
#pragma unroll
    for (int v4 = 0; v4 < 4; ++v4) gv[v4] = gs[v4 * 32 + r32b] * __uint_as_float(omb);
    LAS bf16_t* stg = (LAS bf16_t*)(lds + wid2 * 8704);
#pragma unroll
    for (int r = 0; r < 16; ++r) { const float sc = __builtin_amdgcn_rsqf(ss[r] * (1.0f / 128.0f) + EPSN); LAS bf16_t* yr = stg + crow(r, hib) * 136 + r32b;
#pragma unroll
        for (int v4 = 0; v4 < 4; ++v4) yr[v4 * 32] = f2bf(O[0][v4][r] * sc * gv[v4]); }
    bf16_t* yb = (bf16_t*)(F.ws + WS_YMIX) + (size_t)(b * TPB + qb * 256 + wid2 * 32) * DM + 512 + h * 128;
#pragma unroll
    for (int j = 0; j < 8; ++j) { const int p = lane2 + 64 * j, row = p >> 4, pc = p & 15; *(u32x4*)(yb + (size_t)row * DM + pc * 8) = *(const LAS u32x4*)(stg + row * 136 + pc * 8); }
    __syncthreads();
#undef AT_DMA
#undef AT_K
#undef AT_V
}
__device__ __forceinline__ void conv_unit(const Frame& F, int l, int u) {
    const int t0 = tid_fresh(F.wave_s);
    const int tid = t0;
    const int b = u / 68, pos0 = (u - b * 68) * 64;
    const int seg_lo = pos0 < CTXL ? 0 : CTXL, seg_hi = pos0 < CTXL ? CTXL : TPB;
    const bf16_t* proj = (const bf16_t*)(F.ws + WS_PROJ);
    LAS bf16_t* tile = (LAS bf16_t*)F.lds;
    const int c0 = tid * 2;
    const bool lru = c0 < 256; const int cc = lru ? c0 : c0 - 256;
    const float* cw = lru ? F.in[I_LCW] + l * 1024 : F.in[I_SCW] + l * 3072; const int cs = lru ? 256 : 768;
    const f32x2 w0 = *(const f32x2*)(cw + cc), w1 = *(const f32x2*)(cw + cs + cc), w2 = *(const f32x2*)(cw + 2 * cs + cc), w3 = *(const f32x2*)(cw + 3 * cs + cc);
    const f32x2 cb = *(const f32x2*)((lru ? F.in[I_LCB] + l * 256 : F.in[I_SCB] + l * 768) + cc);
    {   u32x4 v[17];
#pragma unroll
        for (int j = 0; j < 17; ++j) { const int p = tid + NTHR * j, r = p >> 7, c8 = (p & 127) * 8, pos = pos0 - 2 + r, col = c8 < 256 ? 256 + c8 : 512 + c8;
            v[j] = (r < 67 && pos >= seg_lo && pos < seg_hi) ? *(const u32x4*)(proj + (size_t)(b * TPB + pos) * NPROJ + col) : (u32x4){0u, 0u, 0u, 0u}; }
#pragma unroll
        for (int j = 0; j < 17; ++j) { const int p = tid + NTHR * j, r = p >> 7, c8 = (p & 127) * 8; if (r < 67) *(LAS u32x4*)(tile + r * 1032 + c8) = v[j]; }
    }
    __syncthreads();
    {
        const bool tr = (c0 >= 256 && c0 < 768);
        bf16_t* trp = (bf16_t*)(F.ws + WS_XBT) + ((size_t)(b * 34 + (pos0 >> 7)) * 512 + (c0 - 256)) * 136 + (pos0 & 127);
        unsigned x0 = *(const LAS unsigned*)(tile + c0), x1 = *(const LAS unsigned*)(tile + 1032 + c0), x2 = *(const LAS unsigned*)(tile + 2 * 1032 + c0);
#pragma unroll 1
        for (int t8 = 0; t8 < 8; ++t8) { unsigned o[8];
#pragma unroll
            for (int j = 0; j < 8; ++j) { const unsigned x3 = *(const LAS unsigned*)(tile + (t8 * 8 + j + 3) * 1032 + c0);
                float a = cb.x + w0.x * bflo(x0) + w1.x * bflo(x1) + w2.x * bflo(x2) + w3.x * bflo(x3);
                float c = cb.y + w0.y * bfhi(x0) + w1.y * bfhi(x1) + w2.y * bfhi(x2) + w3.y * bfhi(x3);
                if (!lru) { a = siluf_(a); c = siluf_(c); }
                o[j] = cvt_pk_bf16(a, c); *(LAS unsigned*)(tile + (t8 * 8 + j) * 1032 + c0) = o[j];
                x0 = x1; x1 = x2; x2 = x3; }
            if (tr) {
                *(u32x4*)(trp + t8 * 8) = (u32x4){(o[0] & 0xffffu) | (o[1] << 16), (o[2] & 0xffffu) | (o[3] << 16), (o[4] & 0xffffu) | (o[5] << 16), (o[6] & 0xffffu) | (o[7] << 16)};
                *(u32x4*)(trp + 136 + t8 * 8) = (u32x4){(o[0] >> 16) | (o[1] & 0xffff0000u), (o[2] >> 16) | (o[3] & 0xffff0000u), (o[4] >> 16) | (o[5] & 0xffff0000u), (o[6] >> 16) | (o[7] & 0xffff0000u)}; }
        }
    }
    __syncthreads();
    {
        bf16_t* outp = (bf16_t*)(F.ws + WS_CONV) + (size_t)(b * TPB + pos0) * 1024;
#pragma unroll
        for (int j0 = 0; j0 < 16; j0 += 8) { u32x4 v[8];
#pragma unroll
            for (int j = 0; j < 8; ++j) { const int p = tid + NTHR * (j0 + j), r = p >> 7, c8 = (p & 127) * 8; v[j] = *(const LAS u32x4*)(tile + r * 1032 + c8); }
#pragma unroll
            for (int j = 0; j < 8; ++j) { const int p = tid + NTHR * (j0 + j), r = p >> 7, c8 = (p & 127) * 8; st_wt(outp + (size_t)r * 1024 + c8, v[j]); } }
    }
    __syncthreads();
}
__device__ __forceinline__ void p_conv(const Frame& F, int l) { for (int u = F.bx; u < 544; u += F.G) conv_unit(F, l, u); }

constexpr float NL2E = -1.4426950408889634f;
struct LruW { bf16x8 wa[4][2], wx[4][2]; float ba[2], bx[2], sp[2]; };
__device__ __forceinline__ void lru_load_w(const Frame& F, int l, LruW& W) {
    const int lane = F.lane, r32 = lane & 31, hi = lane >> 5, h = F.wid & 3, dir = F.wid >> 2;
    const float* wa = F.in[I_LWA] + (size_t)((l * 2 + dir) * 4 + h) * 4096;
    const float* wx = F.in[I_LWX] + (size_t)((l * 2 + dir) * 4 + h) * 4096;
#pragma unroll
    for (int ks = 0; ks < 4; ++ks)
#pragma unroll
        for (int nb = 0; nb < 2; ++nb) { unsigned a[4], x[4];
#pragma unroll
            for (int j = 0; j < 4; ++j) { const int i0 = 16 * ks + 8 * hi + 2 * j, c = nb * 32 + r32;
                a[j] = cvt_pk_bf16(NL2E * wa[i0 * 64 + c], NL2E * wa[(i0 + 1) * 64 + c]); x[j] = cvt_pk_bf16(NL2E * wx[i0 * 64 + c], NL2E * wx[(i0 + 1) * 64 + c]); }
            W.wa[ks][nb] = __builtin_bit_cast(bf16x8, (u32x4){a[0], a[1], a[2], a[3]}); W.wx[ks][nb] = __builtin_bit_cast(bf16x8, (u32x4){x[0], x[1], x[2], x[3]}); }
#pragma unroll
    for (int nb = 0; nb < 2; ++nb) { const int ch = (l * 2 + dir) * 256 + h * 64 + nb * 32 + r32;
        W.ba[nb] = NL2E * F.in[I_LBA][ch]; W.bx[nb] = NL2E * F.in[I_LBX][ch]; W.sp[nb] = 8.0f * NL2E * softplusf_(-F.in[I_LLAM][ch]); }
}
__device__ __forceinline__ float gelu_tanh(float x) { const float u = x * fmaf(0.044715f, x * x, 1.0f); return x * __builtin_amdgcn_rcpf(1.0f + __builtin_amdgcn_exp2f(u * (-2.0f * 0.7978845608028654f * 1.4426950408889634f))); }
template <int PASS>
__device__ __forceinline__ void lru_unit(const Frame& F, int l, int u, const LruW& W) {
    const int t0 = tid_fresh(F.wave_s);
    const int tid = t0, lane = tid & 63, wid = __builtin_amdgcn_readfirstlane(tid >> 6), r32 = lane & 31, hi = lane >> 5;
    const int b = u / 136, c32 = u - b * 136, pos0 = c32 * 32, row0 = b * TPB + pos0;
    const bf16_t* proj = (const bf16_t*)(F.ws + WS_PROJ);
    LAS bf16_t* xcb = (LAS bf16_t*)F.lds;
    LAS f32x2* au = (LAS f32x2*)(F.lds + 16896);
    float hh_in = 0.f; unsigned gg[8];
#pragma unroll
    for (int j = 0; j < 8; ++j) gg[j] = 0u;
    if (PASS == 2) { hh_in = ((const float*)(F.ws + WS_LRUC))[((size_t)(b * 136 + c32) * 2 + (tid >> 8)) * 256 + (tid & 255)];
#pragma unroll
        for (int j = 0; j < 8; ++j) gg[j] = *(const unsigned*)(proj + (size_t)(row0 + (tid >> 7) * 8 + j) * NPROJ + C_LG + (tid & 127) * 2); }
    {
        const bf16_t* cv = (const bf16_t*)(F.ws + WS_CONV) + (size_t)row0 * 1024;
#pragma unroll
        for (int j = 0; j < 2; ++j) { const int p = tid + NTHR * j, r = p >> 5, c8 = (p & 31) * 8; *(LAS u32x4*)(xcb + r * 264 + c8) = *(const u32x4*)(cv + (size_t)r * 1024 + c8); }
    }
    __syncthreads();
    {
        const int h = wid & 3, dir = wid >> 2;
        f32x16 Da[2], Dx[2];
#pragma unroll
        for (int nb = 0; nb < 2; ++nb)
#pragma unroll
            for (int r = 0; r < 16; ++r) { Da[nb][r] = 0.f; Dx[nb][r] = 0.f; }
#pragma unroll
        for (int ks = 0; ks < 4; ++ks) { const bf16x8 a = *(const LAS bf16x8*)(xcb + r32 * 264 + h * 64 + 16 * ks + 8 * hi);
#pragma unroll
            for (int nb = 0; nb < 2; ++nb) { Da[nb] = MFMA32(a, W.wa[ks][nb], Da[nb]); Dx[nb] = MFMA32(a, W.wx[ks][nb], Dx[nb]); } }
#pragma unroll
        for (int nb = 0; nb < 2; ++nb) { const int ch = h * 64 + nb * 32 + r32;
#pragma unroll
            for (int r = 0; r < 16; ++r) { const int tok = crow(r, hi);
                const float ra = __builtin_amdgcn_rcpf(1.0f + __builtin_amdgcn_exp2f(Da[nb][r] + W.ba[nb])), ix = __builtin_amdgcn_rcpf(1.0f + __builtin_amdgcn_exp2f(Dx[nb][r] + W.bx[nb]));
                const float a = __builtin_amdgcn_exp2f(ra * W.sp[nb]), xcv = bf2f(xcb[tok * 264 + ch]);
                const float uu = __builtin_amdgcn_sqrtf(fmaf(-a, a, 1.0f)) * ix * xcv;
                au[(dir * 32 + tok) * 256 + ch] = (f32x2){a, uu}; } }
    }
    __syncthreads();
    {
        const int dir = tid >> 8, ch = tid & 255; const size_t sidx = ((size_t)(b * 136 + c32) * 2 + dir) * 256 + ch;
        if (PASS == 1) { float A = 1.f, H = 0.f;
#pragma unroll 8
            for (int s2 = 0; s2 < 32; ++s2) { const int tok = dir ? 31 - s2 : s2; const f32x2 v = au[(dir * 32 + tok) * 256 + ch]; H = v.x * H + v.y; A *= v.x; }
            ((f32x2*)(F.ws + WS_LRUS))[sidx] = (f32x2){A, H};
        } else { float hh = hh_in;
#pragma unroll 8
            for (int s2 = 0; s2 < 32; ++s2) { const int tok = dir ? 31 - s2 : s2; f32x2 v = au[(dir * 32 + tok) * 256 + ch]; hh = v.x * hh + v.y; v.y = hh; au[(dir * 32 + tok) * 256 + ch] = v; }
        }
    }
    __syncthreads();
    if (PASS == 2) { const int c2 = (tid & 127) * 2, tq = tid >> 7;
#pragma unroll
        for (int j = 0; j < 8; ++j) { const int tok = tq * 8 + j;
            const float y0 = gelu_tanh(bflo(gg[j])) * (au[tok * 256 + c2].y + au[(32 + tok) * 256 + c2].y), y1 = gelu_tanh(bfhi(gg[j])) * (au[tok * 256 + c2 + 1].y + au[(32 + tok) * 256 + c2 + 1].y);
            *(unsigned*)((bf16_t*)(F.ws + WS_YMIX) + (size_t)(row0 + tok) * DM + c2) = cvt_pk_bf16(y0, y1); }
        __syncthreads();
    }
}
__device__ __forceinline__ void lru_carry_unit(const Frame& F, int u) {
    const int b = u >> 3, dir = (u >> 2) & 1, cg = u & 3, tid = F.tid;
    LAS f32x2* sm = (LAS f32x2*)F.lds;
    { f32x2 v[17];
#pragma unroll
      for (int j = 0; j < 17; ++j) { const int idx = tid + NTHR * j, c = idx >> 6, cl = idx & 63; v[j] = ((const f32x2*)(F.ws + WS_LRUS))[((size_t)(b * 136 + c) * 2 + dir) * 256 + cg * 64 + cl]; }
#pragma unroll
      for (int j = 0; j < 17; ++j) sm[tid + NTHR * j] = v[j]; }
    __syncthreads();
    if (tid < 64) { float h = 0.f; float* cr = (float*)(F.ws + WS_LRUC);
        for (int s2 = 0; s2 < 136; ++s2) { const int c = dir ? (s2 < 8 ? 7 - s2 : 143 - s2) : s2; const f32x2 v = sm[c * 64 + tid];
            cr[((size_t)(b * 136 + c) * 2 + dir) * 256 + cg * 64 + tid] = h; h = v.x * h + v.y; } }
    __syncthreads();
}

__device__ __forceinline__ float wave_incl_scan(float v, int lane) {
#pragma unroll
    for (int o = 1; o < 64; o <<= 1) { const float t = __shfl_up(v, o); if (lane >= o) v += t; }
    return v;
}
#define SSD_CONV128(COL, CCH, EMIT) do { \
        const float* cw_ = F.in[I_SCW] + l * 4 * 768; const float w0_ = cw_[CCH], w1_ = cw_[768 + (CCH)], w2_ = cw_[1536 + (CCH)], w3_ = cw_[2304 + (CCH)], cb_ = F.in[I_SCB][l * 768 + (CCH)]; \
        const bf16_t* pc_ = proj + (size_t)(b * TPB) * NPROJ + (COL); \
        float xm2_ = (pos0 - 2 >= seg_lo) ? bf2f(pc_[(size_t)(pos0 - 2) * NPROJ]) : 0.f, xm1_ = (pos0 - 1 >= seg_lo) ? bf2f(pc_[(size_t)(pos0 - 1) * NPROJ]) : 0.f, x0_ = bf2f(pc_[(size_t)pos0 * NPROJ]); \
        for (int t8_ = 0; t8_ < 16; ++t8_) { float xn_[8], o_[8]; \
            _Pragma("unroll") for (int j_ = 0; j_ < 8; ++j_) { const int p_ = pos0 + t8_ * 8 + j_ + 1; xn_[j_] = (p_ < seg_hi) ? bf2f(pc_[(size_t)p_ * NPROJ]) : 0.f; } \
            _Pragma("unroll") for (int j_ = 0; j_ < 8; ++j_) { const float v_ = cb_ + w0_ * xm2_ + w1_ * xm1_ + w2_ * x0_ + w3_ * xn_[j_]; o_[j_] = siluf_(v_); xm2_ = xm1_; xm1_ = x0_; x0_ = xn_[j_]; } \
            EMIT(t8_, o_); } } while (0)
#define SSD_EMIT_T(rowptr) [&](int t8, const float (&o)[8]) { *(LAS u32x4*)((rowptr) + t8 * 8) = (u32x4){cvt_pk_bf16(o[0], o[1]), cvt_pk_bf16(o[2], o[3]), cvt_pk_bf16(o[4], o[5]), cvt_pk_bf16(o[6], o[7])}; }

__device__ __forceinline__ void ssd_p1_unit(const Frame& F, int l, int u) {
    const int t0 = tid_fresh(F.wave_s);
    const int tid = t0, lane = tid & 63, wid = __builtin_amdgcn_readfirstlane(tid >> 6), r32 = lane & 31, hi = lane >> 5;
    const int b = u / 34, c = u - b * 34, pos0 = c * 128, row0 = b * TPB + pos0;
    const int seg_lo = pos0 < CTXL ? 0 : CTXL, seg_hi = pos0 < CTXL ? CTXL : TPB;
    const bf16_t* proj = (const bf16_t*)(F.ws + WS_PROJ);
    LAS bf16_t* XsT = (LAS bf16_t*)F.lds;
    LAS bf16_t* Bt = (LAS bf16_t*)(F.lds + 69632);
    LAS float* dtf = (LAS float*)(F.lds + 139264);
    LAS float* dtb = dtf + 512; LAS float* wf = dtf + 1024; LAS float* wb = dtf + 1536;
    {
        const char* img = (const char*)(F.ws + WS_XBT) + (size_t)(b * 34 + c) * 512 * 136 * 2; const unsigned lds0 = (unsigned)(unsigned long)F.lds;
#pragma unroll
        for (int j = 0; j < 17; ++j) { const int ck = wid * 17 + j; glds16_s((unsigned)(ck * 1024 + lane * 16), img, (unsigned)__builtin_amdgcn_readfirstlane((int)(lds0 + ck * 1024))); }
    }
    const float alog_w = F.in[I_SALOG][l * 8 + (wid >> 2) * 4 + (wid & 3)];
    if (tid < 128) { const float* dr = (const float*)(F.ws + WS_DTRAW) + (size_t)(row0 + tid) * 8;
        const f32x4 d0 = *(const f32x4*)dr, d1 = *(const f32x4*)(dr + 4);
        const f32x4 b0 = *(const f32x4*)(F.in[I_SDTB] + l * 8), b1 = *(const f32x4*)(F.in[I_SDTB] + l * 8 + 4);
#pragma unroll
        for (int h = 0; h < 4; ++h) { dtf[h * 128 + tid] = softplusf_(d0[h] + b0[h]); dtb[h * 128 + tid] = softplusf_(d1[h] + b1[h]); } }
    asm volatile("s_waitcnt vmcnt(0)" ::: "memory");
    __syncthreads();
    {
        const int h = wid & 3, dir = wid >> 2; const float a = -__expf(alog_w);
        const LAS float* dsrc = (dir ? dtb : dtf) + h * 128; LAS float* wdst = (dir ? wb : wf) + h * 128;
        const int tA = dir ? 2 * lane : 127 - 2 * lane, tB = dir ? 2 * lane + 1 : 126 - 2 * lane;
        const float dA = dsrc[tA], dB = dsrc[tB], pr = (dA + dB) * a, incl = wave_incl_scan(pr, lane), excl = incl - pr;
        wdst[tA] = dA * __expf(excl); wdst[tB] = dB * __expf(excl + dA * a);
        if (lane == 63) ((float*)(F.ws + WS_SSDD))[((size_t)(b * 34 + c) * 4 + h) * 2 + dir] = __expf(incl); }
    __syncthreads();
    {   const int h = wid & 3, dir = wid >> 2, g = h >> 1;
        const LAS float* wv = (dir ? wb : wf) + h * 128;
        f32x16 D[2][4];
#pragma unroll
        for (int pb = 0; pb < 2; ++pb)
#pragma unroll
            for (int nb = 0; nb < 4; ++nb)
#pragma unroll
                for (int r = 0; r < 16; ++r) D[pb][nb][r] = 0.f;
#pragma unroll 2
        for (int ks = 0; ks < 8; ++ks) {
            const f32x4 s0 = *(const LAS f32x4*)(wv + 16 * ks + 8 * hi), s1 = *(const LAS f32x4*)(wv + 16 * ks + 8 * hi + 4);
            bf16x8 Af[2];
#pragma unroll
            for (int pb = 0; pb < 2; ++pb) { const u32x4 x = *(const LAS u32x4*)(XsT + (h * 64 + pb * 32 + r32) * 136 + 16 * ks + 8 * hi);
                const u32x4 y = (u32x4){cvt_pk_bf16(bflo(x.x) * s0[0], bfhi(x.x) * s0[1]), cvt_pk_bf16(bflo(x.y) * s0[2], bfhi(x.y) * s0[3]), cvt_pk_bf16(bflo(x.z) * s1[0], bfhi(x.z) * s1[1]), cvt_pk_bf16(bflo(x.w) * s1[2], bfhi(x.w) * s1[3])};
                Af[pb] = __builtin_bit_cast(bf16x8, y); }
#pragma unroll
            for (int nb = 0; nb < 4; ++nb) { const bf16x8 bfr = *(const LAS bf16x8*)(Bt + (g * 128 + nb * 32 + r32) * 136 + 16 * ks + 8 * hi);
                D[0][nb] = MFMA32(Af[0], bfr, D[0][nb]); D[1][nb] = MFMA32(Af[1], bfr, D[1][nb]); }
        }
        float* sp = (float*)(F.ws + WS_SSDS) + (((size_t)(b * 34 + c) * 4 + h) * 2 + dir) * 8192;
        __syncthreads();
        LAS float* stg = (LAS float*)(F.lds + wid * 16896);
#pragma unroll
        for (int pb = 0; pb < 2; ++pb) {
#pragma unroll
            for (int nb = 0; nb < 4; ++nb)
#pragma unroll
                for (int r = 0; r < 16; ++r) stg[crow(r, hi) * 132 + nb * 32 + r32] = D[pb][nb][r];
#pragma unroll
            for (int j = 0; j < 16; ++j) { const int p = lane + 64 * j, row = p >> 5, pc = p & 31; *(f32x4*)(sp + (size_t)(pb * 32 + row) * 128 + pc * 4) = *(const LAS f32x4*)(stg + row * 132 + pc * 4); }
        }
    }
    __syncthreads();
}
__device__ __forceinline__ void ssd_carry_unit(const Frame& F, int u) {
    const int q = u & 3, dir = (u >> 2) & 1, h = (u >> 3) & 3, b = u >> 5, e = q * 2048 + F.tid * 4;
    const float* __restrict__ sl = (const float*)(F.ws + WS_SSDS); const float* __restrict__ dc = (const float*)(F.ws + WS_SSDD); bf16_t* __restrict__ si = (bf16_t*)(F.ws + WS_SSDI);
    f32x4 S = (f32x4){0.f, 0.f, 0.f, 0.f};
#pragma unroll 1
    for (int half = 0; half < 2; ++half) {
        f32x4 loc[17]; float dec[17];
#pragma unroll
        for (int j = 0; j < 17; ++j) { const int s2 = half * 17 + j, c = dir ? (s2 < 2 ? 1 - s2 : 35 - s2) : s2; const size_t base = ((size_t)(b * 34 + c) * 4 + h) * 2 + dir;
            loc[j] = *(const f32x4*)(sl + base * 8192 + e); dec[j] = dc[base]; }
#pragma unroll
        for (int j = 0; j < 17; ++j) { const int s2 = half * 17 + j, c = dir ? (s2 < 2 ? 1 - s2 : 35 - s2) : s2; const size_t base = ((size_t)(b * 34 + c) * 4 + h) * 2 + dir;
            *(u32x2*)(si + base * 8192 + e) = (u32x2){cvt_pk_bf16(S[0], S[1]), cvt_pk_bf16(S[2], S[3])};
            S = S * dec[j] + loc[j]; }
    }
}
__device__ __forceinline__ void ssd_p2_unit(const Frame& F, int l, int u) {
    const int t0 = tid_fresh(F.wave_s);
    const int tid = t0, lane = tid & 63, wid = __builtin_amdgcn_readfirstlane(tid >> 6), r32 = lane & 31, hi = lane >> 5;
    const int b = u / 34, c = u - b * 34, pos0 = c * 128, row0 = b * TPB + pos0;
    const int seg_lo = pos0 < CTXL ? 0 : CTXL, seg_hi = pos0 < CTXL ? CTXL : TPB;
    const bf16_t* proj = (const bf16_t*)(F.ws + WS_PROJ);
    LAS bf16_t* Cn = (LAS bf16_t*)F.lds;
    LAS bf16_t* Bn = (LAS bf16_t*)(F.lds + 34816);
    LAS bf16_t* XsT = (LAS bf16_t*)(F.lds + 69632);
    LAS f32x4* vec = (LAS f32x4*)(F.lds + 104448);
    LAS float* ssq = (LAS float*)(F.lds + 112640);
    LAS bf16_t* SinL = (LAS bf16_t*)(F.lds + 113152);
    const float alog_w = F.in[I_SALOG][l * 8 + (wid >> 2) * 4 + (wid & 3)];
    if (tid < 128) { const float* dr = (const float*)(F.ws + WS_DTRAW) + (size_t)(row0 + tid) * 8; ssq[tid] = 0.f;
        const f32x4 d0 = *(const f32x4*)dr, d1 = *(const f32x4*)(dr + 4);
        const f32x4 b0 = *(const f32x4*)(F.in[I_SDTB] + l * 8), b1 = *(const f32x4*)(F.in[I_SDTB] + l * 8 + 4);
#pragma unroll
        for (int h = 0; h < 4; ++h) vec[h * 128 + tid] = (f32x4){0.f, 0.f, softplusf_(d0[h] + b0[h]), softplusf_(d1[h] + b1[h])}; }
    __syncthreads();
    {
        const int h = wid & 3, dir = wid >> 2; const float a = -__expf(alog_w); LAS float* vf = (LAS float*)(vec + h * 128);
        const int tA = dir ? 127 - 2 * lane : 2 * lane, tB = dir ? 126 - 2 * lane : 2 * lane + 1;
        const float dA = vf[4 * tA + 2 + dir] * a, dB = vf[4 * tB + 2 + dir] * a, incl = wave_incl_scan(dA + dB, lane);
        vf[4 * tA + dir] = incl - dB; vf[4 * tB + dir] = incl; }
    f32x16 Y[2], Yk0, Yk1;
#pragma unroll
    for (int r = 0; r < 16; ++r) { Yk0[r] = 0.f; Yk1[r] = 0.f; }
#pragma unroll 1
    for (int g = 0; g < 2; ++g) {
        __syncthreads();
        {
            const bf16_t* cv = (const bf16_t*)(F.ws + WS_CONV) + (size_t)row0 * 1024;
            const bf16_t* xt = (const bf16_t*)(F.ws + WS_XBT) + ((size_t)(b * 34 + c) * 512 + g * 128) * 136;
            u32x4 vc[4], vb[4], vx[5];
#pragma unroll
            for (int j = 0; j < 4; ++j) { const int p = tid + NTHR * j, r = p >> 4, c8 = (p & 15) * 8;
                vc[j] = *(const u32x4*)(cv + (size_t)r * 1024 + 768 + g * 128 + c8); vb[j] = *(const u32x4*)(cv + (size_t)r * 1024 + 512 + g * 128 + c8); }
#pragma unroll
            for (int j = 0; j < 5; ++j) { const int p = tid + NTHR * j; vx[j] = (p < 2176) ? *(const u32x4*)(xt + (size_t)p * 8) : (u32x4){0u, 0u, 0u, 0u}; }
#pragma unroll
            for (int j = 0; j < 4; ++j) { const int p = tid + NTHR * j, r = p >> 4, c8 = (p & 15) * 8; *(LAS u32x4*)(Cn + r * 136 + c8) = vc[j]; *(LAS u32x4*)(Bn + r * 136 + c8) = vb[j]; }
#pragma unroll
            for (int j = 0; j < 5; ++j) { const int p = tid + NTHR * j; if (p < 2176) *(LAS u32x4*)(XsT + p * 8) = vx[j]; }
        }
        __syncthreads();
        const int tq = tid_fresh(F.wave_s);
        const int lane_ = tq & 63, wid_ = __builtin_amdgcn_readfirstlane(tq >> 6), r32 = lane_ & 31, hi = lane_ >> 5;
        const int hg = wid_ >> 2, lb = wid_ & 3, h = 2 * g + hg;
        const float dsk = F.in[I_SD][l * 4 + h];
        const LAS f32x4* vh = vec + h * 128;
        const int lme = lb * 32 + r32; const f32x4 vl = vh[lme];
        bf16x8 Pf[8];
#pragma unroll
        for (int sb = 0; sb < 4; ++sb) {
            f32x16 GT;
#pragma unroll
            for (int r = 0; r < 16; ++r) GT[r] = 0.f;
#pragma unroll
            for (int ks = 0; ks < 8; ++ks) { const bf16x8 cf = *(const LAS bf16x8*)(Cn + (lb * 32 + r32) * 136 + 16 * ks + 8 * hi);
                const bf16x8 bf = *(const LAS bf16x8*)(Bn + (sb * 32 + r32) * 136 + 16 * ks + 8 * hi); GT = MFMA32(bf, cf, GT); }
            float pm[16];
#pragma unroll
            for (int r = 0; r < 16; ++r) { const int sidx = sb * 32 + crow(r, hi); const f32x4 vs = vh[sidx];
                const float mf = (sidx <= lme) ? __expf(vl[0] - vs[0]) * vs[2] : 0.f, mb = (sidx >= lme) ? __expf(vl[1] - vs[1]) * vs[3] : 0.f;
                pm[r] = GT[r] * (mf + mb); }
            Pf[sb * 2] = __builtin_bit_cast(bf16x8, (u32x4){cvt_pk_bf16(pm[0], pm[1]), cvt_pk_bf16(pm[2], pm[3]), cvt_pk_bf16(pm[4], pm[5]), cvt_pk_bf16(pm[6], pm[7])});
            Pf[sb * 2 + 1] = __builtin_bit_cast(bf16x8, (u32x4){cvt_pk_bf16(pm[8], pm[9]), cvt_pk_bf16(pm[10], pm[11]), cvt_pk_bf16(pm[12], pm[13]), cvt_pk_bf16(pm[14], pm[15])});
            __builtin_amdgcn_sched_barrier(0);
        }
#pragma unroll
        for (int pb = 0; pb < 2; ++pb)
#pragma unroll
            for (int r = 0; r < 16; ++r) Y[pb][r] = 0.f;
#pragma unroll
        for (int k2 = 0; k2 < 8; ++k2)
#pragma unroll
            for (int pb = 0; pb < 2; ++pb) { const LAS bf16_t* xr = XsT + (hg * 64 + pb * 32 + r32) * 136 + 16 * k2 + 4 * hi;
                const u32x2 lo = *(const LAS u32x2*)xr, hi2 = *(const LAS u32x2*)(xr + 8);
                Y[pb] = MFMA32(Pf[k2], __builtin_bit_cast(bf16x8, (u32x4){lo.x, lo.y, hi2.x, hi2.y}), Y[pb]); }
#pragma unroll 1
        for (int dir = 0; dir < 2; ++dir) {
            {
                u32x4 vs[4];
#pragma unroll
                for (int j = 0; j < 4; ++j) { const int p = tq + NTHR * j, hh = p >> 10, pr = (p >> 4) & 63, c8 = (p & 15) * 8;
                    vs[j] = *(const u32x4*)((const bf16_t*)(F.ws + WS_SSDI) + (((size_t)(b * 34 + c) * 4 + 2 * g + hh) * 2 + dir) * 8192 + pr * 128 + c8); }
                __syncthreads();
#pragma unroll
                for (int j = 0; j < 4; ++j) { const int p = tq + NTHR * j, hh = p >> 10, pr = (p >> 4) & 63, c8 = (p & 15) * 8; *(LAS u32x4*)(SinL + (hh * 64 + pr) * 136 + c8) = vs[j]; }
                __syncthreads();
            }
            f32x16 T[2];
#pragma unroll
            for (int pb = 0; pb < 2; ++pb)
#pragma unroll
                for (int r = 0; r < 16; ++r) T[pb][r] = 0.f;
#pragma unroll 2
            for (int ks = 0; ks < 8; ++ks) { const bf16x8 cf = *(const LAS bf16x8*)(Cn + (lb * 32 + r32) * 136 + 16 * ks + 8 * hi);
#pragma unroll
                for (int pb = 0; pb < 2; ++pb) { const bf16x8 sf = *(const LAS bf16x8*)(SinL + (hg * 64 + pb * 32 + r32) * 136 + 16 * ks + 8 * hi); T[pb] = MFMA32(cf, sf, T[pb]); } }
#pragma unroll
            for (int r = 0; r < 16; ++r) { const f32x4 vr = vh[lb * 32 + crow(r, hi)]; const float sc = __expf(dir ? vr[1] : vr[0]);
                Y[0][r] += sc * T[0][r]; Y[1][r] += sc * T[1][r]; }
        }
        {
          bf16_t zv[16][2]; float sqv[16];
#pragma unroll
          for (int r = 0; r < 16; ++r) { const int ll = lb * 32 + crow(r, hi);
#pragma unroll
              for (int pb = 0; pb < 2; ++pb) zv[r][pb] = proj[(size_t)(row0 + ll) * NPROJ + C_SZ + g * 128 + hg * 64 + pb * 32 + r32]; }
#pragma unroll
          for (int r = 0; r < 16; ++r) { const int ll = lb * 32 + crow(r, hi); float sq = 0.f;
#pragma unroll
              for (int pb = 0; pb < 2; ++pb) { const int pc = hg * 64 + pb * 32 + r32;
                  const float xs = bf2f(XsT[pc * 136 + ll]), z = bf2f(zv[r][pb]);
                  const float y = (Y[pb][r] + dsk * xs) * siluf_(z); Y[pb][r] = y; sq += y * y; }
              sqv[r] = half32_red<OpAdd>(sq); }
#pragma unroll
          for (int r = 0; r < 16; ++r) { const int ll = lb * 32 + crow(r, hi); if (r32 == 0) atomicAdd((float*)(ssq + ll), sqv[r]); } }
        if (g == 0) { Yk0 = Y[0]; Yk1 = Y[1]; }
    }
    __syncthreads();
    { const int t1 = tid_fresh(F.wave_s); const int lane2 = t1 & 63, wid2 = t1 >> 6, r32b = lane2 & 31, hib = lane2 >> 5, hg = wid2 >> 2, lb = wid2 & 3;
      LAS bf16_t* stg = (LAS bf16_t*)F.lds;
      const float* gn = F.in[I_SNG] + l * 256 + hg * 64 + r32b;
      const float g00 = gn[0], g01 = gn[32], g10 = gn[128], g11 = gn[160];
#pragma unroll
      for (int r = 0; r < 16; ++r) { const int ll = lb * 32 + crow(r, hib); const float rs = __builtin_amdgcn_rsqf(ssq[ll] * (1.0f / 256.0f) + EPSN);
          LAS bf16_t* sr = stg + ll * 264 + hg * 64 + r32b;
          sr[0] = f2bf(Yk0[r] * rs * g00); sr[32] = f2bf(Yk1[r] * rs * g01); sr[128] = f2bf(Y[0][r] * rs * g10); sr[160] = f2bf(Y[1][r] * rs * g11); }
      __syncthreads();
      bf16_t* yb = (bf16_t*)(F.ws + WS_YMIX) + (size_t)row0 * DM + 256;
#pragma unroll
      for (int j = 0; j < 8; ++j) { const int p = t1 + NTHR * j, row = p >> 5, pc = p & 31; *(u32x4*)(yb + (size_t)row * DM + pc * 8) = *(const LAS u32x4*)(stg + row * 264 + pc * 8); } }
    __syncthreads();
}

struct AttnConsts { float Mb, lam, lam_init, shift, oml; };
__device__ __forceinline__ AttnConsts attn_consts(const Frame& F, int l) {
    AttnConsts c; const int lane = F.lane;
    float gq = fabsf(F.in[I_QN][l * 64 + lane]), gk = fabsf(F.in[I_KN][l * 64 + lane]);
gq = wave64_red<OpMax>(gq); gk = wave64_red<OpMax>(gk);
    c.Mb = __uint_as_float(__builtin_amdgcn_readfirstlane(__float_as_uint(64.0f * gq * gk * QSCALE * 1.001f)));
    const float d0 = wave_sum_l(F.in[I_LAMQ][l * 128 + lane] * F.in[I_LAMK][l * 128 + lane], lane);
    const float d1 = wave_sum_l(F.in[I_LAMQ][l * 128 + 64 + lane] * F.in[I_LAMK][l * 128 + 64 + lane], lane);
    c.lam_init = (l == 0) ? 0.2f : 0.8f - 0.6f * 0.7408182206817179f;
    c.lam = __uint_as_float(__builtin_amdgcn_readfirstlane(__float_as_uint(expf(d0) - expf(d1) + c.lam_init)));
    c.shift = __uint_as_float(__builtin_amdgcn_readfirstlane(__float_as_uint((c.Mb > 40.f) ? (c.Mb - 40.f) : 0.f)));
    c.oml = __uint_as_float(__builtin_amdgcn_readfirstlane(__float_as_uint(1.0f - c.lam_init)));
    return c;
}
__device__ __forceinline__ void p_post(const Frame& F, int l) {
    for (int rep = 0; rep < (MK_DUP == 31 ? 2 : 1); ++rep)
    for (int u = F.bx; u < 272; u += F.G) ssd_p1_unit(F, l, u);
    { LruW W; lru_load_w(F, l, W);
      for (int rep = 0; rep < (MK_DUP == 32 ? 2 : 1); ++rep)
      for (int u = (F.bx + F.G - 48) % F.G; u < 1088; u += F.G) lru_unit<1>(F, l, u, W); }
    __syncthreads();
    LAS float* tab = (LAS float*)F.lds;
    c1_setup(F, tab);
    for (int rep = 0; rep < (MK_DUP == 33 ? 2 : 1); ++rep)
    for (int u = (F.bx + F.G - 16) % F.G; u < 544; u += F.G) c1_unit(F, l, u, tab);
}
__device__ __forceinline__ void p_mix2(const Frame& F, int l) {
    if (l == 0) {
        for (int u = F.bx; u < 272; u += F.G) ssd_p2_unit(F, l, u);
        if (F.bx >= 16 || F.G < 64) { LruW W; lru_load_w(F, l, W); const int nw = (F.G >= 64) ? F.G - 16 : F.G, w0 = (F.G >= 64) ? F.bx - 16 : F.bx;
          for (int u = w0; u < 1088; u += nw) lru_unit<2>(F, l, u, W); }
    } else {
        for (int i = F.bx; i < 256; i += F.G) ssd_p2_unit(F, l, (i >> 5) * 34 + 2 + (i & 31));
        LruW W; lru_load_w(F, l, W);
        for (int i = F.bx; i < 1024; i += F.G) lru_unit<2>(F, l, (i >> 7) * 136 + 8 + (i & 127), W);
    }
}
__device__ __forceinline__ void p_attn(const Frame& F, int l) {
    for (int u = F.bx; u < 256; u += F.G) ssd_carry_unit(F, u);
    for (int u = F.bx; u < 64; u += F.G) lru_carry_unit(F, u);
    const AttnConsts c = attn_consts(F, l);
    if (l == 0) for (int t = F.G - 1 - F.bx; t < 32; t += F.G) attn_unit(F, l, t >> 2, t & 3, 0, c.shift, c.lam, c.oml);
    for (int u = F.bx; u < 512; u += F.G) { const int bh = u % 32, qi = u / 32; attn_unit(F, l, bh >> 2, bh & 3, qi + 1, c.shift, c.lam, c.oml); }
}

struct EpiOut {
    static constexpr bool META = false, BIAS = false; static constexpr int NST = 16;
    bf16_t* O;
    __device__ __forceinline__ const int* mptr0(const gm::GU&, int) const { return nullptr; }
    __device__ __forceinline__ const int* mptr1(const gm::GU&, int) const { return nullptr; }
    __device__ __forceinline__ void operator()(const f32x4 (&acc)[2][2][4][2], const gm::GU& u, int tz, LAS unsigned char*) const {
        const int wid = tz >> 6, lane = tz & 63, wr = wid >> 2, wc = wid & 3, fr = lane & 15, fq = lane >> 4;
        const int row0 = u.m0 + wr * 64 + fr, col0 = u.pn * 256 + wc * 32 + 8 * fq;
#pragma unroll
        for (int ai = 0; ai < 2; ++ai)
#pragma unroll
            for (int m = 0; m < 4; ++m) { bf16_t* rowp = O + (size_t)(row0 + ai * 128 + m * 16) * DM + col0;
#pragma unroll
                for (int bj = 0; bj < 2; ++bj) { const f32x4 v0 = acc[ai][bj][m][0], v1 = acc[ai][bj][m][1];
                    *(u32x4*)(rowp + bj * 128) = (u32x4){cvt_pk_bf16(v0[0], v0[1]), cvt_pk_bf16(v0[2], v0[3]), cvt_pk_bf16(v1[0], v1[1]), cvt_pk_bf16(v1[2], v1[3])}; } }
    }
};
__device__ __forceinline__ void p_outproj(const Frame& F, int l, bool dummy = false) {
    gm::DenseSched S; S.nrb = NROW / 256; S.npn = 4; S.x = F.gx; S.j = F.gj; S.wpx = F.gn;
    S.Bt = (const char*)(F.ws + WS_WOUT) + (size_t)l * 1024 * 1024 * 2; S.btile = (size_t)256 * 1024 * 2; S.skipctx = (l == 1);
    if (slack_on(F) && l == 0 && !dummy) { if (F.gj >= F.gn - SLK_OUT0) { cvt_slack(F, SLK_A, SLK_B, F.gx * SLK_OUT0 + (F.gj - (F.gn - SLK_OUT0)), 8 * SLK_OUT0); return; } S.wpx = F.gn - SLK_OUT0; }
    EpiOut E{(bf16_t*)(F.ws + (dummy ? WS_YSLOT : WS_CONV))};
    gm::gemm_phase<true, false>(F.lds, (const char*)(F.ws + WS_YMIX), S, E, F.wave_s);
}

__device__ __forceinline__ void p_norm2(const Frame& F, int l, bool dummy = false) {
    constexpr int HSTR = 1032;
    LAS bf16_t* hbH = (LAS bf16_t*)F.lds;
    LAS bf16_t* hbL = hbH + 8 * HSTR;
    LAS float* part = (LAS float*)(hbL + 8 * HSTR);
    constexpr int NTR = 40;
    LAS int* ent = (LAS int*)(F.lds + 131072);
    LAS int* lcnt = ent + 8 * NTR * 4;
    LAS int* gb = lcnt + 32;
    LAS float* entg = (LAS float*)(gb + 32);
    const int tid = F.tid, lane = F.lane, wid = F.wid;
    bf16x8 wh[4][2], wl[4][2];
    { const float* src = F.in[I_RW] + (size_t)l * 1024 * 32 + (size_t)(wid * 128 + 8 * (lane >> 4)) * 32 + (lane & 15);
#pragma unroll
      for (int ks = 0; ks < 4; ++ks)
#pragma unroll
          for (int eh = 0; eh < 2; ++eh) { unsigned ph[4], pl[4];
#pragma unroll
              for (int q = 0; q < 4; ++q) { const float w0 = src[(size_t)(32 * ks + 2 * q) * 32 + 16 * eh], w1 = src[(size_t)(32 * ks + 2 * q + 1) * 32 + 16 * eh];
                  ph[q] = cvt_pk_bf16(w0, w1); pl[q] = cvt_pk_bf16(w0 - bflo(ph[q]), w1 - bfhi(ph[q])); }
              wh[ks][eh] = __builtin_bit_cast(bf16x8, (u32x4){ph[0], ph[1], ph[2], ph[3]}); wl[ks][eh] = __builtin_bit_cast(bf16x8, (u32x4){pl[0], pl[1], pl[2], pl[3]}); } }
    for (int idx = tid; idx < 8 * NTR * 4; idx += NTHR) ent[idx] = -1;
    if (tid < 32) lcnt[tid] = 0;
    __syncthreads();
    const float* ng = F.in[I_N2G] + l * DM;
    f32x4 g[4];
#pragma unroll
    for (int i = 0; i < 4; ++i) g[i] = *(const f32x4*)(ng + lane * 4 + 256 * i);
    const float rbias = F.in[I_RB][l * 32 + (lane >> 1)];
    const int ntrip0 = (NROW + F.G * 8 - 1) / (F.G * 8), ntrip = ntrip0 < NTR ? ntrip0 : NTR;
    u32x2 ow[4], xv[4]; f32x4 xf[4], mg1[4], msh[4], msc[4];
#pragma unroll
    for (int i = 0; i < 4; ++i) { ow[i] = (u32x2){0u, 0u}; xv[i] = ow[i]; xf[i] = (f32x4){0.f, 0.f, 0.f, 0.f}; mg1[i] = xf[i]; msh[i] = xf[i]; msc[i] = xf[i]; }
#define N2_ISSUE(rw) do { const int bq_ = (rw) / TPB, pos_ = (rw) - bq_ * TPB; \
        const float* mod_ = (const float*)(F.ws + WS_MOD) + (size_t)(l * 9 + (pos_ < CTXL ? 8 : bq_)) * 6144; const bf16_t* orow_ = (const bf16_t*)(F.ws + WS_CONV) + (size_t)(rw) * DM; \
        _Pragma("unroll") for (int i_ = 0; i_ < 4; ++i_) { const int c_ = lane * 4 + 256 * i_; ow[i_] = *(const u32x2*)(orow_ + c_); \
            mg1[i_] = *(const f32x4*)(mod_ + 2 * 1024 + c_); msh[i_] = *(const f32x4*)(mod_ + 3 * 1024 + c_); msc[i_] = *(const f32x4*)(mod_ + 4 * 1024 + c_); } \
        if (l == 0) { const float* xr_ = row_input(F, (rw)); _Pragma("unroll") for (int i_ = 0; i_ < 4; ++i_) xf[i_] = *(const f32x4*)(xr_ + lane * 4 + 256 * i_); } \
        else { const bf16_t* xb_ = (const bf16_t*)(F.ws + WS_XRES) + (size_t)(rw) * DM; _Pragma("unroll") for (int i_ = 0; i_ < 4; ++i_) xv[i_] = *(const u32x2*)(xb_ + lane * 4 + 256 * i_); } } while (0)
#define N2_OK(rw) ((rw) < NROW && !(l == 1 && ((rw) % TPB) < CTXL))
    { const int row0_ = F.bx * 8 + wid; if (ntrip > 0 && N2_OK(row0_)) N2_ISSUE(row0_); }
    for (int it = 0; it < ntrip; ++it) {
        const int row = F.bx * 8 + wid + it * F.G * 8;
        const int bq = row / TPB, pos = row - bq * TPB;
        const bool ok = row < NROW && !(l == 1 && pos < CTXL);
        if (ok) {
            bf16_t* xw = (bf16_t*)(F.ws + (dummy ? WS_YSLOT + (128u << 20) : WS_XRES)) + (size_t)(dummy ? 0 : row) * DM;
            f32x4 x[4]; float ss = 0.f;
#pragma unroll
            for (int i = 0; i < 4; ++i) x[i] = xf[i];
#pragma unroll
            for (int i = 0; i < 4; ++i) { if (l != 0) x[i] = (f32x4){bflo(xv[i].x), bfhi(xv[i].x), bflo(xv[i].y), bfhi(xv[i].y)};
                x[i] = x[i] + mg1[i] * (f32x4){bflo(ow[i].x), bfhi(ow[i].x), bflo(ow[i].y), bfhi(ow[i].y)};
                ss += x[i][0] * x[i][0] + x[i][1] * x[i][1] + x[i][2] * x[i][2] + x[i][3] * x[i][3]; }
#pragma unroll
            for (int i = 0; i < 4; ++i) st_wt(xw + lane * 4 + 256 * i, (u32x2){cvt_pk_bf16(x[i][0], x[i][1]), cvt_pk_bf16(x[i][2], x[i][3])});
            ss = wave_sum_l(ss, lane);
            const float rstd = __builtin_amdgcn_rsqf(ss * (1.0f / DM) + EPSN);
            bf16_t* hp = (bf16_t*)(F.ws + WS_H) + (size_t)row * DM;
#pragma unroll
            for (int i = 0; i < 4; ++i) { const int c = lane * 4 + 256 * i;
                const f32x4 h = x[i] * rstd * g[i] * (msc[i] + 1.0f) + msh[i];
                st_wt(hp + c, (u32x2){cvt_pk_bf16(h[0], h[1]), cvt_pk_bf16(h[2], h[3])});
                const unsigned h01 = cvt_pk_bf16(h[0], h[1]), h23 = cvt_pk_bf16(h[2], h[3]);
                *(LAS u32x2*)(hbH + wid * HSTR + c) = (u32x2){h01, h23};
                *(LAS u32x2*)(hbL + wid * HSTR + c) = (u32x2){cvt_pk_bf16(h[0] - bflo(h01), h[1] - bfhi(h01)), cvt_pk_bf16(h[2] - bflo(h23), h[3] - bfhi(h23))}; }
        }
        asm volatile("s_waitcnt lgkmcnt(0)" ::: "memory"); __builtin_amdgcn_s_barrier();
        {
            const LAS bf16_t* ah = hbH + (lane & 7) * HSTR + wid * 128 + 8 * (lane >> 4); const LAS bf16_t* al = hbL + (lane & 7) * HSTR + wid * 128 + 8 * (lane >> 4);
            f32x4 d0 = (f32x4){0.f, 0.f, 0.f, 0.f}, d1 = (f32x4){0.f, 0.f, 0.f, 0.f};
#pragma unroll
            for (int ks = 0; ks < 4; ++ks) { const bf16x8 xh = *(const LAS bf16x8*)(ah + 32 * ks), xl = *(const LAS bf16x8*)(al + 32 * ks);
                d0 = __builtin_amdgcn_mfma_f32_16x16x32_bf16(xh, wh[ks][0], d0, 0, 0, 0); d1 = __builtin_amdgcn_mfma_f32_16x16x32_bf16(xh, wh[ks][1], d1, 0, 0, 0);
                d0 = __builtin_amdgcn_mfma_f32_16x16x32_bf16(xh, wl[ks][0], d0, 0, 0, 0); d1 = __builtin_amdgcn_mfma_f32_16x16x32_bf16(xh, wl[ks][1], d1, 0, 0, 0);
                d0 = __builtin_amdgcn_mfma_f32_16x16x32_bf16(xl, wh[ks][0], d0, 0, 0, 0); d1 = __builtin_amdgcn_mfma_f32_16x16x32_bf16(xl, wh[ks][1], d1, 0, 0, 0); }
            if (lane < 32) { LAS float* pp = part + (wid * 8 + 4 * (lane >> 4)) * 32 + (lane & 15);
#pragma unroll
                for (int i = 0; i < 4; ++i) { pp[i * 32] = d0[i]; pp[i * 32 + 16] = d1[i]; } }
        }
        asm volatile("s_waitcnt lgkmcnt(0)" ::: "memory"); __builtin_amdgcn_s_barrier();
        { const int nrow_ = row + F.G * 8; if (it + 1 < ntrip && N2_OK(nrow_)) N2_ISSUE(nrow_); }
        if (ok) {
            float logit = rbias;
#pragma unroll
            for (int w = 0; w < 8; ++w) logit += part[(w * 8 + wid) * 32 + (lane >> 1)];
            int sel0 = 0, sel1 = 0, sel2 = 0, sel3 = 0; float val0 = 0.f, val1 = 0.f, val2 = 0.f, val3 = 0.f;
#pragma unroll
            for (int r = 0; r < 4; ++r) { float m = logit;
m = wave64_red<OpMax>(m);
                const unsigned long long bal = __ballot(logit == m); const int first = bal ? (__builtin_ctzll(bal) >> 1) : 0;
                if (r == 0) { sel0 = first; val0 = m; } else if (r == 1) { sel1 = first; val1 = m; } else if (r == 2) { sel2 = first; val2 = m; } else { sel3 = first; val3 = m; }
                if ((lane >> 1) == first) logit = -INFINITY; }
            const float e1 = __expf(val1 - val0), e2 = __expf(val2 - val0), e3 = __expf(val3 - val0), inv = 1.0f / (1.0f + e1 + e2 + e3);
            if (lane < 4) { const int e = lane == 0 ? sel0 : (lane == 1 ? sel1 : (lane == 2 ? sel2 : sel3));
                const float gt = (lane == 0 ? 1.0f : (lane == 1 ? e1 : (lane == 2 ? e2 : e3))) * inv;
                const int lp = atomicAdd((int*)(lcnt + e), 1);
                ent[(wid * NTR + it) * 4 + lane] = e | (lp << 8); entg[(wid * NTR + it) * 4 + lane] = gt;
                ((float*)(F.ws + (dummy ? WS_YSLOT + (64u << 20) : WS_TOKG)))[(size_t)row * 4 + lane] = gt; ((int*)(F.ws + (dummy ? WS_YSLOT + (96u << 20) : WS_TOKE)))[(size_t)row * 4 + lane] = e; }
        }
    }
#undef N2_ISSUE
#undef N2_OK
    __syncthreads();
    if (tid < 32) gb[tid] = atomicAdd((int*)(F.ws + WS_CNT) + (dummy ? 64 : 0) + l * 32 + tid, lcnt[tid]);
    __syncthreads();
    for (int idx = tid; idx < 8 * NTR * 4; idx += NTHR) { const int v = ent[idx]; if (v < 0) continue;
        const int w = idx / (NTR * 4), it2 = (idx - w * (NTR * 4)) >> 2, r = idx & 3, row = F.bx * 8 + w + it2 * F.G * 8, e = v & 255, lp = v >> 8;
        ((int*)(F.ws + (dummy ? WS_YSLOT : WS_LIST)))[(size_t)e * NROW + gb[e] + lp] = row * 4 + r;
        ((float*)(F.ws + (dummy ? WS_YSLOT + (32u << 20) : WS_LISTG)))[(size_t)e * NROW + gb[e] + lp] = entg[idx]; }
    __syncthreads();
}

struct MoeTab { LAS int* first; LAS int* cntl; LAS int* tabe; int nbt; };
__device__ __forceinline__ MoeTab moe_tables(const Frame& F, int l) {
    MoeTab T; T.first = (LAS int*)(F.lds + 131072); T.cntl = T.first + 40; T.tabe = T.cntl + 32;
    if (F.tid < 32) T.cntl[F.tid] = ((const int*)(F.ws + WS_CNT))[l * 32 + F.tid];
    __syncthreads();
    if (F.tid == 0) { int a = 0; for (int e = 0; e < 32; ++e) { T.first[e] = a; a += (T.cntl[e] + 255) >> 8; } T.first[32] = a; }
    __syncthreads();
    T.nbt = T.first[32];
    for (int rb = F.tid; rb < T.nbt; rb += NTHR) { int e = 0; while (rb >= T.first[e + 1]) ++e; T.tabe[rb] = e; }
    __syncthreads();
    return T;
}
struct MoeSched {
    MoeTab T; int npn, x, j, wpx, gsz, gather; const char* W; size_t wexp; const int* list;
    __device__ __forceinline__ bool next(int i, gm::GU& u) const {
        const int v = i * wpx + j, rbl = v / npn, gq = rbl / gsz, rbg = gq * (8 * gsz) + x * gsz + (rbl - gq * gsz);
        if (rbg >= T.nbt) return false;
        const int e = __builtin_amdgcn_readfirstlane(T.tabe[rbg]), f = __builtin_amdgcn_readfirstlane(T.first[e]), cn = __builtin_amdgcn_readfirstlane(T.cntl[e]);
        const int rb = rbg - f, nr = cn - rb * 256;
        u.pn = v - rbl * npn; u.e = e; u.rbg = rbg; u.m0 = gather ? rb * 256 : rbg * 256; u.nrows = nr < 256 ? nr : 256;
        u.bptr = W + (size_t)e * wexp + (size_t)u.pn * (256 * 1024 * 2); return true;
    }
    __device__ __forceinline__ const int* lptr(const gm::GU& u, int r) const { const int rc = r < u.nrows ? r : u.nrows - 1; return list + (size_t)u.e * NROW + u.m0 + rc; }
    __device__ __forceinline__ unsigned arow(const gm::GU& u, int r) const { return (unsigned)(*lptr(u, r) >> 2); }
};
struct EpiGU {
    static constexpr bool META = false, BIAS = true; static constexpr int NST = 8;
    bf16_t* act; const float* bgu;
    __device__ __forceinline__ const int* mptr0(const gm::GU&, int) const { return nullptr; }
    __device__ __forceinline__ const int* mptr1(const gm::GU&, int) const { return nullptr; }
    __device__ __forceinline__ const float* bptr(const gm::GU& u, int i) const { return bgu + (size_t)u.e * 2048 + u.pn * 256 + i; }
    __device__ __forceinline__ void operator()(const f32x4 (&acc)[2][2][4][2], const gm::GU& u, int tz, LAS unsigned char* lds) const {
        const int wid = tz >> 6, lane = tz & 63, wr = wid >> 2, wc = wid & 3, fr = lane & 15, fq = lane >> 4;
        const int a0 = u.pn * 128 + wc * 32 + 8 * fq;
        const LAS float* bp = (const LAS float*)(lds + gm::STAGE_BYTES + 16384) + 2 * (wc * 32 + 8 * fq);
        f32x4 bb[4];
#pragma unroll
        for (int q = 0; q < 4; ++q) bb[q] = *(const LAS f32x4*)(bp + 4 * q);
        bf16_t* base = act + (size_t)(u.rbg * 256 + wr * 64 + fr) * DEXP + a0;
#pragma unroll
        for (int ai = 0; ai < 2; ++ai)
#pragma unroll
            for (int m = 0; m < 4; ++m) { float o[8];
#pragma unroll
                for (int n = 0; n < 2; ++n)
#pragma unroll
                    for (int jx = 0; jx < 4; ++jx) { const int a = 4 * n + jx; const float bg = bb[a >> 1][(a & 1) * 2], bu = bb[a >> 1][(a & 1) * 2 + 1];
                        float gt = acc[ai][0][m][n][jx] + bg, up = acc[ai][1][m][n][jx] + bu;
                        gt = fminf(gt, 7.0f); up = fminf(fmaxf(up, -7.0f), 7.0f);
                        o[a] = (up + 1.0f) * gt * __builtin_amdgcn_rcpf(1.0f + __builtin_amdgcn_exp2f(gt * (-1.702f * 1.4426950408889634f))); }
                *(u32x4*)(base + (size_t)(ai * 128 + m * 16) * DEXP) = (u32x4){cvt_pk_bf16(o[0], o[1]), cvt_pk_bf16(o[2], o[3]), cvt_pk_bf16(o[4], o[5]), cvt_pk_bf16(o[6], o[7])}; }
    }
};
struct EpiDown {
    static constexpr bool META = true, BIAS = true; static constexpr int NST = 16;
    bf16_t* ys; const float* bd; const int* list; const float* listg; const LAS int* first;
    __device__ __forceinline__ const float* bptr(const gm::GU& u, int i) const { return bd + (size_t)u.e * 1024 + u.pn * 256 + i; }
    __device__ __forceinline__ size_t lpos(const gm::GU& u, int r) const { const int rc = r < u.nrows ? r : u.nrows - 1; return (size_t)u.e * NROW + (size_t)((u.rbg - first[u.e]) * 256 + rc); }
    __device__ __forceinline__ const int* mptr0(const gm::GU& u, int r) const { return list + lpos(u, r); }
    __device__ __forceinline__ const int* mptr1(const gm::GU& u, int r) const { return (const int*)listg + lpos(u, r); }
    __device__ __forceinline__ void operator()(const f32x4 (&acc)[2][2][4][2], const gm::GU& u, int tz, LAS unsigned char* lds) const {
        const int wid = tz >> 6, lane = tz & 63, wr = wid >> 2, wc = wid & 3, fr = lane & 15, fq = lane >> 4;
        const int col0 = u.pn * 256 + wc * 32 + 8 * fq;
        const LAS unsigned* mslot = (const LAS unsigned*)(lds + gm::STAGE_BYTES + 4096); const LAS float* mgate = (const LAS float*)(lds + gm::STAGE_BYTES + 5120);
        const LAS float* bl = (const LAS float*)(lds + gm::STAGE_BYTES + 16384) + wc * 32 + 8 * fq;
        f32x4 bv[2][2];
#pragma unroll
        for (int bj = 0; bj < 2; ++bj)
#pragma unroll
            for (int n = 0; n < 2; ++n) bv[bj][n] = *(const LAS f32x4*)(bl + bj * 128 + 4 * n);
#pragma unroll
        for (int ai = 0; ai < 2; ++ai)
#pragma unroll
            for (int m = 0; m < 4; ++m) { const int r = ai * 128 + wr * 64 + m * 16 + fr;
                const float gt = mgate[r]; const unsigned sl = r < u.nrows ? mslot[r] : (unsigned)(NROW * 4); bf16_t* rowp = ys + (size_t)sl * DM + col0;
#pragma unroll
                for (int bj = 0; bj < 2; ++bj) { const f32x4 v0 = (acc[ai][bj][m][0] + bv[bj][0]) * gt, v1 = (acc[ai][bj][m][1] + bv[bj][1]) * gt;
                    *(u32x4*)(rowp + bj * 128) = (u32x4){cvt_pk_bf16(v0[0], v0[1]), cvt_pk_bf16(v0[2], v0[3]), cvt_pk_bf16(v1[0], v1[1]), cvt_pk_bf16(v1[2], v1[3])}; } }
    }
};
__device__ __forceinline__ void p_moe_gu(const Frame& F, int l) {
    MoeSched S; S.T = moe_tables(F, l); S.npn = 8; S.x = F.gx; S.j = F.gj; S.wpx = F.gn; S.gsz = F.gn >= 8 ? F.gn / 8 : 1; S.gather = 1;
    S.W = (const char*)(F.ws + WS_WGU) + (size_t)l * 32 * 2048 * 1024 * 2; S.wexp = (size_t)2048 * 1024 * 2; S.list = (const int*)(F.ws + WS_LIST);
    EpiGU E{(bf16_t*)(F.ws + WS_ACT), F.in[I_BGU] + (size_t)l * 32 * 2048};
    gm::gemm_phase<true, true>(F.lds, (const char*)(F.ws + WS_H), S, E, F.wave_s);
}
__device__ __forceinline__ void p_moe_down(const Frame& F, int l) {
    MoeSched S; S.T = moe_tables(F, l); S.npn = 4; S.x = F.gx; S.j = F.gj; S.wpx = F.gn; S.gsz = F.gn >= 4 ? F.gn / 4 : 1; S.gather = 0;
    S.W = (const char*)(F.ws + WS_WD) + (size_t)l * 32 * 1024 * 1024 * 2; S.wexp = (size_t)1024 * 1024 * 2; S.list = (const int*)(F.ws + WS_LIST);
    EpiDown E{(bf16_t*)(F.ws + WS_YSLOT), F.in[I_BD] + (size_t)l * 32 * 1024, (const int*)(F.ws + WS_LIST), (const float*)(F.ws + WS_LISTG), S.T.first};
    gm::gemm_phase<true, false>(F.lds, (const char*)(F.ws + WS_ACT), S, E, F.wave_s);
}
__device__ __forceinline__ void p_final(const Frame& F) {
    const int lane = F.lane;
    for (int r = F.bx * 8 + F.wid; r < NBATCH * SEQ; r += 2 * F.G * 8) {
        const int r2 = r + F.G * 8; const bool two = r2 < NBATCH * SEQ; const int rb = two ? r2 : r;
        const int rowa = (r >> 12) * TPB + CTXL + (r & 4095), rowb = (rb >> 12) * TPB + CTXL + (rb & 4095);
        f32x4 xa[4], xb[4]; load_row_x(F, 2, rowa, xa); load_row_x(F, 2, rowb, xb);
        float* opa = F.out + (size_t)r * DM; float* opb = F.out + (size_t)rb * DM;
#pragma unroll
        for (int i = 0; i < 4; ++i) *(f32x4*)(opa + lane * 4 + 256 * i) = xa[i];
        if (two) {
#pragma unroll
            for (int i = 0; i < 4; ++i) *(f32x4*)(opb + lane * 4 + 256 * i) = xb[i];
        }
    }
}

#if MK_DBG
__device__ __forceinline__ void dbg_acc(const Frame& F, int chk, float got, float ref) {
    float* d = (float*)(F.ws + WS_DBG);
    float e = got - ref; float n = e * e, q = ref * ref;
    if (!(n == n) || n > 1e30f) n = 1e30f;
    atomicAdd(d + 2 * chk, n); atomicAdd(d + 2 * chk + 1, q);
}
__device__ __forceinline__ unsigned hash_u(unsigned x) { x ^= x >> 16; x *= 0x7feb352du; x ^= x >> 15; x *= 0x846ca68bu; x ^= x >> 16; return x; }
__device__ void dbg_check_01(const Frame& F, int l) {
    const int gt = F.bx * NTHR + F.tid;
    { const unsigned hsh = hash_u(gt * 2654435761u + 17u + l); const int r = hsh % 9, j = (hsh >> 8) % 6144; float s = 0.f;
      for (int k = 0; k < 1024; ++k) { const float v = r < 8 ? F.in[I_C][r * 1024 + k] : F.in[I_CCTX][k]; s += siluf_(v) * F.in[I_WMOD][((size_t)l * 1024 + k) * 6144 + j]; }
      s += F.in[I_BMOD][l * 6144 + j];
      dbg_acc(F, 0, ((const float*)(F.ws + WS_MOD))[(size_t)(l * 9 + r) * 6144 + j], s); }
    LAS float* hrow = (LAS float*)F.lds; LAS float* red = hrow + 1024;
    const int row = hash_u(F.bx * 977u + 5u) % NROW;
    const float* xr = (const float*)(F.ws + WS_XRES) + (size_t)row * DM;
    float ss = 0.f; for (int k = F.tid; k < 1024; k += NTHR) ss += xr[k] * xr[k];
    ss = wave_sum(ss); if (F.lane == 0) red[F.wid] = ss; __syncthreads();
    float tot = 0.f; for (int w = 0; w < 8; ++w) tot += red[w];
    const float rstd = 1.0f / sqrtf(tot / 1024.f + EPSN);
    const float* mod = (const float*)(F.ws + WS_MOD) + (size_t)(l * 9 + row_mrow(row)) * 6144;
    for (int k = F.tid; k < 1024; k += NTHR) hrow[k] = xr[k] * rstd * F.in[I_N1G][l * 1024 + k] * (1.f + mod[1024 + k]) + mod[k];
    __syncthreads();
    for (int q = 0; q < 2; ++q) { const int n = hash_u(gt * 31u + q) % 3080; float s = 0.f;
        for (int k = 0; k < 1024; ++k) s += hrow[k] * F.in[I_WIN][((size_t)l * 1024 + k) * 3080 + n];
        float got;
        if (n >= 1536 && n < 1544) got = ((const float*)(F.ws + WS_DTRAW))[(size_t)row * 8 + n - 1536];
        else got = bf2f(((const bf16_t*)(F.ws + WS_PROJ))[(size_t)row * NPROJ + (n < 1536 ? n : n - 8)]);
        dbg_acc(F, 1, got, s); }
    __syncthreads();
}
__device__ void dbg_check_2(const Frame& F, int l) {
    LAS float* qh = (LAS float*)F.lds;
    LAS float* w = qh + 128;
    LAS float* red = w + 2 * TPB;
    LAS float* ov = red + 64;
    const bf16_t* proj = (const bf16_t*)(F.ws + WS_PROJ);
    const unsigned hs = hash_u(F.bx * 7919u + 13u + l);
    const int b = hs & 7, h = (hs >> 3) & 3; int pos = (hs >> 5) % TPB; if (l == 1 && pos < CTXL) pos += CTXL;
    const bool lat = pos >= CTXL; const int nk = lat ? TPB : CTXL; const int row = b * TPB + pos;
    const AttnConsts ac = attn_consts(F, l);
    if (F.tid < 128) { const int sub = F.tid >> 6, d = F.tid & 63; const bf16_t* src = proj + (size_t)row * NPROJ + C_Q + h * 128 + sub * 64; float ss = 0.f;
        for (int k = 0; k < 64; ++k) ss += bf2f(src[k]) * bf2f(src[k]);
        const float rstd = 1.0f / sqrtf(ss / 64.f + EPSN); const int dp = d ^ 32;
        float n = bf2f(src[d]) * rstd * F.in[I_QN][l * 64 + d], m = bf2f(src[dp]) * rstd * F.in[I_QN][l * 64 + dp];
        if (lat) { const int tp = pos - CTXL, i = d & 31; const float ang = (float)((i < 16) ? (tp >> 6) : (tp & 63)) * powf(10000.f, -(float)(i & 15) / 16.f);
            n = (d < 32) ? n * cosf(ang) - m * sinf(ang) : n * cosf(ang) + m * sinf(ang); }
        qh[F.tid] = n; }
    __syncthreads();
    for (int j = F.tid; j < nk; j += NTHR) {
        for (int sub = 0; sub < 2; ++sub) { const bf16_t* src = proj + (size_t)(b * TPB + j) * NPROJ + C_K + h * 128 + sub * 64; float ss = 0.f;
            for (int k = 0; k < 64; ++k) ss += bf2f(src[k]) * bf2f(src[k]);
            const float rstd = 1.0f / sqrtf(ss / 64.f + EPSN); float dot = 0.f;
            for (int i = 0; i < 32; ++i) { float n1 = bf2f(src[i]) * rstd * F.in[I_KN][l * 64 + i], n2 = bf2f(src[i + 32]) * rstd * F.in[I_KN][l * 64 + i + 32];
                if (j >= CTXL) { const int tp = j - CTXL; const float ang = (float)((i < 16) ? (tp >> 6) : (tp & 63)) * powf(10000.f, -(float)(i & 15) / 16.f); const float cs = cosf(ang), sn = sinf(ang);
                    const float o1 = n1 * cs - n2 * sn, o2 = n2 * cs + n1 * sn; n1 = o1; n2 = o2; }
                dot += qh[sub * 64 + i] * n1 + qh[sub * 64 + i + 32] * n2; }
            w[sub * TPB + j] = dot * 0.125f; } }
    __syncthreads();
    float inv[2];
    for (int sub = 0; sub < 2; ++sub) {
        float mx = -1e30f; for (int j = F.tid; j < nk; j += NTHR) mx = fmaxf(mx, w[sub * TPB + j]);
        for (int o = 32; o >= 1; o >>= 1) mx = fmaxf(mx, __shfl_xor(mx, o));
        if (F.lane == 0) red[F.wid] = mx; __syncthreads();
        mx = red[0]; for (int k = 1; k < 8; ++k) mx = fmaxf(mx, red[k]); __syncthreads();
        float sm = 0.f; for (int j = F.tid; j < nk; j += NTHR) { const float e = expf(w[sub * TPB + j] - mx); w[sub * TPB + j] = e; sm += e; }
        sm = wave_sum(sm); if (F.lane == 0) red[F.wid] = sm; __syncthreads();
        sm = 0.f; for (int k = 0; k < 8; ++k) sm += red[k]; __syncthreads();
        inv[sub] = 1.0f / sm; }
    if (F.tid < 128) { float o = 0.f;
        for (int j = 0; j < nk; ++j) o += (w[j] * inv[0] - ac.lam * w[TPB + j] * inv[1]) * bf2f(proj[(size_t)(b * TPB + j) * NPROJ + C_V + h * 128 + F.tid]);
        ov[F.tid] = o; }
    __syncthreads();
    if (F.tid < 128) { float ss = 0.f; for (int k = 0; k < 128; ++k) ss += ov[k] * ov[k];
        const float ref = ov[F.tid] / sqrtf(ss / 128.f + EPSN) * F.in[I_SUBG][l * 128 + F.tid] * (1.f - ac.lam_init);
        dbg_acc(F, 2, bf2f(((const bf16_t*)(F.ws + WS_YMIX))[(size_t)row * DM + 512 + h * 128 + F.tid]), ref); }
    __syncthreads();
}
__device__ __forceinline__ void dbg_acc2(const Frame& F, int chk, float num, float den) {
    num = wave_sum(num); den = wave_sum(den);
    if (F.lane == 0) { if (!(num == num) || num > 1e30f) num = 1e30f; float* d = (float*)(F.ws + WS_DBG); atomicAdd(d + 2 * chk, num); atomicAdd(d + 2 * chk + 1, den); }
}
__device__ __forceinline__ float dbg_px(const Frame& F, int b, int pos, int col, int seg_lo, int seg_hi) {
    return (pos >= seg_lo && pos < seg_hi) ? bf2f(((const bf16_t*)(F.ws + WS_PROJ))[(size_t)(b * TPB + pos) * NPROJ + col]) : 0.f; }
__device__ void dbg_check_3(const Frame& F, int l) {
    LAS float* A = (LAS float*)F.lds;
    const unsigned hs = hash_u(F.bx * 131u + 7u + l); const int b = hs & 7, ch = (hs >> 3) & 255, h = ch >> 6, cj = ch & 63;
    for (int pos = F.tid; pos < TPB; pos += NTHR) { const int seg_lo = pos < CTXL ? 0 : CTXL, seg_hi = pos < CTXL ? CTXL : TPB;
        float da0 = 0.f, dx0 = 0.f, da1 = 0.f, dx1 = 0.f, xself = 0.f;
        for (int i = 0; i < 64; ++i) { const int ci = h * 64 + i; float xc = F.in[I_LCB][l * 256 + ci];
            for (int j = 0; j < 4; ++j) xc += F.in[I_LCW][(l * 4 + j) * 256 + ci] * dbg_px(F, b, pos + j - 2, C_LX + ci, seg_lo, seg_hi);
            if (i == cj) xself = xc;
            da0 += xc * F.in[I_LWA][(size_t)(((l * 2 + 0) * 4 + h) * 64 + i) * 64 + cj]; dx0 += xc * F.in[I_LWX][(size_t)(((l * 2 + 0) * 4 + h) * 64 + i) * 64 + cj];
            da1 += xc * F.in[I_LWA][(size_t)(((l * 2 + 1) * 4 + h) * 64 + i) * 64 + cj]; dx1 += xc * F.in[I_LWX][(size_t)(((l * 2 + 1) * 4 + h) * 64 + i) * 64 + cj]; }
        for (int dir = 0; dir < 2; ++dir) { const int pi = (l * 2 + dir) * 256 + ch; const float da = dir ? da1 : da0, dx = dir ? dx1 : dx0;
            const float r = 1.f / (1.f + expf(-(da + F.in[I_LBA][pi]))), ii = 1.f / (1.f + expf(-(dx + F.in[I_LBX][pi])));
            const float la = -8.f * r * log1pf(expf(-F.in[I_LLAM][pi])); A[(2 * dir) * TPB + pos] = expf(la); A[(2 * dir + 1) * TPB + pos] = sqrtf(-expm1f(2.f * la)) * ii * xself; } }
    __syncthreads();
    if (F.tid == 0) { float hh = 0.f; for (int pos = 0; pos < TPB; ++pos) { hh = A[pos] * hh + A[TPB + pos]; A[TPB + pos] = hh; } }
    if (F.tid == 64) { float hh = 0.f; for (int pos = CTXL - 1; pos >= 0; --pos) { hh = A[2 * TPB + pos] * hh + A[3 * TPB + pos]; A[3 * TPB + pos] = hh; }
        for (int pos = TPB - 1; pos >= CTXL; --pos) { hh = A[2 * TPB + pos] * hh + A[3 * TPB + pos]; A[3 * TPB + pos] = hh; } }
    __syncthreads();
    float num = 0.f, den = 0.f;
    for (int pos = F.tid; pos < TPB; pos += NTHR) { const size_t row = (size_t)b * TPB + pos; const float g = bf2f(((const bf16_t*)(F.ws + WS_PROJ))[row * NPROJ + C_LG + ch]);
        const float ref = 0.5f * g * (1.f + tanhf(0.7978845608f * (g + 0.044715f * g * g * g))) * (A[TPB + pos] + A[3 * TPB + pos]);
        const float got = bf2f(((const bf16_t*)(F.ws + WS_YMIX))[row * DM + ch]); num += (got - ref) * (got - ref); den += ref * ref; }
    dbg_acc2(F, 3, num, den);
    __syncthreads();
}
__device__ __forceinline__ float dbg_convsilu(const Frame& F, int l, int b, int pos, int col, int cch) {
    const int seg_lo = pos < CTXL ? 0 : CTXL, seg_hi = pos < CTXL ? CTXL : TPB; float v = F.in[I_SCB][l * 768 + cch];
    for (int j = 0; j < 4; ++j) v += F.in[I_SCW][(l * 4 + j) * 768 + cch] * dbg_px(F, b, pos + j - 2, col, seg_lo, seg_hi);
    return v / (1.f + expf(-v)); }
__device__ void dbg_check_45(const Frame& F, int l) {
    LAS float* yp = (LAS float*)F.lds;
    const unsigned hs = hash_u(F.bx * 733u + 3u + l); const int b = hs & 7, h = (hs >> 3) & 3, p = (hs >> 5) & 63, g = h >> 1;
    if (F.tid < 256) { const int dir = F.tid >> 7, n = F.tid & 127; float st = 0.f;
        const float a = -expf(F.in[I_SALOG][l * 8 + dir * 4 + h]), bias = F.in[I_SDTB][l * 8 + dir * 4 + h];
        for (int s2 = 0; s2 < TPB; ++s2) { const int pos = dir ? (s2 < CTXL ? CTXL - 1 - s2 : TPB - 1 - (s2 - CTXL)) : s2;
            const float xs = dbg_convsilu(F, l, b, pos, C_XS + h * 64 + p, h * 64 + p), bn = dbg_convsilu(F, l, b, pos, C_BM + g * 128 + n, 256 + g * 128 + n), cn = dbg_convsilu(F, l, b, pos, C_CM + g * 128 + n, 512 + g * 128 + n);
            const float draw = ((const float*)(F.ws + WS_DTRAW))[(size_t)(b * TPB + pos) * 8 + dir * 4 + h] + bias; const float dt = draw > 20.f ? draw : log1pf(expf(draw));
            st = expf(dt * a) * st + bn * dt * xs; const float part = wave_sum(cn * st); if (F.lane == 0) yp[F.wid * TPB + pos] = part; } }
    __syncthreads();
    float num = 0.f, den = 0.f;
    for (int pos = F.tid; pos < TPB; pos += NTHR) { const size_t row = (size_t)b * TPB + pos; const float xs = dbg_convsilu(F, l, b, pos, C_XS + h * 64 + p, h * 64 + p);
        const float z = bf2f(((const bf16_t*)(F.ws + WS_PROJ))[row * NPROJ + C_SZ + h * 64 + p]);
        const float ref = (yp[pos] + yp[TPB + pos] + yp[2 * TPB + pos] + yp[3 * TPB + pos] + F.in[I_SD][l * 4 + h] * xs) * (z / (1.f + expf(-z)));
        const float got = ((const float*)(F.ws + WS_YPRE))[row * 256 + h * 64 + p]; num += (got - ref) * (got - ref); den += ref * ref; }
    dbg_acc2(F, 4, num, den);
    { const int row = hash_u((F.bx * 8 + F.wid) * 977u + 11u) % NROW; const float* yr = (const float*)(F.ws + WS_YPRE) + (size_t)row * 256; float v[4], ss = 0.f;
      for (int i = 0; i < 4; ++i) { v[i] = yr[F.lane + 64 * i]; ss += v[i] * v[i]; }
      ss = wave_sum(ss); const float rs = 1.f / sqrtf(ss / 256.f + EPSN); float n5 = 0.f, d5 = 0.f;
      for (int i = 0; i < 4; ++i) { const float ref = v[i] * rs * F.in[I_SNG][l * 256 + F.lane + 64 * i], got = bf2f(((const bf16_t*)(F.ws + WS_YMIX))[(size_t)row * DM + 256 + F.lane + 64 * i]); n5 += (got - ref) * (got - ref); d5 += ref * ref; }
      dbg_acc2(F, 5, n5, d5); }
    __syncthreads();
}
__device__ void dbg_check_6(const Frame& F, int l) {
    const int gt = F.bx * NTHR + F.tid; const unsigned hs = hash_u(gt * 2246822519u + 3u);
    const int row = hs % NROW, n = (hs >> 16) & 1023; float sacc = 0.f;
    for (int k = 0; k < 1024; ++k) sacc += bf2f(((const bf16_t*)(F.ws + WS_YMIX))[(size_t)row * DM + k]) * F.in[I_WOUT][((size_t)l * 1024 + k) * 1024 + n];
    const float ref = row_input(F, row)[n] + ((const float*)(F.ws + WS_MOD))[(size_t)(l * 9 + row_mrow(row)) * 6144 + 2 * 1024 + n] * sacc;
    dbg_acc2(F, 6, (((const float*)(F.ws + WS_XRES))[(size_t)row * DM + n] - ref) * (((const float*)(F.ws + WS_XRES))[(size_t)row * DM + n] - ref), ref * ref);
}
__device__ void dbg_check_78(const Frame& F, int l) {
    LAS float* hrow = (LAS float*)F.lds; LAS float* red = hrow + 1024; LAS float* lg = red + 16;
    const int row = hash_u(F.bx * 1597u + 29u) % NROW;
    const float* xr = (const float*)(F.ws + WS_XRES) + (size_t)row * DM;
    float ss = 0.f; for (int k = F.tid; k < 1024; k += NTHR) ss += xr[k] * xr[k];
    ss = wave_sum(ss); if (F.lane == 0) red[F.wid] = ss; __syncthreads();
    float tot = 0.f; for (int w = 0; w < 8; ++w) tot += red[w];
    const float rstd = 1.0f / sqrtf(tot / 1024.f + EPSN);
    const float* mod = (const float*)(F.ws + WS_MOD) + (size_t)(l * 9 + row_mrow(row)) * 6144;
    float num = 0.f, den = 0.f;
    for (int k = F.tid; k < 1024; k += NTHR) { const float h = xr[k] * rstd * F.in[I_N2G][l * 1024 + k] * (1.f + mod[4 * 1024 + k]) + mod[3 * 1024 + k]; hrow[k] = h;
        const float got = bf2f(((const bf16_t*)(F.ws + WS_H))[(size_t)row * DM + k]); num += (got - h) * (got - h); den += h * h; }
    __syncthreads();
    if (F.tid < 32) { float a = F.in[I_RB][l * 32 + F.tid]; for (int k = 0; k < 1024; ++k) a += hrow[k] * F.in[I_RW][((size_t)l * 1024 + k) * 32 + F.tid]; lg[F.tid] = a; }
    __syncthreads();
    if (F.tid == 0) { LAS float* sv = lg + 32; LAS int* se = (LAS int*)(lg + 40); unsigned used = 0u;
        for (int r = 0; r < 4; ++r) { float m = -1e30f; int bi = 0; for (int j = 0; j < 32; ++j) if (!((used >> j) & 1u) && lg[j] > m) { m = lg[j]; bi = j; } used |= 1u << bi; sv[r] = m; se[r] = bi; }
        float sm = 0.f; for (int r = 0; r < 4; ++r) sm += expf(sv[r] - sv[0]);
        float n8 = 0.f;
        for (int r = 0; r < 4; ++r) { const float ref = expf(sv[r] - sv[0]) / sm, got = ((const float*)(F.ws + WS_TOKG))[(size_t)row * 4 + r]; num += (got - ref) * (got - ref); den += ref * ref;
            n8 += (((const int*)(F.ws + WS_TOKE))[(size_t)row * 4 + r] != se[r]) ? 1.f : 0.f; }
        float* d = (float*)(F.ws + WS_DBG); atomicAdd(d + 16, n8); atomicAdd(d + 17, 4.f * 1000.f); }
    dbg_acc2(F, 7, num, den);
    __syncthreads();
}
__device__ void dbg_check_9(const Frame& F, int l) {
    LAS float* hrow = (LAS float*)F.lds; LAS float* act = hrow + 1024;
    const unsigned hs = hash_u(F.bx * 2971u + 41u); int row = hs % NROW; if (l == 1 && (row % TPB) < CTXL) row += CTXL; const int r = (hs >> 20) & 3, slot = row * 4 + r;
    const int e = ((const int*)(F.ws + WS_TOKE))[slot]; const float gate = ((const float*)(F.ws + WS_TOKG))[slot];
    for (int k = F.tid; k < 1024; k += NTHR) hrow[k] = bf2f(((const bf16_t*)(F.ws + WS_H))[(size_t)row * DM + k]);
    __syncthreads();
    const float* wgu = F.in[I_WGU] + ((size_t)l * 32 + e) * 1024 * 2048; const float* bgu = F.in[I_BGU] + ((size_t)l * 32 + e) * 2048;
    for (int j = F.tid; j < 1024; j += NTHR) { float g = bgu[2 * j], u = bgu[2 * j + 1];
        for (int k = 0; k < 1024; ++k) { const f32x2 w = *(const f32x2*)(wgu + (size_t)k * 2048 + 2 * j); g += hrow[k] * w.x; u += hrow[k] * w.y; }
        g = fminf(g, 7.f); u = fminf(fmaxf(u, -7.f), 7.f); act[j] = (u + 1.f) * g / (1.f + expf(-1.702f * g)); }
    __syncthreads();
    const float* wd = F.in[I_WD] + ((size_t)l * 32 + e) * 1024 * 1024; float num = 0.f, den = 0.f;
    for (int n = F.tid; n < 1024; n += NTHR) { float y = F.in[I_BD][((size_t)l * 32 + e) * 1024 + n]; for (int j = 0; j < 1024; ++j) y += act[j] * wd[(size_t)j * 1024 + n];
        y *= gate; const float got = bf2f(((const bf16_t*)(F.ws + WS_YSLOT))[(size_t)slot * DM + n]); num += (got - y) * (got - y); den += y * y; }
    dbg_acc2(F, 9, num, den);
    __syncthreads();
}
__device__ void dbg_report(const Frame& F, int nchk) {
    const float* d = (const float*)(F.ws + WS_DBG);
    int bad = -1; float rel = 0.f;
    for (int i = 0; i < nchk; ++i) { const float n = d[2 * i], q = d[2 * i + 1]; float r = (q > 0.f) ? sqrtf(n / q) : 1e9f; if (!(r == r)) r = 1e9f; if (r > 0.03f) { bad = i; rel = r; break; } }
    float V = 0.f;
    if (bad >= 0) { float m = 5.f + log10f(rel); m = m < 1.f ? 1.f : (m > 9.9f ? 9.9f : m); V = m * powf(10.f, (float)(3 + bad)); }
    else return;
    for (size_t i = (size_t)F.bx * NTHR + F.tid; i < (size_t)NBATCH * SEQ * DM; i += (size_t)F.G * NTHR) F.out[i] = V;
}
#endif

#if MK_DBG
__global__ void __launch_bounds__(NTHR) hymba_dbg(Args args) {
    extern __shared__ __attribute__((aligned(16))) unsigned char lds_raw[];
    Frame F; F.in = args.in; F.in0 = args.in; F.out = args.out; F.ws = args.ws; F.ws0 = args.ws; F.lds = (LAS unsigned char*)lds_raw;
    F.tid = threadIdx.x; F.lane = F.tid & 63; F.wid = __builtin_amdgcn_readfirstlane(F.tid >> 6); F.G = gridDim.x; F.bx = blockIdx.x;
    const int lo = args.lo, hi = args.hi;
    if (lo == 1001) dbg_check_01(F, hi);
    if (lo == 1002) dbg_check_2(F, hi);
    if (lo == 1003) dbg_check_3(F, hi);
    if (lo == 1004) dbg_check_45(F, hi);
    if (lo == 1006) dbg_check_6(F, hi);
    if (lo == 1007) dbg_check_78(F, hi);
    if (lo == 1009) dbg_check_9(F, hi);
    if (lo == 1099) dbg_report(F, hi);
}
#endif

__global__ void __launch_bounds__(NTHR, 2) hymba_fwd(Args args) {
    extern __shared__ __attribute__((aligned(16))) unsigned char lds_raw[];
    Frame F; F.in = args.in; F.in0 = args.in; F.out = args.out; F.ws = args.ws; F.ws0 = args.ws; F.lds = (LAS unsigned char*)lds_raw;
    F.tid = threadIdx.x; F.lane = F.tid & 63; F.wid = __builtin_amdgcn_readfirstlane(F.tid >> 6); F.wave_s = F.wid; F.G = gridDim.x; F.bx = blockIdx.x;
    const int lo = args.lo, hi = args.hi;
#define IN(k) (lo <= (k) && (k) < hi)
#define BOTH(k) (IN(k) && IN((k) + 1))
#if MK_ONE_LAUNCH
    volatile LAS unsigned* misc = (volatile LAS unsigned*)(F.lds + LDS_MISC);
    if (F.tid < 4) misc[F.tid] = 0u;
    __syncthreads();
    XcdBarrier bar = xcd_barrier_post((unsigned*)(F.ws + WS_BAR), misc, F.wave_s);
#define GRID_BAR() xcd_barrier(bar)
#else
#define GRID_BAR() do {} while (0)
#endif
#if MK_PA >= 0
#define STAMP(k) do { if (blockIdx.x == 0 && xb_thread0(F.wave_s)) { unsigned long long z_; asm volatile("s_mov_b64 %0, 0" : "=s"(z_)); ((unsigned*)(args.ws + WS_DBG + z_))[8 + (k)] = (unsigned)__builtin_amdgcn_s_memrealtime(); } } while (0)
#else
#define STAMP(k) do {} while (0)
#endif
    STAMP(-1);
    F.gx = F.bx & 7; F.gj = F.bx >> 3; F.gn = F.G >> 3;
    if (IN(0)) { F.refresh(); p0_prologue(F); if (MK_DUP == 100) { GRID_BAR(); F.refresh(); p0_prologue(F); } if (BOTH(0)) GRID_BAR(); STAMP(0); }
#if MK_ONE_LAUNCH
    if (lo == 0 && hi > 1) {
        const unsigned nloc = misc[0], rank = misc[2];
        unsigned tot = 0u, minc = 0xffffffffu; bool all8 = true;
#pragma unroll
        for (int j = 0; j < 8; ++j) { const unsigned cj = xb_ld(&bar.bar[XB_XCNT(j)]); tot += cj; all8 = all8 && (cj > 0u); minc = cj < minc ? cj : minc; }
        if (all8 && tot == (unsigned)F.G && minc >= 16u) { F.gx = (int)bar.x; F.gj = __builtin_amdgcn_readfirstlane((int)rank); F.gn = __builtin_amdgcn_readfirstlane((int)nloc); }
    }
#endif
    for (int l = 0; l < 2; ++l) {
        const int pb = 1 + 10 * l;
        if (IN(pb + 0)) { F.refresh(); p_norm1(F, l); if (MK_DUP == 0 && l == 0) { GRID_BAR(); F.refresh(); p_norm1(F, l); } if (BOTH(pb + 0)) GRID_BAR(); STAMP(pb + 0); }
#if MK_DUP == 11
        { F.refresh(); p_inproj_null(F, l); GRID_BAR(); }
#endif
        if (IN(pb + 1)) { F.refresh(); p_inproj(F, l); if (MK_DUP == 1) { GRID_BAR(); F.refresh(); p_inproj(F, l); } if (BOTH(pb + 1)) GRID_BAR(); STAMP(pb + 1); }
        if (IN(pb + 2)) { F.refresh(); p_conv(F, l); if (MK_DUP == 2) { GRID_BAR(); F.refresh(); p_conv(F, l); } if (BOTH(pb + 2)) GRID_BAR(); STAMP(pb + 2); }
        if (IN(pb + 3)) { F.refresh(); p_post(F, l); if (MK_DUP == 3) { GRID_BAR(); F.refresh(); p_post(F, l); } if (BOTH(pb + 3)) GRID_BAR(); STAMP(pb + 3); }
        if (IN(pb + 4)) { F.refresh(); p_attn(F, l); if (MK_DUP == 4) { GRID_BAR(); F.refresh(); p_attn(F, l); } if (BOTH(pb + 4)) GRID_BAR(); STAMP(pb + 4); }
        if (IN(pb + 5)) { F.refresh(); p_mix2(F, l); if (MK_DUP == 5) { GRID_BAR(); F.refresh(); p_mix2(F, l); } if (BOTH(pb + 5)) GRID_BAR(); STAMP(pb + 5); }
        if (IN(pb + 6)) { if (MK_DUP == 6) { F.refresh(); p_outproj(F, l, true); GRID_BAR(); } F.refresh(); p_outproj(F, l); if (BOTH(pb + 6)) GRID_BAR(); STAMP(pb + 6); }
        if (IN(pb + 7)) { if (MK_DUP == 7) { F.refresh(); p_norm2(F, l, true); GRID_BAR(); } F.refresh(); p_norm2(F, l); if (BOTH(pb + 7)) GRID_BAR(); STAMP(pb + 7); }
        if (IN(pb + 8)) { F.refresh(); p_moe_gu(F, l); if (MK_DUP == 8) { GRID_BAR(); F.refresh(); p_moe_gu(F, l); } if (BOTH(pb + 8)) GRID_BAR(); STAMP(pb + 8); }
        if (IN(pb + 9)) { F.refresh(); p_moe_down(F, l); if (MK_DUP == 9) { GRID_BAR(); F.refresh(); p_moe_down(F, l); } if (BOTH(pb + 9)) GRID_BAR(); STAMP(pb + 9); }
    }
    if (IN(21)) { F.refresh(); p_final(F); }
#if MK_PA >= 0
    {
        GRID_BAR();
        const unsigned* st = (const unsigned*)(args.ws + WS_DBG) + 8;
        const float va = (float)(__hip_atomic_load(st + MK_PA, __ATOMIC_RELAXED, __HIP_MEMORY_SCOPE_AGENT) - __hip_atomic_load(st + MK_PA - 1, __ATOMIC_RELAXED, __HIP_MEMORY_SCOPE_AGENT)) * 30.f;
        const float vb = (float)(__hip_atomic_load(st + MK_PB, __ATOMIC_RELAXED, __HIP_MEMORY_SCOPE_AGENT) - __hip_atomic_load(st + MK_PB - 1, __ATOMIC_RELAXED, __HIP_MEMORY_SCOPE_AGENT)) * 1.f;
        for (size_t i = (size_t)blockIdx.x * NTHR + threadIdx.x; i < (size_t)NBATCH * SEQ * DM; i += (size_t)gridDim.x * NTHR) args.out[i] = (i == 0) ? va : vb;
    }
#endif
#undef IN
#undef BOTH
}

extern "C" void kernel_launch(void* const* d_in, const int* in_sizes, int n_in, void* d_out, int out_size, void* d_ws, size_t ws_size, hipStream_t stream) {
    static int grid = 0;
    if (grid == 0) {
        if (n_in != N_IN || out_size != NBATCH * SEQ * DM || ws_size < WS_END) { fprintf(stderr, "kernel_launch: unexpected shapes (n_in %d, out %d, ws %zu < %zu)\n", n_in, out_size, ws_size, (size_t)WS_END); grid = -1; return; }
        int dev = 0, cus = 0;
        if (hipGetDevice(&dev) != hipSuccess || hipDeviceGetAttribute(&cus, hipDeviceAttributeMultiprocessorCount, dev) != hipSuccess) { grid = -1; return; }
        if (hipFuncSetAttribute((const void*)hymba_fwd, hipFuncAttributeMaxDynamicSharedMemorySize, LDS_BYTES) != hipSuccess) { fprintf(stderr, "kernel_launch: hipFuncSetAttribute failed\n"); grid = -1; return; }
#if MK_DBG
        (void)hipFuncSetAttribute((const void*)hymba_dbg, hipFuncAttributeMaxDynamicSharedMemorySize, LDS_BYTES);
#endif
        int per_cu = 0;
        if (hipOccupancyMaxActiveBlocksPerMultiprocessor(&per_cu, (const void*)hymba_fwd, NTHR, LDS_BYTES) != hipSuccess || per_cu < 1) fprintf(stderr, "kernel_launch: occupancy query says %d\n", per_cu);
        (void)hipGetLastError();
        grid = (cus / 8) * 8;
        if (grid < 8) grid = 8;
    }
    if (grid < 0) return;
    (void)hipMemsetAsync(d_ws, 0, WS_ZERO_END, stream);
    Args a{};
    for (int i = 0; i < N_IN; ++i) a.in[i] = (const float*)d_in[i];
    a.out = (float*)d_out; a.ws = (unsigned char*)d_ws;
    auto launch = [&](int lo, int hi) { a.lo = lo; a.hi = hi;
#if MK_DBG
        if (lo >= 1000) { hipLaunchKernelGGL(hymba_dbg, dim3(grid), dim3(NTHR), LDS_BYTES, stream, a); return; }
#endif
        hipLaunchKernelGGL(hymba_fwd, dim3(grid), dim3(NTHR), LDS_BYTES, stream, a); };
#if MK_ONE_LAUNCH
    launch(0, 22);
#else
    const int last = MK_LAST_PHASE;
    for (int p = 0; p <= last; ++p) {
        launch(p, p + 1);
#if MK_DBG
        if (p == 2) launch(1001, 0);
        if (p == 5) launch(1002, 0);
        if (p == 6) { launch(1003, 0); launch(1004, 0); }
        if (p == 7) launch(1006, 0);
        if (p == 8) launch(1007, 0);
        if (p == 10) launch(1009, 0);
#endif
    }
#if MK_DBG
    launch(1099, 10);
#endif
#endif
}
```
